# Optimizing an MI355X kernel written in HIP

```python
import math
import jax, jax.numpy as jnp
from jax import lax
import numpy as np

D_MODEL = 1024
BATCH = 4
SEQ = 4096
DEPTH = 4

GRID_W = 64
CTX_LEN = 256
RET_HEADS = 4
RET_DK = 128
RET_DV = 256
RET_CHUNK = 128
DIFF_HEADS = 4
DIFF_DK = 64
DIFF_DV = 2 * DIFF_DK
DIFF_QBLOCK = 128
GQA_HEADS = 8
GQA_KV_HEADS = 2
GQA_DH = 64
WINDOW = 128
N_EXPERTS = 32
TOP_K = 4
D_EXPERT = D_MODEL
SWIGLU_ALPHA = 1.702
SWIGLU_LIMIT = 7.0
MOE_BLOCK = 256
ROPE_BASE = 10000.0
NORM_EPS = 1e-6

RET_QK_W = RET_HEADS * RET_DK
RET_V_W = RET_HEADS * RET_DV
DIFF_QK_W = DIFF_HEADS * 2 * DIFF_DK
DIFF_V_W = DIFF_HEADS * DIFF_DV
GQA_Q_W = GQA_HEADS * GQA_DH
GQA_KV_W = GQA_KV_HEADS * GQA_DH
N_BRANCH = 3
IN_SPLITS = (RET_QK_W, RET_QK_W, RET_V_W, RET_V_W,
             DIFF_QK_W, DIFF_QK_W, DIFF_V_W,
             GQA_Q_W, GQA_KV_W, GQA_KV_W,
             N_BRANCH * D_MODEL)
D_IN = sum(IN_SPLITS)
BRANCH_W = (RET_V_W, DIFF_V_W, GQA_Q_W)
D_BRANCH = sum(BRANCH_W)

kernel_name = "hybrid_retention_diffattn_swa_moe_dit"


def _offsets(sizes):
    return [int(i) for i in np.cumsum(sizes)[:-1]]


def rms_norm(x, g):
    xf = x.astype(jnp.float32)
    y = xf * lax.rsqrt(jnp.mean(xf * xf, axis=-1, keepdims=True) + NORM_EPS)
    return (y * g.astype(jnp.float32)).astype(x.dtype)


def split_heads(t, n_heads):
    b, l, _ = t.shape
    return t.reshape(b, l, n_heads, -1).transpose(0, 2, 1, 3)


def merge_heads(t):
    b, h, l, d = t.shape
    return t.transpose(0, 2, 1, 3).reshape(b, l, h * d)


def flip_seq(t):
    return t[:, :, ::-1]


def axial_rope(rows, head_dim):
    quarter = head_dim // 4
    inv_freq = ROPE_BASE ** (-jnp.arange(quarter, dtype=jnp.float32) / quarter)
    row = jnp.repeat(jnp.arange(rows, dtype=jnp.float32), GRID_W)
    col = jnp.tile(jnp.arange(GRID_W, dtype=jnp.float32), rows)
    ang = jnp.concatenate([row[:, None] * inv_freq, col[:, None] * inv_freq], axis=-1)
    return jnp.cos(ang), jnp.sin(ang)


def apply_rope(x, cos, sin):
    half = x.shape[-1] // 2
    x1, x2 = x[..., :half], x[..., half:]
    c = cos.astype(x.dtype)
    s = sin.astype(x.dtype)
    return jnp.concatenate([x1 * c - x2 * s, x1 * s + x2 * c], axis=-1)


def retention_chunkwise(q, k, v, log_gamma, s0):
    b, h, l, _ = q.shape
    dv = v.shape[-1]
    C = RET_CHUNK
    n = l // C
    f32 = jnp.float32
    pos = jnp.arange(C, dtype=f32)
    lg = log_gamma[:, None]
    rel = pos[:, None] - pos[None, :]
    decay_mask = jnp.where(rel >= 0, jnp.exp(jnp.maximum(rel, 0.0)[None] * lg[:, :, None]), 0.0)
    q_decay = jnp.exp((pos + 1.0)[None] * lg)[..., None]
    k_decay = jnp.exp((C - 1.0 - pos)[None] * lg)[..., None]
    chunk_decay = jnp.exp(C * lg)[..., None]

    def chunks(t):
        return jnp.moveaxis(t.astype(f32).reshape(b, h, n, C, t.shape[-1]), 2, 0)

    def step(s, qkv):
        qc, kc, vc = qkv
        o = (jnp.einsum('bhij,bhje->bhie', jnp.einsum('bhid,bhjd->bhij', qc, kc) * decay_mask, vc)
             + jnp.einsum('bhid,bhde->bhie', qc * q_decay, s))
        s = s * chunk_decay + jnp.einsum('bhjd,bhje->bhde', kc * k_decay, vc)
        return s, o

    s_fin, o = lax.scan(step, s0, (chunks(q), chunks(k), chunks(v)))
    return jnp.moveaxis(o, 0, 2).reshape(b, h, l, dv), s_fin


def retention_out(o, g):
    mu = jnp.mean(o, axis=-1, keepdims=True)
    var = jnp.mean(jnp.square(o - mu), axis=-1, keepdims=True)
    o = (o - mu) * lax.rsqrt(var + NORM_EPS)
    return jax.nn.silu(g) * merge_heads(o).astype(g.dtype)


def retention_mixer(lat, ctx, lg_f, lg_b, cos, sin, need_ctx):
    q, k, v, g = lat
    qc, kc, vc, gc = ctx
    scale = RET_DK ** -0.5
    q = apply_rope(split_heads(q, RET_HEADS), cos, sin) * scale
    k = apply_rope(split_heads(k, RET_HEADS), cos, sin)
    v = split_heads(v, RET_HEADS)
    qc = split_heads(qc, RET_HEADS) * scale
    kc = split_heads(kc, RET_HEADS)
    vc = split_heads(vc, RET_HEADS)
    s0 = jnp.zeros((q.shape[0], RET_HEADS, RET_DK, RET_DV), jnp.float32)
    oc_f, sc_f = retention_chunkwise(qc, kc, vc, lg_f, s0)
    oc_b, sc_b = retention_chunkwise(flip_seq(qc), flip_seq(kc), flip_seq(vc), lg_b, s0)
    o_f, _ = retention_chunkwise(q, k, v, lg_f, sc_f)
    o_b, _ = retention_chunkwise(flip_seq(q), flip_seq(k), flip_seq(v), lg_b, sc_b)
    y = retention_out(o_f + flip_seq(o_b), g)
    yc = retention_out(oc_f + flip_seq(oc_b), gc) if need_ctx else None
    return y, yc


def diff_weights_values(q1, q2, k1, k2, v, lam):
    scale = DIFF_DK ** -0.5
    a1 = jax.nn.softmax((jnp.einsum('bhqd,bhkd->bhqk', q1, k1) * scale).astype(jnp.float32), axis=-1)
    a2 = jax.nn.softmax((jnp.einsum('bhqd,bhkd->bhqk', q2, k2) * scale).astype(jnp.float32), axis=-1)
    return jnp.einsum('bhqk,bhkd->bhqd', (a1 - lam * a2).astype(v.dtype), v)


def diff_head_norm(o, g, lam_init):
    of = o.astype(jnp.float32)
    of = of * lax.rsqrt(jnp.mean(of * of, axis=-1, keepdims=True) + NORM_EPS) * g.astype(jnp.float32) * (1.0 - lam_init)
    return merge_heads(of.astype(o.dtype))


def diff_attention(lat, ctx, lam, lam_init, subln_g, cos, sin, need_ctx):
    q, k, v = lat
    qc, kc, vc = ctx

    def halves(t, rope):
        t = split_heads(t, DIFF_HEADS)
        t1, t2 = t[..., :DIFF_DK], t[..., DIFF_DK:]
        if rope:
            t1, t2 = apply_rope(t1, cos, sin), apply_rope(t2, cos, sin)
        return t1, t2

    q1, q2 = halves(q, True)
    k1, k2 = halves(k, True)
    kc1, kc2 = halves(kc, False)
    v = split_heads(v, DIFF_HEADS)
    vc = split_heads(vc, DIFF_HEADS)
    K1 = jnp.concatenate([k1, kc1], axis=2)
    K2 = jnp.concatenate([k2, kc2], axis=2)
    V = jnp.concatenate([v, vc], axis=2)
    B, H, S, _ = q1.shape
    nq = S // DIFF_QBLOCK

    def to_blocks(t):
        return jnp.moveaxis(t.reshape(B, H, nq, DIFF_QBLOCK, DIFF_DK), 2, 0)

    o = lax.map(lambda qq: diff_weights_values(qq[0], qq[1], K1, K2, V, lam), (to_blocks(q1), to_blocks(q2)))
    o = jnp.moveaxis(o, 0, 2).reshape(B, H, S, DIFF_DV)
    y = diff_head_norm(o, subln_g, lam_init)
    yc = None
    if need_ctx:
        qc1, qc2 = halves(qc, False)
        yc = diff_head_norm(diff_weights_values(qc1, qc2, kc1, kc2, vc, lam), subln_g, lam_init)
    return y, yc


def band_blocks(t, w):
    b, h, l, d = t.shape
    tb = jnp.pad(t.reshape(b, h, l // w, w, d), ((0, 0), (0, 0), (1, 1), (0, 0), (0, 0)))
    return jnp.concatenate([tb[:, :, :-2], tb[:, :, 1:-1], tb[:, :, 2:]], axis=3)


def window_gqa(lat, ctx, sink, cos, sin, need_ctx):
    q, k, v = lat
    qc, kc, vc = ctx
    B, S, _ = q.shape
    Hk, G, d, W = GQA_KV_HEADS, GQA_HEADS // GQA_KV_HEADS, GQA_DH, WINDOW
    NB = S // W
    scale = d ** -0.5
    sink_f = sink.astype(jnp.float32).reshape(Hk, G)
    q = apply_rope(q.reshape(B, S, Hk, G, d).transpose(0, 2, 3, 1, 4), cos, sin)
    k = apply_rope(split_heads(k, Hk), cos, sin)
    v = split_heads(v, Hk)
    kc = split_heads(kc, Hk)
    vc = split_heads(vc, Hk)
    n_ctx = kc.shape[2]
    qb = q.reshape(B, Hk, G, NB, W, d)
    kb, vb = band_blocks(k, W), band_blocks(v, W)
    s_loc = jnp.einsum('bkgnqd,bknjd->bkgnqj', qb, kb).astype(jnp.float32) * scale
    s_ctx = jnp.einsum('bkgnqd,bkcd->bkgnqc', qb, kc).astype(jnp.float32) * scale
    qi = jnp.arange(W)[:, None]
    kj = jnp.arange(3 * W)[None, :]
    kpos = (jnp.arange(NB)[:, None, None] - 1) * W + kj[None]
    mask = (jnp.abs(qi - kj + W) <= WINDOW)[None] & (kpos >= 0) & (kpos < S)
    s_sink = jnp.broadcast_to(sink_f[None, :, :, None, None, None], s_ctx.shape[:-1] + (1,))
    p = jax.nn.softmax(jnp.concatenate([jnp.where(mask, s_loc, -jnp.inf), s_ctx, s_sink], axis=-1), axis=-1)
    o = (jnp.einsum('bkgnqj,bknjd->bkgnqd', p[..., :3 * W].astype(v.dtype), vb)
         + jnp.einsum('bkgnqc,bkcd->bkgnqd', p[..., 3 * W:3 * W + n_ctx].astype(v.dtype), vc))
    y = o.reshape(B, Hk, G, S, d).transpose(0, 3, 1, 2, 4).reshape(B, S, Hk * G * d)
    yc = None
    if need_ctx:
        qcg = qc.reshape(B, n_ctx, Hk, G, d).transpose(0, 2, 3, 1, 4)
        sc = jnp.einsum('bkgqd,bkcd->bkgqc', qcg, kc).astype(jnp.float32) * scale
        sc_sink = jnp.broadcast_to(sink_f[None, :, :, None, None], sc.shape[:-1] + (1,))
        pc = jax.nn.softmax(jnp.concatenate([sc, sc_sink], axis=-1), axis=-1)
        oc = jnp.einsum('bkgqc,bkcd->bkgqd', pc[..., :n_ctx].astype(vc.dtype), vc)
        yc = oc.transpose(0, 3, 1, 2, 4).reshape(B, n_ctx, Hk * G * d)
    return y, yc


def merge_branches(ys, gate_pre, w_branch, w_out):
    w_r, w_d, w_g = jnp.split(w_branch, _offsets(BRANCH_W), axis=0)
    g_r, g_d, g_g = jnp.split(jax.nn.sigmoid(gate_pre), N_BRANCH, axis=-1)
    merged = g_r * (ys[0] @ w_r) + g_d * (ys[1] @ w_d) + g_g * (ys[2] @ w_g)
    return merged @ w_out


def hybrid_mixer(h, hc, w_in, lg_f, lg_b, lam, lam_init, subln_g, sink, w_branch, w_out, ropes, need_ctx):
    p = jnp.split(h @ w_in, _offsets(IN_SPLITS), axis=-1)
    pc = jnp.split(hc @ w_in, _offsets(IN_SPLITS), axis=-1)
    y_r, yc_r = retention_mixer(p[0:4], pc[0:4], lg_f, lg_b, *ropes[0], need_ctx)
    y_d, yc_d = diff_attention(p[4:7], pc[4:7], lam, lam_init, subln_g, *ropes[1], need_ctx)
    y_g, yc_g = window_gqa(p[7:10], pc[7:10], sink, *ropes[2], need_ctx)
    out = merge_branches((y_r, y_d, y_g), p[10], w_branch, w_out)
    out_c = merge_branches((yc_r, yc_d, yc_g), pc[10], w_branch, w_out) if need_ctx else None
    return out, out_c


def moe_ffn(h, w_router, b_router, w_gu, b_gu, w_dn, b_dn):
    T, D = h.shape
    A = T * TOP_K
    n_blocks = (A + N_EXPERTS * (MOE_BLOCK - 1) + MOE_BLOCK - 1) // MOE_BLOCK
    P = n_blocks * MOE_BLOCK
    logits = (h @ w_router + b_router).astype(jnp.float32)
    top_val, top_idx = lax.top_k(logits, TOP_K)
    weights = jax.nn.softmax(top_val, axis=-1).reshape(A)
    expert = top_idx.reshape(A)
    token = jnp.arange(A, dtype=jnp.int32) // TOP_K
    order = jnp.argsort(expert)
    e_sorted = expert[order]
    counts = jnp.zeros((N_EXPERTS,), jnp.int32).at[expert].add(1)
    padded = (counts + MOE_BLOCK - 1) // MOE_BLOCK * MOE_BLOCK
    pad_end = jnp.cumsum(padded)
    rank = jnp.arange(A, dtype=jnp.int32) - (jnp.cumsum(counts) - counts)[e_sorted]
    dest = (pad_end - padded)[e_sorted] + rank
    slot_token = jnp.full((P,), T, jnp.int32).at[dest].set(token[order])
    slot_weight = jnp.zeros((P,), jnp.float32).at[dest].set(weights[order])
    block_start = jnp.arange(n_blocks, dtype=jnp.int32) * MOE_BLOCK
    block_expert = jnp.minimum(jnp.searchsorted(pad_end, block_start, side='right'), N_EXPERTS - 1)
    h_pad = jnp.concatenate([h, jnp.zeros((1, D), h.dtype)], axis=0)
    xin = h_pad[slot_token].reshape(n_blocks, MOE_BLOCK, D)

    def expert_block(xs):
        xb, e = xs
        gu = xb @ w_gu[e] + b_gu[e]
        glu = jnp.minimum(gu[:, :D_EXPERT], SWIGLU_LIMIT)
        lin = jnp.clip(gu[:, D_EXPERT:], -SWIGLU_LIMIT, SWIGLU_LIMIT)
        return (glu * jax.nn.sigmoid(SWIGLU_ALPHA * glu) * (lin + 1.0)) @ w_dn[e] + b_dn[e]

    y = lax.map(expert_block, (xin, block_expert)).reshape(P, D) * slot_weight[:, None].astype(h.dtype)
    return jnp.zeros((T + 1, D), h.dtype).at[slot_token].add(y)[:T]


def setup_inputs(seed: int = 0) -> dict:
    key = jax.random.key(seed)
    ks = jax.random.split(key, 32)
    f32 = jnp.float32
    D = D_MODEL

    def nrm(k, shape, s):
        return jax.random.normal(k, shape, f32) * s

    gam = 1.0 - 2.0 ** (-5.0 - jnp.arange(RET_HEADS, dtype=f32))
    ret_logit = jnp.log(gam) - jnp.log1p(-gam)
    kb = jax.random.split(ks[31], N_BRANCH)
    w_branch = jnp.concatenate([nrm(kb[i], (DEPTH, w, D), w ** -0.5) for i, w in enumerate(BRANCH_W)], axis=1)
    return {
        "x": nrm(ks[0], (BATCH, SEQ, D), 1.0),
        "c": nrm(ks[1], (BATCH, D), 1.0),
        "ctx": nrm(ks[2], (BATCH, CTX_LEN, D), 1.0),
        "c_ctx": nrm(ks[3], (D,), 1.0),
        "w_mod": nrm(ks[4], (DEPTH, D, 6 * D), 0.5 * D ** -0.5),
        "b_mod": nrm(ks[5], (DEPTH, 6 * D), 0.02),
        "g_norm_mix": 1.0 + nrm(ks[6], (DEPTH, D), 0.02),
        "g_norm_ffn": 1.0 + nrm(ks[7], (DEPTH, D), 0.02),
        "w_in": nrm(ks[8], (DEPTH, D, D_IN), D ** -0.5),
        "ret_decay_fwd": ret_logit + nrm(ks[9], (DEPTH, RET_HEADS), 0.1),
        "ret_decay_bwd": ret_logit + nrm(ks[10], (DEPTH, RET_HEADS), 0.1),
        "diff_lambda_q1": nrm(ks[11], (DEPTH, DIFF_DK), 0.1),
        "diff_lambda_k1": nrm(ks[12], (DEPTH, DIFF_DK), 0.1),
        "diff_lambda_q2": nrm(ks[13], (DEPTH, DIFF_DK), 0.1),
        "diff_lambda_k2": nrm(ks[14], (DEPTH, DIFF_DK), 0.1),
        "diff_subln_g": 1.0 + nrm(ks[15], (DEPTH, DIFF_DV), 0.02),
        "gqa_sink": nrm(ks[16], (DEPTH, GQA_HEADS), 0.5),
        "w_branch": w_branch,
        "w_out": nrm(ks[17], (DEPTH, D, D), D ** -0.5),
        "w_router": nrm(ks[18], (DEPTH, D, N_EXPERTS), D ** -0.5),
        "b_router": nrm(ks[19], (DEPTH, N_EXPERTS), 0.01),
        "w_gate_up": nrm(ks[20], (DEPTH, N_EXPERTS, D, 2 * D_EXPERT), D ** -0.5),
        "b_gate_up": nrm(ks[21], (DEPTH, N_EXPERTS, 2 * D_EXPERT), 0.01),
        "w_down": nrm(ks[22], (DEPTH, N_EXPERTS, D_EXPERT, D), D_EXPERT ** -0.5),
        "b_down": nrm(ks[23], (DEPTH, N_EXPERTS, D), 0.01),
        "g_final": 1.0 + nrm(ks[24], (D,), 0.02),
    }


def reference(x, c, ctx, c_ctx, w_mod, b_mod, g_norm_mix, g_norm_ffn, w_in, ret_decay_fwd, ret_decay_bwd,
              diff_lambda_q1, diff_lambda_k1, diff_lambda_q2, diff_lambda_k2, diff_subln_g, gqa_sink,
              w_branch, w_out, w_router, b_router, w_gate_up, b_gate_up, w_down, b_down, g_final):
    f32 = jnp.float32
    B, S, D = x.shape
    rows = S // GRID_W
    ropes = (axial_rope(rows, RET_DK), axial_rope(rows, DIFF_DK), axial_rope(rows, GQA_DH))
    xc = ctx
    for l in range(DEPTH):
        need_ctx = l < DEPTH - 1
        mod = jax.nn.silu(c) @ w_mod[l] + b_mod[l]
        mod_c = jax.nn.silu(c_ctx) @ w_mod[l] + b_mod[l]
        sh1, sc1, ga1, sh2, sc2, ga2 = jnp.split(mod[:, None, :], 6, axis=-1)
        sh1c, sc1c, ga1c, sh2c, sc2c, ga2c = jnp.split(mod_c, 6, axis=-1)
        h = rms_norm(x, g_norm_mix[l]) * (1.0 + sc1) + sh1
        hc = rms_norm(xc, g_norm_mix[l]) * (1.0 + sc1c) + sh1c
        lam_init = 0.8 - 0.6 * math.exp(-0.3 * l)
        lam = (jnp.exp(jnp.sum(diff_lambda_q1[l].astype(f32) * diff_lambda_k1[l].astype(f32)))
               - jnp.exp(jnp.sum(diff_lambda_q2[l].astype(f32) * diff_lambda_k2[l].astype(f32))) + lam_init)
        lg_f = jax.nn.log_sigmoid(ret_decay_fwd[l].astype(f32))
        lg_b = jax.nn.log_sigmoid(ret_decay_bwd[l].astype(f32))
        mix, mix_c = hybrid_mixer(h, hc, w_in[l], lg_f, lg_b, lam, lam_init, diff_subln_g[l], gqa_sink[l],
                                  w_branch[l], w_out[l], ropes, need_ctx)
        x = x + ga1 * mix
        h = (rms_norm(x, g_norm_ffn[l]) * (1.0 + sc2) + sh2).reshape(B * S, D)
        moe_args = (w_router[l], b_router[l], w_gate_up[l], b_gate_up[l], w_down[l], b_down[l])
        if need_ctx:
            xc = xc + ga1c * mix_c
            n_c = xc.shape[1]
            hc = (rms_norm(xc, g_norm_ffn[l]) * (1.0 + sc2c) + sh2c).reshape(B * n_c, D)
            y = moe_ffn(jnp.concatenate([h, hc], axis=0), *moe_args)
            x = x + ga2 * y[:B * S].reshape(B, S, D)
            xc = xc + ga2c * y[B * S:].reshape(B, n_c, D)
        else:
            x = x + ga2 * moe_ffn(h, *moe_args).reshape(B, S, D)
    return rms_norm(x, g_final)
```

```cpp
#include <hip/hip_runtime.h>
#include <cstdio>
#include <cstdint>

#define LAS __attribute__((address_space(3)))
#define GAS __attribute__((address_space(1)))
typedef unsigned short bf16_t;
typedef short bf16x8 __attribute__((ext_vector_type(8)));
typedef short s16x4 __attribute__((ext_vector_type(4)));
typedef float f32x2 __attribute__((ext_vector_type(2)));
typedef float f32x4 __attribute__((ext_vector_type(4)));
typedef float f32x16 __attribute__((ext_vector_type(16)));
typedef unsigned u32x2 __attribute__((ext_vector_type(2)));
typedef unsigned u32x4 __attribute__((ext_vector_type(4)));
typedef int v4i32 __attribute__((ext_vector_type(4)));
typedef int v8i32 __attribute__((ext_vector_type(8)));

#ifndef WIN_FP8
#define WIN_FP8 1
#endif
#ifndef BR_FP8
#define BR_FP8 0
#endif
#ifndef DUP_MASK
#define DUP_MASK 0
#endif
#ifndef MK_MULTI
#define MK_MULTI 0
#endif

constexpr int D = 1024, NB = 4, SEQ = 4096, DEPTH = 4, CTXL = 256;
constexpr int TL = NB * SEQ, TC = NB * CTXL, TT = TL + TC;
constexpr int DIN = 8448;
constexpr int C_RQ = 0, C_RK = 512, C_RV = 1024, C_RG = 2048, C_DQ = 3072, C_DK = 3584, C_DV = 4096, C_GQ = 4608, C_GKV = 5120, C_GATE = 5376;
constexpr int NEXP = 32, TOPK = 4, NASG = TT * TOPK;
constexpr int SLOT_TILES = 304, NSLOT = SLOT_TILES * 256;
constexpr int NCHUNK = 34;
constexpr float NORM_EPS = 1e-6f;
constexpr float LOG2E = 1.4426950408889634f;

constexpr size_t al256(size_t x) { return (x + 255) & ~(size_t)255; }
constexpr size_t WS_CTL = 0, CTL_ZERO_BYTES = 1u << 20;
constexpr size_t WS_MOD = CTL_ZERO_BYTES;
constexpr size_t WS_ROPE128 = al256(WS_MOD + (size_t)DEPTH * 5 * 6144 * 4);
constexpr size_t WS_ROPE64 = al256(WS_ROPE128 + 64 * 32 * 8);
constexpr size_t WS_DEC = al256(WS_ROPE64 + 64 * 16 * 8);
constexpr size_t WS_XRES = al256(WS_DEC + 1024);
constexpr size_t WS_H = al256(WS_XRES + (size_t)TT * D * 4);
constexpr size_t WS_P = al256(WS_H + (size_t)TT * D * 2);
constexpr size_t WS_KDF = al256(WS_P + (size_t)TT * DIN * 2);
constexpr size_t WS_KDB = al256(WS_KDF + (size_t)TT * 512 * 2);
constexpr size_t WS_ST = al256(WS_KDB + (size_t)TT * 512 * 2);
constexpr size_t WS_Y = al256(WS_ST + (size_t)NB * 4 * 2 * NCHUNK * 256 * 128 * 2);
constexpr size_t WS_MG = al256(WS_Y + (size_t)TT * 2048 * 2);
constexpr size_t WS_MGB = al256(WS_MG + (size_t)TT * D * 4);
constexpr size_t WS_ACT = al256(WS_MGB + (size_t)TT * D * 2);
constexpr size_t WS_YK = al256(WS_ACT + (size_t)NSLOT * D * 2);
constexpr size_t WS_LIST = al256(WS_YK + (size_t)NASG * D * 2);
constexpr size_t WS_TW = al256(WS_LIST + (size_t)NEXP * TT * 4);
constexpr size_t WS_WIN = al256(WS_TW + (size_t)NASG * 4);
constexpr size_t WS_WBR = al256(WS_WIN + (size_t)DEPTH * DIN * D * 2);
constexpr size_t WS_WOUT = al256(WS_WBR + (size_t)DEPTH * D * 2048 * 2);
constexpr size_t WS_WGU = al256(WS_WOUT + (size_t)DEPTH * D * D * 2);
constexpr size_t WS_WDN = al256(WS_WGU + (size_t)DEPTH * NEXP * 2048 * D * 2);
constexpr size_t WS_WRT = al256(WS_WDN + (size_t)DEPTH * NEXP * D * D * 2);
constexpr size_t WS_END = al256(WS_WRT + (size_t)DEPTH * 2 * NEXP * D * 2);
constexpr int CW_BAR = 4096;
constexpr int CW_CNT = 8192;

constexpr int LDS_MAIN = 139264;
constexpr int LDS_MISC = LDS_MAIN;
constexpr int LDS_BYTES = LDS_MAIN + 256;
constexpr int NTHR = 512;

typedef __bf16 bf16x2_t __attribute__((ext_vector_type(2)));
__device__ __forceinline__ unsigned cvt_pk_bf16(float lo, float hi) { const f32x2 v = {lo, hi}; return __builtin_bit_cast(unsigned, __builtin_convertvector(v, bf16x2_t)); }
__device__ __forceinline__ unsigned pk_fp8x4(float a, float b, float c, float d) { unsigned w = 0u; w = __builtin_amdgcn_cvt_pk_fp8_f32(a, b, w, false); w = __builtin_amdgcn_cvt_pk_fp8_f32(c, d, w, true); return w; }
__device__ __forceinline__ float bf2f(unsigned short x) { return __builtin_bit_cast(float, (unsigned)x << 16); }
__device__ __forceinline__ float bflo(unsigned x) { return __builtin_bit_cast(float, x << 16); }
__device__ __forceinline__ float bfhi(unsigned x) { return __builtin_bit_cast(float, x & 0xffff0000u); }
__device__ __forceinline__ float fexp2(float x) { return __builtin_amdgcn_exp2f(x); }
__device__ __forceinline__ float frcp(float x) { return __builtin_amdgcn_rcpf(x); }
__device__ __forceinline__ float sigmoidf_(float x) { return frcp(1.f + fexp2(-x * LOG2E)); }
template <int CTRL> __device__ __forceinline__ float dpp_f(float v) { return __builtin_bit_cast(float, __builtin_amdgcn_update_dpp(0, __builtin_bit_cast(int, v), CTRL, 0xf, 0xf, false)); }
__device__ __forceinline__ f32x2 halves(float v) {
    unsigned va = __builtin_bit_cast(unsigned, v), vb = va;
    asm volatile("v_nop\n\tv_nop\n\tv_permlane32_swap_b32 %0, %1" : "+v"(va), "+v"(vb));
    return (f32x2){__builtin_bit_cast(float, va), __builtin_bit_cast(float, vb)}; }
__device__ __forceinline__ float xsum(float v) { const f32x2 h = halves(v); return h.x + h.y; }
__device__ __forceinline__ float xmax(float v) { const f32x2 h = halves(v); return fmaxf(h.x, h.y); }
__device__ __forceinline__ int lane_now() { int l; asm volatile("v_mbcnt_lo_u32_b32 %0, -1, 0\n\tv_mbcnt_hi_u32_b32 %0, -1, %0" : "=v"(l)); return l; }
__device__ __forceinline__ int tid_now(int wave) { return (wave << 6) | lane_now(); }
__device__ __forceinline__ int opaque_lane() { int l = lane_now(); asm volatile("" : "+v"(l)); return l; }
__device__ __forceinline__ float shx(float v, int mask, int lane) { return __builtin_bit_cast(float, __builtin_amdgcn_ds_bpermute((lane ^ mask) << 2, __builtin_bit_cast(int, v))); }
__device__ __forceinline__ float xother(float v, int) { return shx(v, 32, opaque_lane()); }
__device__ __forceinline__ float wave_sum(float v) {
    const int l = opaque_lane();
#pragma unroll
    for (int o = 1; o < 64; o <<= 1) v += shx(v, o, l);
    return v;
}
#define XB_TMO      128
#define XB_XCNT(j)  (256  + 64 * (j))
#define XB_XSUB(j)  (1280 + 64 * (j))
#define XB_XGEN(j)  (2304 + 64 * (j))
#define XB_TOP      3328
#define XB_TOPGEN   3392
#define XCD_BAR_WORDS 3456
#define XB_SPIN_CAP (1u << 27)
__device__ __forceinline__ unsigned xb_ld(unsigned* p)              { return __hip_atomic_load(p, __ATOMIC_RELAXED, __HIP_MEMORY_SCOPE_AGENT); }
__device__ __forceinline__ unsigned xb_add(unsigned* p, unsigned v) { return __hip_atomic_fetch_add(p, v, __ATOMIC_RELAXED, __HIP_MEMORY_SCOPE_AGENT); }
__device__ __forceinline__ unsigned xb_xcc_id() { return (unsigned)__builtin_amdgcn_s_getreg((3 << 11) | 20) & 0xFu; }
#define XB_SPIN(cond, bar) do { unsigned _sp = 0; while (cond) { __builtin_amdgcn_s_sleep(1); \
    if ((++_sp & 255u) == 0u) { if (xb_ld(&(bar)[XB_TMO])) break; if (_sp > XB_SPIN_CAP) { atomicAdd(&(bar)[XB_TMO], 1u); break; } } } } while (0)
extern __shared__ __attribute__((aligned(16))) unsigned char lds_dyn_base[];
struct XcdBarrier { unsigned* bar; unsigned x; int wv; };
#define XB_ST ((volatile LAS unsigned*)((LAS unsigned char*)lds_dyn_base + LDS_MISC))
__device__ __forceinline__ XcdBarrier xcd_barrier_post(unsigned* bar, volatile LAS unsigned* st) {
    XcdBarrier b; b.bar = bar; b.x = xb_xcc_id(); b.wv = 0; (void)st;
    if (threadIdx.x == 0) (void)xb_add(&bar[XB_XCNT(b.x)], 1u);
    return b;
}
__device__ __forceinline__ void xcd_barrier_complete(unsigned* bar, unsigned x, unsigned& nloc, unsigned& nx) {
    const unsigned G = gridDim.x * gridDim.y * gridDim.z;
    unsigned sum, cnt, mine, sp = 0u;
    for (;;) {
        sum = 0u; cnt = 0u; mine = 0u;
#pragma unroll
        for (unsigned j = 0; j < 16; ++j) { const unsigned c = xb_ld(&bar[XB_XCNT(j)]); sum += c; cnt += (c > 0u) ? 1u : 0u; mine = (j == x) ? c : mine; }
        if (sum == G) break;
        __builtin_amdgcn_s_sleep(1);
        if ((++sp & 255u) == 0u) { if (xb_ld(&bar[XB_TMO])) break; if (sp > XB_SPIN_CAP) { atomicAdd(&bar[XB_TMO], 1u); break; } }
    }
    nloc = mine > 0u ? mine : 1u; nx = cnt > 0u ? cnt : 1u;
}
__device__ __forceinline__ void xcd_barrier(const XcdBarrier& b) {
    asm volatile("s_waitcnt vmcnt(0)" ::: "memory");
    __syncthreads();
    if (b.wv == 0 && lane_now() == 0) {
        unsigned* bar = b.bar;
        __builtin_amdgcn_s_waitcnt(0);
        unsigned nloc = XB_ST[0], nx = XB_ST[1];
        if (nloc == 0u) { xcd_barrier_complete(bar, b.x, nloc, nx); XB_ST[0] = nloc; XB_ST[1] = nx; }
        const unsigned old = xb_add(&bar[XB_XSUB(b.x)], 1u);
        const unsigned gen = old / nloc;
        if (old + 1u == (gen + 1u) * nloc) {
            __builtin_amdgcn_fence(__ATOMIC_RELEASE, "agent");
            asm volatile("s_waitcnt vmcnt(0)" ::: "memory");
            const unsigned og = xb_add(&bar[XB_TOP], 1u);
            const unsigned tg = og / nx;
            if (og + 1u == (tg + 1u) * nx) xb_add(&bar[XB_TOPGEN], 1u);
            else XB_SPIN(xb_ld(&bar[XB_TOPGEN]) == tg, bar);
            __builtin_amdgcn_fence(__ATOMIC_ACQUIRE, "agent");
            xb_add(&bar[XB_XGEN(b.x)], 1u);
            asm volatile("s_waitcnt vmcnt(0)" ::: "memory");
        } else {
            XB_SPIN(xb_ld(&bar[XB_XGEN(b.x)]) == gen, bar);
            __builtin_amdgcn_fence(__ATOMIC_ACQUIRE, "agent");
            asm volatile("s_waitcnt vmcnt(0)" ::: "memory");
        }
    }
    __syncthreads();
}

template <class T> __device__ __forceinline__ T* pin(T* p_) { const unsigned long long v_ = (unsigned long long)p_;
    return (T*)(((unsigned long long)(unsigned)__builtin_amdgcn_readfirstlane((int)(unsigned)(v_ >> 32)) << 32) | (unsigned)__builtin_amdgcn_readfirstlane((int)(unsigned)v_)); }
namespace gm {
constexpr int BM = 256, BK = 64, HALF = 128, HTB = HALF * BK * 2, STAGE_BYTES = 8 * HTB;
__device__ __forceinline__ int lds_byte(int r, int c) { const int st = (r >> 4) * 2 + (c >> 5), rr = r & 15, cc = c & 31, ob = rr * 64 + cc * 2; return st * 1024 + (ob ^ (((ob >> 9) & 1) << 5)); }
__device__ __forceinline__ void stage_rc(int b, int& R, int& C) { const int st = b / 1024, sb = b % 1024, swz = sb ^ (((sb >> 9) & 1) << 5); R = (st >> 1) * 16 + swz / 64; C = (st & 1) * 32 + (swz % 64) / 2; }
__device__ __forceinline__ int perm32(int rho) { const int n = rho >> 4, i = rho & 15; return 8 * (i >> 2) + 4 * n + (i & 3); }

struct GU {
    unsigned A;
    unsigned B;
    int nt;
    int pm, pn, e0, e1;
};

template <class Epi, class Sched, bool GATHER, bool FP8 = false>
__device__ __forceinline__ void gemm_phase(LAS unsigned char* lds, const Sched& S, const Epi& E, const int lda, const int ldb, const int wv) {
    int tid_ = tid_now(wv); asm volatile("" : "+v"(tid_));
    const int tid = tid_, wid = __builtin_amdgcn_readfirstlane(tid >> 6), lane = tid & 63, wr = wid >> 2, wc = wid & 3, fr = lane & 15, fq = lane >> 4;
    int sR[2], sC[2];
    unsigned voffB[2], cvA[2][2], nvA[2][2];
#pragma unroll
    for (int i = 0; i < 2; ++i) { stage_rc(tid * 16 + i * 8192, sR[i], sC[i]); const int Rb = (sR[i] & ~31) + perm32(sR[i] & 31);
        voffB[i] = (unsigned)(Rb * ldb + sC[i] * 2); cvA[0][i] = (unsigned)(sR[i] * lda + sC[i] * 2); cvA[1][i] = cvA[0][i]; nvA[0][i] = cvA[0][i]; nvA[1][i] = cvA[0][i]; }
    const unsigned kstep = (unsigned)(BK * 2);
    const unsigned hstepB = (unsigned)(HALF * ldb), hstepA = GATHER ? 0u : (unsigned)(HALF * lda);
    const unsigned ldsw = (unsigned)wid * 1024u;
    const int aoff = lds_byte(wr * 64 + fr, fq * (FP8 ? 16 : 8)), boff = lds_byte(wc * 32 + fr, fq * (FP8 ? 16 : 8));
    auto rfl64 = [](const char* p_) { const unsigned long long v_ = (unsigned long long)p_; return (const char*)(((unsigned long long)(unsigned)__builtin_amdgcn_readfirstlane((int)(unsigned)(v_ >> 32)) << 32) | (unsigned)__builtin_amdgcn_readfirstlane((int)(unsigned)v_)); };
    const char* const baseA = rfl64(S.baseA()); const char* const baseB = rfl64(S.baseB());
    int nr_, fl_; asm volatile("s_mov_b32 %0, 0x7fffffff\n\ts_mov_b32 %1, 0x20000" : "=s"(nr_), "=s"(fl_));
    const __amdgpu_buffer_rsrc_t rsA = __builtin_amdgcn_make_buffer_rsrc((void*)baseA, 0, nr_, fl_), rsB = __builtin_amdgcn_make_buffer_rsrc((void*)baseB, 0, nr_, fl_);
#define G_SA(b, h) (((b) * 2 + (h)) * HTB)
#define G_SB(b, h) ((4 + (b) * 2 + (h)) * HTB)
#define G_STAGE2(bufoff, rs, so, o0, o1) do { \
        __builtin_amdgcn_raw_ptr_buffer_load_lds(rs, (LAS void*)(lds + (bufoff) + ldsw), 16, (int)(o0), (int)(so), 0, 0); \
        __builtin_amdgcn_raw_ptr_buffer_load_lds(rs, (LAS void*)(lds + (bufoff) + ldsw + 8192), 16, (int)(o1), (int)(so), 0, 0); } while (0)
#define G_STB(bufoff, so) G_STAGE2(bufoff, rsB, so, voffB[0], voffB[1])
#define G_STA(bufoff, so, h, o0, o1) G_STAGE2(bufoff, rsA, (so) + (h) * hstepA, o0, o1)
#define G_LD16(off_) (*(const LAS v4i32*)(lds + (off_)))
#define G_LDA(dst, b, h) do { if constexpr (FP8) { LAS unsigned char* pa_ = lds + G_SA(b, h) + aoff; asm volatile("" : "+v"(pa_));   \
            _Pragma("unroll") for (int m = 0; m < 4; ++m) dst##8[m] = __builtin_shufflevector(*(const LAS v4i32*)(pa_ + m * 2048), *(const LAS v4i32*)(pa_ + m * 2048 + 16), 0, 1, 2, 3, 4, 5, 6, 7); } \
        else { _Pragma("unroll") for (int m = 0; m < 4; ++m) _Pragma("unroll") for (int k = 0; k < 2; ++k) dst[m][k] = *(const LAS bf16x8*)(lds + G_SA(b, h) + aoff + m * 2048 + k * 1024); } } while (0)
#define G_LDB(dst, b, h) do { if constexpr (FP8) { LAS unsigned char* pb_ = lds + G_SB(b, h) + boff; asm volatile("" : "+v"(pb_)); \
            _Pragma("unroll") for (int n = 0; n < 2; ++n) dst##8[n] = __builtin_shufflevector(*(const LAS v4i32*)(pb_ + n * 2048), *(const LAS v4i32*)(pb_ + n * 2048 + 16), 0, 1, 2, 3, 4, 5, 6, 7); } \
        else { _Pragma("unroll") for (int n = 0; n < 2; ++n) _Pragma("unroll") for (int k = 0; k < 2; ++k) dst[n][k] = *(const LAS bf16x8*)(lds + G_SB(b, h) + boff + n * 2048 + k * 1024); } } while (0)
#define G_MMA(ai, bj, At, Bt) do { __builtin_amdgcn_s_setprio(1); \
        if constexpr (FP8) { _Pragma("unroll") for (int m = 0; m < 4; ++m) _Pragma("unroll") for (int n = 0; n < 2; ++n) \
            acc[ai][bj][m][n] = __builtin_amdgcn_mfma_scale_f32_16x16x128_f8f6f4(Bt##8[n], At##8[m], acc[ai][bj][m][n], 0, 0, 0, 0x7F7F7F7F, 0, 0x7F7F7F7F); } \
        else { _Pragma("unroll") for (int m = 0; m < 4; ++m) _Pragma("unroll") for (int n = 0; n < 2; ++n) _Pragma("unroll") for (int k = 0; k < 2; ++k) \
            acc[ai][bj][m][n] = __builtin_amdgcn_mfma_f32_16x16x32_bf16(Bt[n][k], At[m][k], acc[ai][bj][m][n], 0, 0, 0); } \
        __builtin_amdgcn_s_setprio(0); } while (0)
#define G_WAIT_V(n) asm volatile("s_waitcnt vmcnt(" #n ")" ::: "memory")
#define G_WAIT_L(n) asm volatile("s_waitcnt lgkmcnt(" #n ")" ::: "memory")
#define G_BAR __builtin_amdgcn_s_barrier()
#define G_SCHED __builtin_amdgcn_sched_barrier(0)
    GU cur, nxt; int ui = 0;
    if (!S.next(0, cur)) return;
    if constexpr (GATHER) { S.gather(cur, cvA); }
    S.a_ready(cur);
    f32x4 acc[2][2][4][2];
#pragma unroll
    for (int a = 0; a < 2; ++a)
#pragma unroll
        for (int b = 0; b < 2; ++b)
#pragma unroll
            for (int m = 0; m < 4; ++m)
#pragma unroll
                for (int n = 0; n < 2; ++n) acc[a][b][m][n] = (f32x4){0.f, 0.f, 0.f, 0.f};
    bf16x8 At[4][2], B0[2][2], B1[2][2];
    v8i32 At8[4], B08[2], B18[2];
    (void)At; (void)B0; (void)B1; (void)At8; (void)B08; (void)B18;
    unsigned cA = (unsigned)__builtin_amdgcn_readfirstlane((int)cur.A), cB = (unsigned)__builtin_amdgcn_readfirstlane((int)cur.B);
    G_STB(G_SB(0, 0), cB); G_STB(G_SB(0, 1), cB + hstepB); G_STA(G_SA(0, 0), cA, 0, cvA[0][0], cvA[0][1]); G_STA(G_SA(0, 1), cA, 1, cvA[1][0], cvA[1][1]);
    if (wr == 1) G_BAR;
    G_WAIT_V(2); G_BAR;
    G_STB(G_SB(1, 0), cB + kstep); G_STA(G_SA(1, 0), cA + kstep, 0, cvA[0][0], cvA[0][1]); G_STB(G_SB(1, 1), cB + hstepB + kstep);
    G_WAIT_V(6); G_BAR;
    for (;;) {
        const bool has_next = S.next(ui + 1, nxt);
        if (has_next) { if constexpr (GATHER) S.gather(nxt, nvA); }
        const unsigned nA = (unsigned)__builtin_amdgcn_readfirstlane((int)(has_next ? nxt.A : cA)), nB = (unsigned)__builtin_amdgcn_readfirstlane((int)(has_next ? nxt.B : cB));
        int nt = cur.nt; asm volatile("" : "+s"(nt));
#pragma unroll 1
        for (int t = 0; t < nt; t += 2) {
            const bool last = (t == nt - 2);
            const int km = ((DUP_MASK & 16384) && Epi::DUPK) ? (nt >> 1) - 1 : 0x7fff;
            const unsigned a1 = cA + (unsigned)((t + 1) & km) * kstep;
            const unsigned a2 = last ? nA : cA + (unsigned)((t + 2) & km) * kstep, b2 = last ? nB : cB + (unsigned)((t + 2) & km) * kstep;
            const unsigned a3 = a2 + kstep, b3 = b2 + kstep;
            unsigned x00, x01, x10, x11;
            if (last && has_next) S.a_ready(nxt);
            if (GATHER && last && has_next) { x00 = nvA[0][0]; x01 = nvA[0][1]; x10 = nvA[1][0]; x11 = nvA[1][1]; } else { x00 = cvA[0][0]; x01 = cvA[0][1]; x10 = cvA[1][0]; x11 = cvA[1][1]; }
            G_LDB(B0, 0, 0); G_LDB(B1, 0, 1); G_SCHED; G_LDA(At, 0, 0); G_STA(G_SA(1, 1), a1, 1, cvA[1][0], cvA[1][1]);
            G_WAIT_V(8); G_WAIT_L(0); G_BAR; G_MMA(0, 0, At, B0); G_MMA(0, 1, At, B1); G_BAR; G_SCHED;
            G_LDA(At, 0, 1); G_STB(G_SB(0, 0), b2); G_STB(G_SB(0, 1), b2 + hstepB); G_STA(G_SA(0, 0), a2, 0, x00, x01);
            G_WAIT_V(8); G_WAIT_L(0); G_BAR; G_MMA(1, 0, At, B0); G_MMA(1, 1, At, B1); G_BAR; G_SCHED;
            G_LDB(B0, 1, 0); G_LDB(B1, 1, 1); G_SCHED; G_LDA(At, 1, 0); G_STA(G_SA(0, 1), a2, 1, x10, x11);
            G_WAIT_V(8); G_WAIT_L(0); G_BAR; G_MMA(0, 0, At, B0); G_MMA(0, 1, At, B1); G_BAR; G_SCHED;
            G_LDA(At, 1, 1); G_STB(G_SB(1, 0), b3); G_STB(G_SB(1, 1), b3 + hstepB); G_STA(G_SA(1, 0), a3, 0, x00, x01);
            G_WAIT_V(8); G_WAIT_L(0); G_BAR; G_MMA(1, 0, At, B0); G_MMA(1, 1, At, B1); G_BAR; G_SCHED;
        }
        if (wr == 0) G_BAR;
        { int t2_ = lane_now(); asm volatile("" : "+v"(t2_)); const int fr_ = t2_ & 15, fq_ = (t2_ & 63) >> 4; E(acc, cur, wr, wc, fr_, fq_);
          if (Epi::DUPE) { asm volatile("" : "+v"(t2_)); const int fr2_ = t2_ & 15, fq2_ = (t2_ & 63) >> 4; E(acc, cur, wr, wc, fr2_, fq2_); } }
        S.done(cur);
        if (!has_next) break;
        if (!(Epi::CHAIN && cur.e1)) {
#pragma unroll
        for (int a = 0; a < 2; ++a)
#pragma unroll
            for (int b = 0; b < 2; ++b)
#pragma unroll
                for (int m = 0; m < 4; ++m)
#pragma unroll
                    for (int n = 0; n < 2; ++n) acc[a][b][m][n] = (f32x4){0.f, 0.f, 0.f, 0.f};
        }
        cur = nxt; cA = nA; cB = nB; ++ui;
        if constexpr (GATHER) {
#pragma unroll
            for (int h = 0; h < 2; ++h)
#pragma unroll
                for (int i = 0; i < 2; ++i) cvA[h][i] = nvA[h][i];
        }
        if (wr == 1) G_BAR;
    }
    G_WAIT_V(0);
    G_BAR;
#undef G_SA
#undef G_SB
#undef G_STAGE2
#undef G_STB
#undef G_STA
#undef G_LDA
#undef G_LDB
#undef G_MMA
#undef G_WAIT_V
#undef G_WAIT_L
#undef G_BAR
#undef G_SCHED
}
}

struct Frame {
    LAS unsigned char* lds;
    int tid, lane, wave, G, bid;
    unsigned char* ws;
    unsigned* ctl;
    const float* const* in;
    float* out;
};
enum { I_X = 0, I_C, I_CTX, I_CCTX, I_WMOD, I_BMOD, I_GMIX, I_GFFN, I_WIN, I_RDF, I_RDB, I_LQ1, I_LK1, I_LQ2, I_LK2, I_SUBLN, I_SINK, I_WBR, I_WOUT, I_WR, I_BR, I_WGU, I_BGU, I_WDN, I_BDN, I_GFIN };

__device__ __forceinline__ int row_modv(int row) { return row < TL ? (row >> 12) : 4; }
__device__ __forceinline__ const float* modp(const Frame& F, int l, int v, int part) { return (const float*)(F.ws + WS_MOD) + ((size_t)(l * 5 + v) * 6 + part) * 1024; }

__device__ __forceinline__ unsigned swz(unsigned r) { return ((r & 3u) << 2) | ((r >> 2) & 3u); }
__device__ __forceinline__ unsigned img_off(unsigned row, unsigned ch) { return 256u * row + 16u * (ch ^ swz(row)); }
__device__ __forceinline__ void dma4(LAS unsigned char* img, int idx, const char* g0, unsigned stride, int lane) {
    const unsigned q4 = (unsigned)lane >> 4, ch = (((unsigned)lane & 15u) ^ (q4 << 2)) ^ ((unsigned)idx & 3u);
    __builtin_amdgcn_global_load_lds((const unsigned*)(g0 + (q4 * stride + 16u * ch)), (LAS unsigned*)(img + 1024u * (unsigned)idx), 16, 0, 0);
}
#define DMA4(img, idx, ROWPTR) dma4((img), (idx), (const char*)(ROWPTR(4 * (idx))), DIN * 2, dl)
#define DMA4S(img, idx, ROWPTR, stride) dma4((img), (idx), (const char*)(ROWPTR(4 * (idx))), (stride), dl)
#define DMA_LANE() int dl = lane; asm volatile("" : "+v"(dl))
struct LA { unsigned rowb, trn, trp; };
__device__ __forceinline__ LA make_la(int lane) {
    const unsigned r32 = lane & 31, hh = (unsigned)lane >> 5, blk = ((unsigned)lane >> 4) & 1u, q = ((unsigned)lane & 15u) >> 2, p = (unsigned)lane & 3u;
    LA a; a.rowb = 256u * r32 + 16u * swz(r32);
    a.trn = 256u * (8u * hh + q) + 16u * ((2u * blk + (p >> 1)) ^ ((q << 2) | (2u * hh))) + 8u * (p & 1u);
    a.trp = 256u * (4u * hh + q) + 16u * ((2u * blk + (p >> 1)) ^ ((q << 2) | hh)) + 8u * (p & 1u);
    return a;
}
#define OPAQUE(x) asm volatile("" : "+v"(x))
__device__ __forceinline__ bf16x8 frag_row(LAS unsigned char* img, unsigned rowb, unsigned R0, unsigned ch) { return *(const LAS bf16x8*)(img + 256u * R0 + (rowb ^ (16u * ch))); }
__device__ __forceinline__ s16x4 tr4(LAS unsigned char* p) { return __builtin_bit_cast(s16x4, __builtin_amdgcn_ds_read_tr16_b64_v4i16((LAS s16x4*)p)); }
__device__ __forceinline__ bf16x8 frag_trn(LAS unsigned char* img, unsigned trn, unsigned R0, unsigned c, unsigned cb0) {
    const s16x4 lo = tr4(img + 256u * R0 + (trn ^ (16u * (cb0 + 4u * c)))), hi = tr4(img + 256u * (R0 + 4u) + (trn ^ (16u * ((cb0 + 4u * c) ^ 1u))));
    return (bf16x8){lo[0], lo[1], lo[2], lo[3], hi[0], hi[1], hi[2], hi[3]};
}
__device__ __forceinline__ bf16x8 frag_trp(LAS unsigned char* img, unsigned trp, unsigned R0, unsigned c, unsigned cb0) {
    const s16x4 lo = tr4(img + 256u * R0 + (trp ^ (16u * (cb0 + 4u * c)))), hi = tr4(img + 256u * (R0 + 8u) + (trp ^ (16u * ((cb0 + 4u * c) ^ 2u))));
    return (bf16x8){lo[0], lo[1], lo[2], lo[3], hi[0], hi[1], hi[2], hi[3]};
}
__device__ __forceinline__ bf16x8 pack8(const f32x16& v, int o) {
    u32x4 w; w.x = cvt_pk_bf16(v[o], v[o + 1]); w.y = cvt_pk_bf16(v[o + 2], v[o + 3]); w.z = cvt_pk_bf16(v[o + 4], v[o + 5]); w.w = cvt_pk_bf16(v[o + 6], v[o + 7]);
    return __builtin_bit_cast(bf16x8, w);
}
__device__ __forceinline__ int crow(int r, int hh) { return (r & 3) + 8 * (r >> 2) + 4 * hh; }
#define MFMA32(a, b, c) __builtin_amdgcn_mfma_f32_32x32x16_bf16((a), (b), (c), 0, 0, 0)
#define VMWAIT0() asm volatile("s_waitcnt vmcnt(0)" ::: "memory")

template <int MAP>
__device__ __forceinline__ int rowmap(int n) {
    if (MAP == 1) {
        if (n < 1024) { const int i = n & 127; return (n & ~127) + (i < 64 ? 2 * i : 2 * (i - 64) + 1); }
        if ((n >= C_DQ && n < C_DV) || (n >= C_GQ && n < C_GKV)) { const int i = n & 63; return (n & ~63) + (i < 32 ? 2 * i : 2 * (i - 32) + 1); }
        if (n >= C_GKV && n < C_GKV + 128) { const int kvh = (n - C_GKV) >> 6, i = n & 63; return C_GKV + kvh * 128 + (i < 32 ? 2 * i : 2 * (i - 32) + 1); }
        if (n >= C_GKV + 128 && n < C_GATE) { const int kvh = (n - C_GKV - 128) >> 6, i = n & 63; return C_GKV + kvh * 128 + 64 + i; }
        return n;
    }
    if (MAP == 2) return n < 1024 ? 2 * n : 2 * (n - 1024) + 1;
    return n;
}
template <int MAP, bool OUT8 = false>
__device__ __forceinline__ void transpose_item(const float* W, int K, int N, bf16_t* WT, LAS float* scr, int item, int lane) {
    const int nblk = N / 64, kb = item / nblk, nb = item % nblk, k0 = 64 * kb, n0 = 64 * nb;
    const int lr = lane >> 4, lc = (lane & 15) * 4;
    f32x4 v[16];
#pragma unroll
    for (int i = 0; i < 16; ++i) v[i] = *(const f32x4*)(W + (size_t)(k0 + 4 * i + lr) * N + n0 + lc);
#pragma unroll
    for (int i = 0; i < 16; ++i) *(LAS f32x4*)(scr + (4 * i + lr) * 64 + (lc ^ (8 * ((i >> 1) & 3)))) = v[i];
    asm volatile("s_waitcnt lgkmcnt(0)" ::: "memory");
    const int c = lane & 7;
#pragma unroll
    for (int j = 0; j < 8; ++j) { const int n = (lane >> 3) + 8 * j; const LAS float* s_ = scr + (8 * c) * 64 + (n ^ (8 * (c & 3)));
        if constexpr (OUT8) {
            *(u32x2*)((unsigned char*)WT + (size_t)rowmap<MAP>(n0 + n) * K + k0 + 8 * c) = (u32x2){pk_fp8x4(s_[0 * 64] * 32.f, s_[1 * 64] * 32.f, s_[2 * 64] * 32.f, s_[3 * 64] * 32.f), pk_fp8x4(s_[4 * 64] * 32.f, s_[5 * 64] * 32.f, s_[6 * 64] * 32.f, s_[7 * 64] * 32.f)};
        } else {
        u32x4 o; o.x = cvt_pk_bf16(s_[0 * 64], s_[1 * 64]); o.y = cvt_pk_bf16(s_[2 * 64], s_[3 * 64]); o.z = cvt_pk_bf16(s_[4 * 64], s_[5 * 64]); o.w = cvt_pk_bf16(s_[6 * 64], s_[7 * 64]);
        *(u32x4*)(WT + (size_t)rowmap<MAP>(n0 + n) * K + k0 + 8 * c) = o; } }
    asm volatile("s_waitcnt lgkmcnt(0)" ::: "memory");
}
constexpr int CV_IN = 16 * (DIN / 64), CV_BRN = 32 * 16, CV_OUT = 16 * 16, CV_GU = 16 * 32, CV_DN = 16 * 16;
constexpr int CV_PER_L = CV_IN + CV_BRN + CV_OUT + NEXP * (CV_GU + CV_DN);
constexpr int CW_R1 = 8192 + 1024;
constexpr int CW_Q = 8192 + 512;
constexpr int CW_LONG = CW_Q + 64;
__device__ __forceinline__ void conv_item(Frame& F, int l, int r, LAS float* scr) {
    if (r < CV_IN) { if (WIN_FP8) transpose_item<1, true>(F.in[I_WIN] + (size_t)l * D * DIN, D, DIN, (bf16_t*)(F.ws + WS_WIN + (size_t)l * DIN * D), scr, r, F.lane);
        else transpose_item<1>(F.in[I_WIN] + (size_t)l * D * DIN, D, DIN, (bf16_t*)(F.ws + WS_WIN) + (size_t)l * DIN * D, scr, r, F.lane); return; } r -= CV_IN;
    if (r < CV_BRN) { if (BR_FP8) transpose_item<0, true>(F.in[I_WBR] + (size_t)l * 2048 * D, 2048, D, (bf16_t*)(F.ws + WS_WBR + (size_t)l * D * 2048), scr, r, F.lane);
        else transpose_item<0>(F.in[I_WBR] + (size_t)l * 2048 * D, 2048, D, (bf16_t*)(F.ws + WS_WBR) + (size_t)l * D * 2048, scr, r, F.lane); return; } r -= CV_BRN;
    if (r < CV_OUT) { if (BR_FP8) transpose_item<0, true>(F.in[I_WOUT] + (size_t)l * D * D, D, D, (bf16_t*)(F.ws + WS_WOUT + (size_t)l * D * D), scr, r, F.lane);
        else transpose_item<0>(F.in[I_WOUT] + (size_t)l * D * D, D, D, (bf16_t*)(F.ws + WS_WOUT) + (size_t)l * D * D, scr, r, F.lane); return; } r -= CV_OUT;
    const int e = r / (CV_GU + CV_DN); r %= (CV_GU + CV_DN);
    if (r < CV_GU) transpose_item<2, true>(F.in[I_WGU] + ((size_t)l * NEXP + e) * D * 2048, D, 2048, (bf16_t*)(F.ws + WS_WGU + ((size_t)l * NEXP + e) * 2048 * D), scr, r, F.lane);
    else transpose_item<0, true>(F.in[I_WDN] + ((size_t)l * NEXP + e) * D * D, D, D, (bf16_t*)(F.ws + WS_WDN + ((size_t)l * NEXP + e) * D * D), scr, r - CV_GU, F.lane);
}
__device__ __forceinline__ bool conv_chunk(Frame& F, int l, const unsigned* stop, unsigned stop_at) {
    volatile LAS int* slot = (volatile LAS int*)(F.lds + LDS_MISC + 64);
    __syncthreads();
    if (F.tid == 0) { int base = -1;
        if (!(stop && __hip_atomic_load(stop, __ATOMIC_RELAXED, __HIP_MEMORY_SCOPE_AGENT) >= stop_at)) { base = (int)__hip_atomic_fetch_add(F.ctl + CW_Q + l, 8u, __ATOMIC_RELAXED, __HIP_MEMORY_SCOPE_AGENT); if (base >= CV_PER_L) base = -1; }
        *slot = base; }
    __syncthreads();
    const int base = *slot;
    if (base < 0) return false;
    if (base + F.wave < CV_PER_L) conv_item(F, l, base + F.wave, (LAS float*)(F.lds + F.wave * 16384));
    return true;
}
__device__ __forceinline__ void p0_prologue(Frame& F) {
    const int gw = F.bid * 8 + F.wave, NGW = F.G * 8;
    {
        LAS float* sc = (LAS float*)F.lds;
        LAS float* red = sc + 5 * 1024;
        for (int i = F.tid; i < 5 * 1024; i += NTHR) { const int v = i >> 10, k = i & 1023; const float c = v < 4 ? F.in[I_C][v * 1024 + k] : F.in[I_CCTX][k]; sc[i] = c * sigmoidf_(c); }
        __syncthreads();
        for (int u = F.bid; u < DEPTH * 96; u += F.G) {
            const int l = u / 96, n0 = (u % 96) * 64;
            const float* W = F.in[I_WMOD] + (size_t)l * 1024 * 6144 + n0 + F.lane;
            float a0 = 0.f, a1 = 0.f, a2 = 0.f, a3 = 0.f, a4 = 0.f;
            const int kb = F.wave * 128;
#pragma unroll 8
            for (int k = 0; k < 128; ++k) { const float w = W[(size_t)(kb + k) * 6144];
                a0 += w * sc[kb + k]; a1 += w * sc[1024 + kb + k]; a2 += w * sc[2048 + kb + k]; a3 += w * sc[3072 + kb + k]; a4 += w * sc[4096 + kb + k]; }
            red[(F.wave * 5 + 0) * 64 + F.lane] = a0; red[(F.wave * 5 + 1) * 64 + F.lane] = a1; red[(F.wave * 5 + 2) * 64 + F.lane] = a2;
            red[(F.wave * 5 + 3) * 64 + F.lane] = a3; red[(F.wave * 5 + 4) * 64 + F.lane] = a4;
            __syncthreads();
            if (F.tid < 320) { const int v = F.tid >> 6, c = F.tid & 63; float s = F.in[I_BMOD][l * 6144 + n0 + c];
#pragma unroll
                for (int w = 0; w < 8; ++w) s += red[(w * 5 + v) * 64 + c];
                ((float*)(F.ws + WS_MOD))[(size_t)(l * 5 + v) * 6144 + n0 + c] = s; }
            __syncthreads();
        }
    }
    if (F.bid == 0) {
        for (int i = F.tid; i < 64 * 32; i += NTHR) { const int pos = i >> 5, j = i & 31; const float inv = powf(10000.f, -(float)j / 32.f), a = (float)pos * inv;
            ((f32x2*)(F.ws + WS_ROPE128))[i] = (f32x2){cosf(a), sinf(a)}; }
        for (int i = F.tid; i < 64 * 16; i += NTHR) { const int pos = i >> 4, j = i & 15; const float inv = powf(10000.f, -(float)j / 16.f), a = (float)pos * inv;
            ((f32x2*)(F.ws + WS_ROPE64))[i] = (f32x2){cosf(a), sinf(a)}; }
        if (F.tid < DEPTH * 8) { const int l = F.tid >> 3, dir = (F.tid >> 2) & 1, h = F.tid & 3; const float x = (dir ? F.in[I_RDB] : F.in[I_RDF])[l * 4 + h];
            const float ls = -log1pf(expf(-x));
            ((float*)(F.ws + WS_DEC))[F.tid] = ls * LOG2E; }
        if (F.tid >= 64 && F.tid < 64 + DEPTH) { const int l = F.tid - 64; float s1 = 0.f, s2 = 0.f;
            for (int i = 0; i < 64; ++i) { s1 += F.in[I_LQ1][l * 64 + i] * F.in[I_LK1][l * 64 + i]; s2 += F.in[I_LQ2][l * 64 + i] * F.in[I_LK2][l * 64 + i]; }
            const float lam_init = 0.8f - 0.6f * expf(-0.3f * (float)l);
            ((float*)(F.ws + WS_DEC))[32 + l] = expf(s1) - expf(s2) + lam_init; ((float*)(F.ws + WS_DEC))[40 + l] = lam_init; }
    }
    for (int i = F.bid * NTHR + F.tid; i < DEPTH * NEXP * D; i += F.G * NTHR) { const int l = i / (NEXP * D), e = (i / D) % NEXP, k = i % D;
        const float w = F.in[I_WR][((size_t)l * D + k) * NEXP + e]; const unsigned hi = cvt_pk_bf16(w, 0.f) & 0xffffu; const float lo = w - bf2f((unsigned short)hi);
        bf16_t* o = (bf16_t*)(F.ws + WS_WRT) + (size_t)l * 2 * NEXP * D; o[(size_t)e * D + k] = (bf16_t)hi; o[(size_t)(NEXP + e) * D + k] = (bf16_t)(cvt_pk_bf16(lo, 0.f) & 0xffffu); }
    __syncthreads();
    while (conv_chunk(F, 0, nullptr, 0u)) { }
}
struct Row16 { f32x4 v[4]; };
__device__ __forceinline__ Row16 ld_row_f32(const float* p, int lane) { Row16 r; const f32x4* q = (const f32x4*)p + lane;
#pragma unroll
    for (int j = 0; j < 4; ++j) r.v[j] = q[64 * j];
    return r; }
__device__ __forceinline__ void st_row_f32(float* p, int lane, const Row16& r) { f32x4* q = (f32x4*)p + lane;
#pragma unroll
    for (int j = 0; j < 4; ++j) q[64 * j] = r.v[j]; }
__device__ __forceinline__ void st_row_bf16(bf16_t* p, int lane, const Row16& r) { u32x2* q = (u32x2*)p + lane;
#pragma unroll
    for (int j = 0; j < 4; ++j) q[64 * j] = (u32x2){cvt_pk_bf16(r.v[j].x, r.v[j].y), cvt_pk_bf16(r.v[j].z, r.v[j].w)}; }
__device__ __forceinline__ float row_rstd(const Row16& r) { float s = 0.f;
#pragma unroll
    for (int j = 0; j < 4; ++j) s += (r.v[j].x * r.v[j].x + r.v[j].y * r.v[j].y) + (r.v[j].z * r.v[j].z + r.v[j].w * r.v[j].w);
    return 1.f / sqrtf(wave_sum(s) * (1.f / D) + NORM_EPS); }
__device__ __forceinline__ Row16 x_row_combined(const Frame& F, int l, int row) {
    if (l == 0) return ld_row_f32(row < TL ? F.in[I_X] + (size_t)row * D : F.in[I_CTX] + (size_t)(row - TL) * D, F.lane);
    Row16 x = ld_row_f32((const float*)(F.ws + WS_XRES) + (size_t)row * D, F.lane);
    const Row16 ga = ld_row_f32(modp(F, l - 1, row_modv(row), 5), F.lane);
    const u32x2* yk = (const u32x2*)(F.ws + WS_YK) + (size_t)row * 4 * (D / 4) + F.lane;
#pragma unroll
    for (int j = 0; j < 4; ++j) { f32x4 s = (f32x4){0.f, 0.f, 0.f, 0.f};
#pragma unroll
        for (int k = 0; k < 4; ++k) { const u32x2 w = yk[(size_t)k * (D / 4) + 64 * j]; s += (f32x4){bflo(w.x), bfhi(w.x), bflo(w.y), bfhi(w.y)}; }
        x.v[j] += ga.v[j] * s; }
    return x;
}
__device__ __forceinline__ void p_norm1(Frame& F, int l, bool dry = false) {
    const int gw = F.bid * 8 + F.wave, NGW = F.G * 8;
    const Row16 g = ld_row_f32(F.in[I_GMIX] + (size_t)l * D, F.lane);
    for (int row = gw; row < TT; row += NGW) {
        const Row16 x = x_row_combined(F, l, row);
        if (!dry) st_row_f32((float*)(F.ws + WS_XRES) + (size_t)row * D, F.lane, x);
        const float rs = row_rstd(x); const int v = row_modv(row);
        const Row16 sh = ld_row_f32(modp(F, l, v, 0), F.lane), sc = ld_row_f32(modp(F, l, v, 1), F.lane);
        Row16 h;
#pragma unroll
        for (int j = 0; j < 4; ++j) h.v[j] = x.v[j] * rs * g.v[j] * (sc.v[j] + 1.f) + sh.v[j];
        if (!WIN_FP8) st_row_bf16((bf16_t*)(F.ws + WS_H) + (size_t)row * D, F.lane, h);
        else { unsigned* h8 = (unsigned*)(F.ws + WS_H + (size_t)row * D) + F.lane;
#pragma unroll
          for (int j = 0; j < 4; ++j) h8[64 * j] = pk_fp8x4(h.v[j].x * 8.f, h.v[j].y * 8.f, h.v[j].z * 8.f, h.v[j].w * 8.f); }
    }
}
__device__ __forceinline__ void p_final(Frame& F) {
    const int gw = F.bid * 8 + F.wave, NGW = F.G * 8;
    const Row16 g = ld_row_f32(F.in[I_GFIN], F.lane);
    for (int row = gw; row < TL; row += NGW) {
        const Row16 x = x_row_combined(F, DEPTH, row);
        const float rs = row_rstd(x); Row16 o;
#pragma unroll
        for (int j = 0; j < 4; ++j) o.v[j] = x.v[j] * rs * g.v[j];
        st_row_f32(F.out + (size_t)row * D, F.lane, o);
    }
}

struct OrderMN {
    int nM, nN, nwg, G, c;
    __device__ __forceinline__ void init(int nM_, int nN_, int G_, int c_) { nM = nM_; nN = nN_; nwg = nM * nN; G = G_; c = c_; }
    __device__ __forceinline__ bool tile(int i, int& pm, int& pn) const {
        const long L = (long)i * G + c; if (L >= nwg) return false;
        int wgid = (int)L; { const int q = nwg / 8, r = nwg % 8, xcd = wgid % 8, off = wgid / 8; wgid = (xcd < r ? xcd * (q + 1) : r * (q + 1) + (xcd - r) * q) + off; }
        const int nig = 8 * nN, gid = wgid / nig, fm = gid * 8, gsz = (nM - fm) < 8 ? (nM - fm) : 8;
        pm = fm + ((wgid % nig) % gsz); pn = (wgid % nig) / gsz; return true;
    }
};
struct SchedPlain {
    __device__ __forceinline__ void a_ready(const gm::GU&) const {}
    __device__ __forceinline__ void done(const gm::GU&) const {}
    OrderMN o; const char* A; const char* B; int lda, ldb, nt; int dupk = 0;
    __device__ __forceinline__ const char* baseA() const { return A; }
    __device__ __forceinline__ const char* baseB() const { return B; }
    __device__ __forceinline__ bool next(int i, gm::GU& u) const { int pm, pn; const int j = i; if (!o.tile(j, pm, pn)) return false;
        u.A = (unsigned)(pm * 256 * lda); u.B = (unsigned)(pn * 256 * ldb); u.nt = dupk ? 2 * nt : nt; u.pm = pm; u.pn = pn; u.e0 = 0; u.e1 = 0; return true; }
};
struct EpiIn {
    static constexpr bool CHAIN = false; static constexpr bool DUPK = true; static constexpr bool DUPE = (DUP_MASK & 32768) != 0;
    bf16_t* P; const f32x4* rope128; const f32x4* rope64; float pre = 1.f;
    template <int MODE, int BJ>
    __device__ __forceinline__ void rows(const f32x4 (&acc)[2][2][4][2], const gm::GU& u, int wr, int fr, int ct, int cl, float scale) const {
        int j0 = 0, usecol = 0;
        if (MODE == 1) { const int i0 = cl >> 1; usecol = i0 >= 32; j0 = i0 & 31; } else if (MODE == 2) { const int i0 = (cl & 63) >> 1; usecol = i0 >= 16; j0 = i0 & 15; }
        f32x4 frq = {0.f, 0.f, 0.f, 0.f};
        if (MODE == 1 || MODE == 2) { const float lstep = (MODE == 1 ? -13.287712379549449f / 32.f : -13.287712379549449f / 16.f);
#pragma unroll
            for (int q = 0; q < 4; ++q) frq[q] = fexp2(lstep * (float)(j0 + q)) * 0.15915494309189535f; }
        const float sc = (WIN_FP8 ? scale * (1.f / 256.f) : scale) * pre;
#pragma unroll
        for (int ai = 0; ai < 2; ++ai)
#pragma unroll
            for (int m = 0; m < 4; ++m) {
                const int row = u.pm * 256 + ai * 128 + wr * 64 + m * 16 + fr;
                f32x4 v0 = acc[ai][BJ][m][0] * sc, v1 = acc[ai][BJ][m][1] * sc;
                if (MODE == 1 || MODE == 2) {
                    const int s = row & 4095; const float pos = (float)(usecol ? (s & 63) : (s >> 6));
                    f32x4 cs, sn;
#pragma unroll
                    for (int q = 0; q < 4; ++q) { const float rev = pos * frq[q]; cs[q] = __builtin_amdgcn_cosf(rev); sn[q] = __builtin_amdgcn_sinf(rev); }
                    f32x4 r0, r1;
                    r0.x = v0.x * cs[0] - v0.y * sn[0]; r0.y = v0.x * sn[0] + v0.y * cs[0]; r0.z = v0.z * cs[1] - v0.w * sn[1]; r0.w = v0.z * sn[1] + v0.w * cs[1];
                    r1.x = v1.x * cs[2] - v1.y * sn[2]; r1.y = v1.x * sn[2] + v1.y * cs[2]; r1.z = v1.z * cs[3] - v1.w * sn[3]; r1.w = v1.z * sn[3] + v1.w * cs[3];
                    v0 = r0; v1 = r1;
                }
                if (MODE == 3) {
#pragma unroll
                    for (int q = 0; q < 4; ++q) { v0[q] = v0[q] * sigmoidf_(v0[q]); v1[q] = v1[q] * sigmoidf_(v1[q]); }
                } else if (MODE == 4) {
#pragma unroll
                    for (int q = 0; q < 4; ++q) { v0[q] = sigmoidf_(v0[q]); v1[q] = sigmoidf_(v1[q]); }
                }
                u32x4 w; w.x = cvt_pk_bf16(v0[0], v0[1]); w.y = cvt_pk_bf16(v0[2], v0[3]); w.z = cvt_pk_bf16(v1[0], v1[1]); w.w = cvt_pk_bf16(v1[2], v1[3]);
                *(u32x4*)(P + (size_t)row * DIN + ct + cl) = w;
            }
    }
    template <int BJ>
    __device__ __forceinline__ void half(const f32x4 (&acc)[2][2][4][2], const gm::GU& u, int wr, int wc, int fr, int fq) const {
        const bool latent = u.pm < (TL / 256);
        const int ct = u.pn * 256 + BJ * 128;
        const int cl = wc * 32 + fq * 8;
        int mode = 0; float scale = 1.f;
        if (ct < C_RK) { mode = 1; scale = 0.08838834764831845f; }
        else if (ct < C_RV) mode = 1;
        else if (ct < C_RG) mode = 0;
        else if (ct < C_DQ) mode = 3;
        else if (ct < C_DK) { mode = 2; scale = 0.125f * LOG2E; }
        else if (ct < C_DV) mode = 2;
        else if (ct < C_GQ) mode = 0;
        else if (ct < C_GKV) { mode = 2; scale = 0.125f * LOG2E; }
        else if (ct < C_GATE) mode = (wc < 2) ? 2 : 0;
        else mode = 4;
        if (!latent && (mode == 1 || mode == 2)) mode = 0;
        switch (mode) {
            case 0: rows<0, BJ>(acc, u, wr, fr, ct, cl, scale); break;
            case 1: rows<1, BJ>(acc, u, wr, fr, ct, cl, scale); break;
            case 2: rows<2, BJ>(acc, u, wr, fr, ct, cl, scale); break;
            case 3: rows<3, BJ>(acc, u, wr, fr, ct, cl, scale); break;
            default: rows<4, BJ>(acc, u, wr, fr, ct, cl, scale); break;
        }
    }
    __device__ __forceinline__ void operator()(const f32x4 (&acc)[2][2][4][2], const gm::GU& u, int wr, int wc, int fr, int fq) const {
        half<0>(acc, u, wr, wc, fr, fq); half<1>(acc, u, wr, wc, fr, fq);
    }
};
struct SchedBranch {
    __device__ __forceinline__ void a_ready(const gm::GU&) const {}
    __device__ __forceinline__ void done(const gm::GU&) const {}
    OrderMN o; const char* Y; const char* W;
    __device__ __forceinline__ const char* baseA() const { return Y; }
    __device__ __forceinline__ const char* baseB() const { return W; }
    __device__ __forceinline__ bool next(int i, gm::GU& u) const { int pm, pn; const int ti = i / 3, seg = i - 3 * ti; if (!o.tile(ti, pm, pn)) return false;
        const int koff = seg == 0 ? 0 : (seg == 1 ? 1024 : 1536), eb = BR_FP8 ? 1 : 2;
        u.A = (unsigned)(pm * 256 * 2048 * eb + koff * eb); u.B = (unsigned)(pn * 256 * 2048 * eb + koff * eb); u.nt = (seg == 0 ? 16 : 8) / (BR_FP8 ? 2 : 1); u.pm = pm; u.pn = pn; u.e0 = seg; u.e1 = seg < 2; return true; }
};
constexpr int CW_PB = 32768;
struct SchedBranchX {
    int c, ctx; const char* Y; const char* W; unsigned* cnt; int wv;
    __device__ __forceinline__ const char* baseA() const { return Y; }
    __device__ __forceinline__ const char* baseB() const { return W; }
    __device__ __forceinline__ bool next(int i, gm::GU& u) const { const int ti = i / 3, seg = i - 3 * ti, x = c & 7, r = c >> 3; int pm, pn;
        if (ti == 0) { pm = x + 8 * (r >> 2); pn = r & 3; } else if (ti == 1 && ctx && x < 4 && r < 4) { pm = 64 + x; pn = r; } else return false;
        const int koff = seg == 0 ? 0 : (seg == 1 ? 1024 : 1536);
        u.A = (unsigned)(pm * 256 * 4096 + koff * 2); u.B = (unsigned)(pn * 256 * 4096 + koff * 2); u.nt = seg == 0 ? 16 : 8; u.pm = pm; u.pn = pn; u.e0 = seg; u.e1 = seg < 2; return true; }
    __device__ __forceinline__ void a_ready(const gm::GU&) const {}
    __device__ __forceinline__ void done(const gm::GU& u) const {
        if (u.e0 != 2) return;
        asm volatile("s_waitcnt vmcnt(0)" ::: "memory");
        __builtin_amdgcn_s_barrier();
        if (wv == 0 && lane_now() == 0) { __builtin_amdgcn_fence(__ATOMIC_RELEASE, "agent"); asm volatile("s_waitcnt vmcnt(0)" ::: "memory");
            __hip_atomic_fetch_add(cnt + 16 * u.pm, 1u, __ATOMIC_RELAXED, __HIP_MEMORY_SCOPE_AGENT); }
    }
};
struct SchedOutX {
    int c, ctx; const char* A; const char* B; const unsigned* cnt; int wv;
    __device__ __forceinline__ const char* baseA() const { return A; }
    __device__ __forceinline__ const char* baseB() const { return B; }
    __device__ __forceinline__ bool next(int i, gm::GU& u) const { const int x = c & 7, r = c >> 3; const bool lng = ctx && x < 4 && r < 4; int pm, pn;
        if (i == 0) { if (lng) { pm = 64 + x; pn = r; } else { pm = x + 8 * (r >> 2); pn = r & 3; } }
        else if (i == 1 && ctx && x < 4 && r >= 4 && r < 8) { pm = x; pn = r - 4; }
        else return false;
        u.A = (unsigned)(pm * 256 * 2048); u.B = (unsigned)(pn * 256 * 2048); u.nt = 16; u.pm = pm; u.pn = pn; u.e0 = 0; u.e1 = 0; return true; }
    __device__ __forceinline__ void a_ready(const gm::GU& u) const {
        if (wv == 0) { const unsigned* w_ = cnt + 16 * u.pm; unsigned sp_ = 0;
            while ((unsigned)__builtin_amdgcn_readfirstlane((int)__hip_atomic_load(w_, __ATOMIC_RELAXED, __HIP_MEMORY_SCOPE_AGENT)) < 4u) { __builtin_amdgcn_s_sleep(2); if (++sp_ > (1u << 22)) break; }
            __builtin_amdgcn_fence(__ATOMIC_ACQUIRE, "agent"); asm volatile("s_waitcnt vmcnt(0)" ::: "memory"); }
        asm volatile("" ::: "memory"); __builtin_amdgcn_s_barrier(); asm volatile("" ::: "memory");
    }
    __device__ __forceinline__ void done(const gm::GU&) const {}
};
struct EpiBranch {
    static constexpr bool DUPK = false; static constexpr bool DUPE = false;
    static constexpr bool CHAIN = true;
    const bf16_t* P; bf16_t* MGB;
    __device__ __forceinline__ void operator()(f32x4 (&acc)[2][2][4][2], const gm::GU& u, int wr, int wc, int fr, int fq) const {
        const bool last = u.e0 == 2;
        const bf16_t* gbase = P + C_GATE + u.e0 * 1024 + u.pn * 256 + wc * 32 + fq * 8;
        const int nxt = last ? 0 : 1024;
#pragma unroll
        for (int ai = 0; ai < 2; ++ai)
#pragma unroll
            for (int m = 0; m < 4; ++m) {
                const int row = u.pm * 256 + ai * 128 + wr * 64 + m * 16 + fr;
                const bf16_t* gp = gbase + (size_t)row * DIN;
                u32x4 ga[2], gb[2];
#pragma unroll
                for (int bj = 0; bj < 2; ++bj) { ga[bj] = *(const u32x4*)(gp + bj * 128); gb[bj] = *(const u32x4*)(gp + nxt + bj * 128); }
                __builtin_amdgcn_sched_barrier(0);
#pragma unroll
                for (int bj = 0; bj < 2; ++bj) {
                    const int col = u.pn * 256 + bj * 128 + wc * 32 + fq * 8;
                    const u32x4 g = ga[bj], h = gb[bj];
                    f32x4 f0 = (f32x4){bflo(g.x), bfhi(g.x), bflo(g.y), bfhi(g.y)}, f1 = (f32x4){bflo(g.z), bfhi(g.z), bflo(g.w), bfhi(g.w)};
                    const f32x4 d0 = (f32x4){bflo(h.x), bfhi(h.x), bflo(h.y), bfhi(h.y)}, d1 = (f32x4){bflo(h.z), bfhi(h.z), bflo(h.w), bfhi(h.w)};
#pragma unroll
                    for (int q = 0; q < 4; ++q) { f0[q] *= frcp(last ? 1.f : fmaxf(d0[q], 1e-20f)); f1[q] *= frcp(last ? 1.f : fmaxf(d1[q], 1e-20f)); }
                    const f32x4 v0 = acc[ai][bj][m][0] * f0, v1 = acc[ai][bj][m][1] * f1;
                    acc[ai][bj][m][0] = v0; acc[ai][bj][m][1] = v1;
                    if (last) { u32x4 w; w.x = cvt_pk_bf16(v0[0], v0[1]); w.y = cvt_pk_bf16(v0[2], v0[3]); w.z = cvt_pk_bf16(v1[0], v1[1]); w.w = cvt_pk_bf16(v1[2], v1[3]);
                        *(u32x4*)(MGB + (size_t)row * D + col) = w; }
                }
                __builtin_amdgcn_sched_barrier(0);
            }
    }
};
struct EpiOut {
    static constexpr bool DUPK = false; static constexpr bool DUPE = false;
    static constexpr bool CHAIN = false;
    float* X; const float* mod; float* XO;
    __device__ __forceinline__ void operator()(const f32x4 (&acc)[2][2][4][2], const gm::GU& u, int wr, int wc, int fr, int fq) const {
        const int v = u.pm < (TL / 256) ? (u.pm >> 4) : 4;
#pragma unroll
        for (int bj = 0; bj < 2; ++bj) {
            const int col = u.pn * 256 + bj * 128 + wc * 32 + fq * 8;
            const f32x4 g0 = *(const f32x4*)(mod + (size_t)v * 6144 + 2048 + col), g1 = *(const f32x4*)(mod + (size_t)v * 6144 + 2048 + col + 4);
#pragma unroll
            for (int ai = 0; ai < 2; ++ai) {
                f32x4 x0[4], x1[4];
#pragma unroll
                for (int m = 0; m < 4; ++m) { const float* x = X + (size_t)(u.pm * 256 + ai * 128 + wr * 64 + m * 16 + fr) * D + col; x0[m] = *(const f32x4*)x; x1[m] = *(const f32x4*)(x + 4); }
                __builtin_amdgcn_sched_barrier(0);
#pragma unroll
                for (int m = 0; m < 4; ++m) {
                    float* xo = XO + (size_t)(u.pm * 256 + ai * 128 + wr * 64 + m * 16 + fr) * D + col;
                    constexpr float SCO = BR_FP8 ? 1.f / 256.f : 1.f;
                    *(f32x4*)xo = x0[m] + g0 * (acc[ai][bj][m][0] * SCO);
                    *(f32x4*)(xo + 4) = x1[m] + g1 * (acc[ai][bj][m][1] * SCO);
                }
                __builtin_amdgcn_sched_barrier(0);
            }
        }
    }
};
struct SchedGU {
    __device__ __forceinline__ void a_ready(const gm::GU&) const {}
    __device__ __forceinline__ void done(const gm::GU&) const {}
    int G, c; const LAS int* pref; const int* cnt; const int* list; const char* H; const char* W; int wv;
    __device__ __forceinline__ const char* baseA() const { return H; }
    __device__ __forceinline__ const char* baseB() const { return W; }
    __device__ __forceinline__ bool next(int i, gm::GU& u) const {
        const int ntile = __builtin_amdgcn_readfirstlane(pref[NEXP]); int ti, pn;
        if ((G & 7) == 0) {
            const int x = c & 7, j = c >> 3, t0 = x * ntile / 8, t1 = (x + 1) * ntile / 8, m = j + (G >> 3) * i; if (m >= (t1 - t0) * 8) return false; ti = t0 + (m >> 3); pn = m & 7;
        } else { const long L = (long)i * G + c; if (L >= (long)ntile * 8) return false; ti = (int)(L >> 3); pn = (int)(L & 7); }
        const int rec = __builtin_amdgcn_readfirstlane(pref[64 + ti]); const int e = rec & 255, valid = (rec >> 8) & 4095, mt = rec >> 20;
        u.A = 0u; u.B = (unsigned)((e * 2048 + pn * 256) * 1024); u.nt = 8; u.pm = ti; u.pn = pn; u.e0 = e | (mt << 8); u.e1 = valid; return true;
    }
    __device__ __forceinline__ void gather(const gm::GU& u, unsigned (&o)[2][2]) const {
        const int e = u.e0 & 255, mt = u.e0 >> 8;
        int tid = tid_now(wv); asm volatile("" : "+v"(tid));
#pragma unroll
        for (int i = 0; i < 2; ++i) { int R, C; gm::stage_rc(tid * 16 + i * 8192, R, C);
#pragma unroll
            for (int h = 0; h < 2; ++h) { const int r = h * 128 + R; const int idx = mt * 256 + (r < u.e1 ? r : 0); const int a = list[(size_t)e * TT + idx];
                o[h][i] = (unsigned)(a >> 2) * 1024u + (unsigned)C * 2u; } }
    }
};
struct EpiGU {
    static constexpr bool DUPK = false; static constexpr bool DUPE = (DUP_MASK & 65536) != 0;
    static constexpr bool CHAIN = false;
    bf16_t* ACT; const float* bgu;
    __device__ __forceinline__ void operator()(const f32x4 (&acc)[2][2][4][2], const gm::GU& u, int wr, int wc, int fr, int fq) const {
        const int e = u.e0 & 255;
#pragma unroll
        for (int bj = 0; bj < 2; ++bj) {
            const int j0 = u.pn * 128 + bj * 64 + wc * 16 + fq * 4;
            const f32x4 bg = *(const f32x4*)(bgu + (size_t)e * 2048 + j0), bl = *(const f32x4*)(bgu + (size_t)e * 2048 + 1024 + j0);
#pragma unroll
            for (int ai = 0; ai < 2; ++ai)
#pragma unroll
                for (int m = 0; m < 4; ++m) {
                    const int r = ai * 128 + wr * 64 + m * 16 + fr;
                    const f32x4 v0 = acc[ai][bj][m][0], v1 = acc[ai][bj][m][1];
                    constexpr float SC = 1.f / 256.f;
                    float gl[4] = {v0[0] * SC + bg[0], v0[2] * SC + bg[1], v1[0] * SC + bg[2], v1[2] * SC + bg[3]};
                    float li[4] = {v0[1] * SC + bl[0], v0[3] * SC + bl[1], v1[1] * SC + bl[2], v1[3] * SC + bl[3]};
                    float o[4];
#pragma unroll
                    for (int q = 0; q < 4; ++q) { const float g = fminf(gl[q], 7.f), ln = fminf(fmaxf(li[q], -7.f), 7.f); o[q] = g * sigmoidf_(1.702f * g) * (ln + 1.f); }
                    *(unsigned*)((unsigned char*)ACT + ((size_t)u.pm * 256 + r) * D + j0) = pk_fp8x4(o[0] * 4.f, o[1] * 4.f, o[2] * 4.f, o[3] * 4.f);
                }
        }
    }
};
struct SchedDN {
    __device__ __forceinline__ void a_ready(const gm::GU&) const {}
    __device__ __forceinline__ void done(const gm::GU&) const {}
    int G, c; const LAS int* pref; const int* cnt; const char* ACT; const char* W;
    __device__ __forceinline__ const char* baseA() const { return ACT; }
    __device__ __forceinline__ const char* baseB() const { return W; }
    __device__ __forceinline__ bool next(int i, gm::GU& u) const {
        const int ntile = __builtin_amdgcn_readfirstlane(pref[NEXP]); int ti, pn;
        if ((G & 7) == 0) { const int x = c & 7, j = c >> 3, t0 = x * ntile / 8, t1 = (x + 1) * ntile / 8, m = j + (G >> 3) * i; if (m >= (t1 - t0) * 4) return false; ti = t0 + (m >> 2); pn = m & 3; }
        else { const long L = (long)i * G + c; if (L >= (long)ntile * 4) return false; ti = (int)(L >> 2); pn = (int)(L & 3); }
        const int rec = __builtin_amdgcn_readfirstlane(pref[64 + ti]); const int e = rec & 255, valid = (rec >> 8) & 4095, mt = rec >> 20;
        u.A = (unsigned)(ti * 256 * 1024); u.B = (unsigned)((e * 1024 + pn * 256) * 1024); u.nt = 8; u.pm = ti; u.pn = pn; u.e0 = e | (mt << 8); u.e1 = valid; return true;
    }
};
struct EpiDN {
    static constexpr bool DUPK = false; static constexpr bool DUPE = (DUP_MASK & 131072) != 0;
    static constexpr bool CHAIN = false;
    bf16_t* YK; const float* bdn; const int* list; const float* tw;
    __device__ __forceinline__ void operator()(const f32x4 (&acc)[2][2][4][2], const gm::GU& u, int wr, int wc, int fr, int fq) const {
        const int e = u.e0 & 255, mt = u.e0 >> 8;
        int aid[8]; float wgt[8];
#pragma unroll
        for (int k = 0; k < 8; ++k) { const int r = (k >> 2) * 128 + wr * 64 + (k & 3) * 16 + fr; aid[k] = list[(size_t)e * TT + mt * 256 + (r < u.e1 ? r : 0)]; }
#pragma unroll
        for (int k = 0; k < 8; ++k) wgt[k] = tw[aid[k]];
#pragma unroll
        for (int bj = 0; bj < 2; ++bj) {
            const int col = u.pn * 256 + bj * 128 + wc * 32 + fq * 8;
            const f32x4 b0 = *(const f32x4*)(bdn + (size_t)e * 1024 + col), b1 = *(const f32x4*)(bdn + (size_t)e * 1024 + col + 4);
#pragma unroll
            for (int ai = 0; ai < 2; ++ai)
#pragma unroll
                for (int m = 0; m < 4; ++m) {
                    const int r = ai * 128 + wr * 64 + m * 16 + fr; const int k = ai * 4 + m;
                    if (r < u.e1) {
                        const float w = wgt[k];
                        const f32x4 v0 = (acc[ai][bj][m][0] * (1.f / 128.f) + b0) * w, v1 = (acc[ai][bj][m][1] * (1.f / 128.f) + b1) * w;
                        u32x4 o; o.x = cvt_pk_bf16(v0[0], v0[1]); o.y = cvt_pk_bf16(v0[2], v0[3]); o.z = cvt_pk_bf16(v1[0], v1[1]); o.w = cvt_pk_bf16(v1[2], v1[3]);
                        *(u32x4*)(YK + (size_t)aid[k] * D + col) = o;
                    }
                }
        }
    }
};

struct SmState { float m, l; };
constexpr float SM_DEFER = 8.f;
__device__ __forceinline__ float max3f(float a, float b, float c) { float r; asm("v_max3_f32 %0, %1, %2, %3" : "=v"(r) : "v"(a), "v"(b), "v"(c)); return r; }
template <int NC>
__device__ __forceinline__ void softmax_tile(f32x16& s0, f32x16& s1, SmState& st, f32x16 (&O)[NC], bf16x8 (&pf)[4]) {
    float ma, mb;
    asm volatile("s_nop 15\n\ts_nop 3\n\tv_max3_f32 %0, %2, %3, %4\n\tv_max3_f32 %1, %5, %6, %7" : "=&v"(ma), "=&v"(mb) : "v"(s0[0]), "v"(s0[1]), "v"(s1[0]), "v"(s0[2]), "v"(s0[3]), "v"(s1[1]));
    ma = max3f(ma, s1[2], s1[3]);
#pragma unroll
    for (int r = 4; r < 16; r += 4) { ma = max3f(ma, s0[r], s0[r + 1]); mb = max3f(mb, s0[r + 2], s0[r + 3]); ma = max3f(ma, s1[r], s1[r + 1]); mb = max3f(mb, s1[r + 2], s1[r + 3]); }
    const float mx = xmax(max3f(ma, mb, mb));
    if (!__all(mx <= st.m)) {
        const float mn = max3f(st.m, mx, mx); const float alpha = fexp2(st.m - mn);
        st.m = mn; st.l *= alpha;
#pragma unroll
        for (int c = 0; c < NC; ++c) O[c] = O[c] * alpha;
    }
    const float mn = st.m;
    s0 = s0 - mn; s1 = s1 - mn;
#pragma unroll
    for (int r = 0; r < 16; ++r) { s0[r] = fexp2(s0[r]); s1[r] = fexp2(s1[r]); }
    const f32x16 ssum = s0 + s1;
    float sum = 0.f;
#pragma unroll
    for (int r = 0; r < 16; ++r) sum += ssum[r];
    st.l += sum;
    pf[0] = pack8(s0, 0); pf[1] = pack8(s0, 8); pf[2] = pack8(s1, 0); pf[3] = pack8(s1, 8);
}
template <int NC>
__device__ __forceinline__ void softmax_pre(f32x16& s0, f32x16& s1, f32x16& p0, f32x16& p1, bool shift_p, SmState& st, f32x16& negm, f32x16 (&O)[NC], bf16x8 (&pf)[4], bool first) {
    float ma, mb;
    asm volatile("s_nop 15\n\ts_nop 3\n\tv_max3_f32 %0, %2, %3, %4\n\tv_max3_f32 %1, %5, %6, %7" : "=&v"(ma), "=&v"(mb) : "v"(s0[0]), "v"(s0[1]), "v"(s1[0]), "v"(s0[2]), "v"(s0[3]), "v"(s1[1]));
    ma = max3f(ma, s1[2], s1[3]);
#pragma unroll
    for (int r = 4; r < 16; r += 4) { ma = max3f(ma, s0[r], s0[r + 1]); mb = max3f(mb, s0[r + 2], s0[r + 3]); ma = max3f(ma, s1[r], s1[r + 1]); mb = max3f(mb, s1[r + 2], s1[r + 3]); }
    const float mx = xmax(max3f(ma, mb, mb));
    if (first || !__all(mx <= 0.f)) {
        const float d = first ? mx : fmaxf(mx, 0.f); const float alpha = first ? 1.f : fexp2(-d);
        st.m += d; st.l *= alpha;
#pragma unroll
        for (int c = 0; c < NC; ++c) O[c] = O[c] * alpha;
        s0 = s0 - d; s1 = s1 - d;
        if (shift_p) { p0 = p0 - d; p1 = p1 - d; }
        const float nm = -st.m;
#pragma unroll
        for (int r = 0; r < 16; ++r) negm[r] = nm;
    }
#pragma unroll
    for (int r = 0; r < 16; ++r) { s0[r] = fexp2(s0[r]); s1[r] = fexp2(s1[r]); }
    const f32x16 ssum = s0 + s1;
    float sum = 0.f;
#pragma unroll
    for (int r = 0; r < 16; ++r) sum += ssum[r];
    st.l += sum;
    pf[0] = pack8(s0, 0); pf[1] = pack8(s0, 8); pf[2] = pack8(s1, 0); pf[3] = pack8(s1, 8);
}
template <int NC>
__device__ __forceinline__ void softmax_head(f32x16& s0, f32x16& s1, SmState& st, f32x16 (&O)[NC]) {
    float ma, mb;
    asm volatile("s_nop 15\n\ts_nop 3\n\tv_max3_f32 %0, %2, %3, %4\n\tv_max3_f32 %1, %5, %6, %7" : "=&v"(ma), "=&v"(mb) : "v"(s0[0]), "v"(s0[1]), "v"(s1[0]), "v"(s0[2]), "v"(s0[3]), "v"(s1[1]));
    ma = max3f(ma, s1[2], s1[3]);
#pragma unroll
    for (int r = 4; r < 16; r += 4) { ma = max3f(ma, s0[r], s0[r + 1]); mb = max3f(mb, s0[r + 2], s0[r + 3]); ma = max3f(ma, s1[r], s1[r + 1]); mb = max3f(mb, s1[r + 2], s1[r + 3]); }
    const float mx = xmax(max3f(ma, mb, mb));
    if (!__all(mx <= st.m + SM_DEFER)) {
        const float mn = max3f(st.m, mx, mx); const float alpha = fexp2(st.m - mn);
        st.m = mn; st.l *= alpha;
#pragma unroll
        for (int c = 0; c < NC; ++c) O[c] = O[c] * alpha;
    }
    const float mn = st.m;
    s0 = s0 - mn; s1 = s1 - mn;
}
template <int NC>
__device__ __forceinline__ void sm_max2(f32x16& a0, f32x16& a1, f32x16& b0, f32x16& b1, SmState& st, f32x16& negm, f32x16 (&O)[NC], bool first) {
    float ma, mb;
    asm volatile("s_nop 15\n\ts_nop 3\n\tv_max3_f32 %0, %2, %3, %4\n\tv_max3_f32 %1, %5, %6, %7" : "=&v"(ma), "=&v"(mb) : "v"(a0[0]), "v"(a0[1]), "v"(a1[0]), "v"(a0[2]), "v"(a0[3]), "v"(a1[1]));
    ma = max3f(ma, a1[2], a1[3]);
#pragma unroll
    for (int r = 4; r < 16; r += 4) { ma = max3f(ma, a0[r], a0[r + 1]); mb = max3f(mb, a0[r + 2], a0[r + 3]); ma = max3f(ma, a1[r], a1[r + 1]); mb = max3f(mb, a1[r + 2], a1[r + 3]); }
#pragma unroll
    for (int r = 0; r < 16; r += 4) { ma = max3f(ma, b0[r], b0[r + 1]); mb = max3f(mb, b0[r + 2], b0[r + 3]); ma = max3f(ma, b1[r], b1[r + 1]); mb = max3f(mb, b1[r + 2], b1[r + 3]); }
    const float mx = xmax(max3f(ma, mb, mb));
    if (first || !__all(mx <= SM_DEFER)) {
        const float d = first ? mx : fmaxf(mx, 0.f); const float alpha = first ? 1.f : fexp2(-d);
        st.m += d; st.l *= alpha;
#pragma unroll
        for (int c = 0; c < NC; ++c) O[c] = O[c] * alpha;
        a0 = a0 - d; a1 = a1 - d; b0 = b0 - d; b1 = b1 - d;
        const float nm = -st.m;
#pragma unroll
        for (int r = 0; r < 16; ++r) negm[r] = nm;
    }
}
__device__ __forceinline__ void sm_exp_q(f32x16& s, SmState& st, bf16x8& p0, bf16x8& p1) {
#pragma unroll
    for (int r = 0; r < 16; ++r) s[r] = fexp2(s[r]);
    float su0 = s[0] + s[1], su1 = s[2] + s[3];
#pragma unroll
    for (int r = 4; r < 16; r += 4) { su0 += s[r] + s[r + 1]; su1 += s[r + 2] + s[r + 3]; }
    st.l += su0 + su1;
    p0 = pack8(s, 0); p1 = pack8(s, 8);
}
__device__ __forceinline__ void sm_exp(f32x16& s0, f32x16& s1, SmState& st, bf16x8 (&pf)[4]) {
#pragma unroll
    for (int r = 0; r < 16; ++r) { s0[r] = fexp2(s0[r]); s1[r] = fexp2(s1[r]); }
    const f32x16 ssum = s0 + s1;
    float sum = 0.f;
#pragma unroll
    for (int r = 0; r < 16; ++r) sum += ssum[r];
    st.l += sum;
    pf[0] = pack8(s0, 0); pf[1] = pack8(s0, 8); pf[2] = pack8(s1, 0); pf[3] = pack8(s1, 8);
}
#define ZERO16(x) do { _Pragma("unroll") for (int _r = 0; _r < 16; ++_r) (x)[_r] = 0.f; } while (0)

__device__ __forceinline__ void diff_unit(Frame& F, int l, int b, int h, int ctxq, int qblk) {
    const bf16_t* P = (const bf16_t*)(F.ws + WS_P);
#define DKimg(x) (F.lds + 65536 * (x))
#define DVimg(x) (F.lds + 32768 + 65536 * (x))
    int lane_ = lane_now(); asm volatile("" : "+v"(lane_)); const int lane = lane_, w = F.wave, r32 = lane & 31, hh = lane >> 5;
    LA la = make_la(lane); la.rowb ^= 16u * hh;
    const int sm = w >> 2;
    const int qrow0 = ctxq ? TL + b * 256 + qblk * 128 : b * 4096 + qblk * 128;
    const int kt0 = ctxq ? 32 : 0, nkt = ctxq ? 2 : 34;
    const char* kbase = (const char*)(P + C_DK + h * 128); const char* vbase = (const char*)(P + C_DV + h * 128);
#define DIFF_KROW(kt, i) ((kt) < 32 ? (size_t)(b * 4096 + (kt) * 128 + (i)) : (size_t)(TL + b * 256 + ((kt) - 32) * 128 + (i)))
#define DIFF_KP(r_) (kbase + DIFF_KROW(ktn, (r_)) * (DIN * 2))
#define DIFF_VP(r_) (vbase + DIFF_KROW(ktn, (r_)) * (DIN * 2))
    bf16x8 qf[4];
    { const bf16_t* qp = P + (size_t)(qrow0 + 32 * (w & 3) + r32) * DIN + C_DQ + h * 128 + 64 * sm + 8 * hh;
#pragma unroll
      for (int ks = 0; ks < 4; ++ks) qf[ks] = *(const bf16x8*)(qp + 16 * ks); }
    f32x16 O[4];
#pragma unroll
    for (int c = 0; c < 4; ++c) ZERO16(O[c]);
    SmState st = {0.f, 0.f};
    f32x16 negm; ZERO16(negm);
    __syncthreads();
    { DMA_LANE(); const int ktn = kt0;
#pragma unroll
      for (int i = 0; i < 4; ++i) { DMA4(DKimg(0), 4 * w + i, DIFF_KP); DMA4(DVimg(0), 4 * w + i, DIFF_VP); } }
    VMWAIT0(); __syncthreads();
    for (int t = 0; t < nkt; ++t) {
        const int cur = t & 1;
        LAS unsigned char* Kc = DKimg(cur); LAS unsigned char* Vc = DVimg(cur);
        OPAQUE(la.rowb); OPAQUE(la.trp);
#define SB() __builtin_amdgcn_sched_barrier(0)
        bf16x8 kfa[8], kfb[8], pfa[4], pfb[4], vf[2][4];
        f32x16 a0, a1, b0, b1;
#define LOAD_K(dst, R0_) do { _Pragma("unroll") for (int ks = 0; ks < 4; ++ks) { dst[ks] = frag_row(Kc, la.rowb, (R0_), 8 * sm + 2 * ks); dst[4 + ks] = frag_row(Kc, la.rowb, (R0_) + 32, 8 * sm + 2 * ks); } } while (0)
#define QK(kf_, s0_, s1_) do { s0_ = MFMA32(kf_[0], qf[0], negm); s1_ = MFMA32(kf_[4], qf[0], negm); _Pragma("unroll") for (int ks = 1; ks < 4; ++ks) { s0_ = MFMA32(kf_[ks], qf[ks], s0_); s1_ = MFMA32(kf_[4 + ks], qf[ks], s1_); } } while (0)
#define LOAD_V(slot_, R0_) do { _Pragma("unroll") for (int c = 0; c < 4; ++c) vf[slot_][c] = frag_trp(Vc, la.trp, (R0_), c, 0); } while (0)
#define PV(pf_, R0_) do { _Pragma("unroll") for (int kq = 0; kq < 4; ++kq) { \
            _Pragma("unroll") for (int c = 0; c < 4; ++c) { O[c] = MFMA32(vf[kq & 1][c], pf_[kq], O[c]); if (DUP_MASK & 262144) O[c] = MFMA32(vf[kq & 1][c], pf_[kq], O[c]); } \
            SB(); if (kq + 2 < 4) { LOAD_V(kq & 1, (R0_) + 16 * (kq + 2)); SB(); } } } while (0)
        LOAD_K(kfa, 0); LOAD_K(kfb, 64); SB();
        QK(kfa, a0, a1); QK(kfb, b0, b1); SB();
        LOAD_V(0, 0); LOAD_V(1, 16); SB();
        sm_max2<4>(a0, a1, b0, b1, st, negm, O, t == 0); SB();
        sm_exp(a0, a1, st, pfa); SB();
        if (t + 1 < nkt) { DMA_LANE(); const int ktn = kt0 + t + 1;
#pragma unroll
            for (int i = 0; i < 4; ++i) { DMA4(DKimg(cur ^ 1), 4 * w + i, DIFF_KP); DMA4(DVimg(cur ^ 1), 4 * w + i, DIFF_VP); } }
        SB();
#pragma unroll
        for (int kq = 0; kq < 4; ++kq) {
#pragma unroll
            for (int c = 0; c < 4; ++c) O[c] = MFMA32(vf[kq & 1][c], pfa[kq], O[c]);
            if (kq + 2 < 4) LOAD_V(kq & 1, 16 * (kq + 2)); }
        sm_exp(b0, b1, st, pfb);
#pragma unroll
        for (int i_ = 0; i_ < 16; ++i_) { __builtin_amdgcn_sched_group_barrier(0x008, 1, 0); __builtin_amdgcn_sched_group_barrier(0x002, 5, 0); __builtin_amdgcn_sched_group_barrier(0x100, 1, 0); }
        SB();
        LOAD_V(0, 64); LOAD_V(1, 80); SB();
        PV(pfb, 64);
#undef LOAD_K
#undef QK
#undef LOAD_V
#undef PV
#undef SB
        VMWAIT0(); __syncthreads();
    }
#undef DIFF_KP
#undef DIFF_VP
#undef DIFF_KROW
#undef DKimg
#undef DVimg
    const float lam = ((const float*)(F.ws + WS_DEC))[32 + l], li = ((const float*)(F.ws + WS_DEC))[40 + l];
    int lane2_ = lane_now(); asm volatile("" : "+v"(lane2_));
    LAS float* ex = (LAS float*)F.lds + (size_t)(w & 3) * 4096 + lane2_;
    const float inv = (sm ? lam : 1.f) * ((DUP_MASK & 262144) ? 0.5f : 1.f) / xsum(st.l);
    if (sm) {
#pragma unroll
        for (int c = 0; c < 4; ++c)
#pragma unroll
            for (int r = 0; r < 16; ++r) ex[(c * 16 + r) * 64] = O[c][r] * inv;
    }
    __syncthreads();
    if (!sm) {
        const int hh2 = lane2_ >> 5; const int qrow2 = qrow0 + 32 * w + (lane2_ & 31);
        float ss = 0.f;
#pragma unroll
        for (int c = 0; c < 4; ++c)
#pragma unroll
            for (int r = 0; r < 16; ++r) { const float o = O[c][r] * inv - ex[(c * 16 + r) * 64]; O[c][r] = o; ss += o * o; }
        ss = xsum(ss);
        const float rs = (1.f / sqrtf(ss * (1.f / 128.f) + NORM_EPS)) * (1.f - li);
        const float* gs = F.in[I_SUBLN] + l * 128;
        bf16_t* yo = (bf16_t*)(F.ws + WS_Y) + (size_t)qrow2 * 2048 + 1024 + h * 128; unsigned char* yo8 = F.ws + WS_Y + (size_t)qrow2 * 2048 + 1024 + h * 128;
        f32x4 ggv[4][4];
#pragma unroll
        for (int c = 0; c < 4; ++c)
#pragma unroll
            for (int g = 0; g < 4; ++g) ggv[c][g] = *(const f32x4*)(gs + 32 * c + 8 * g + 4 * hh2);
        __builtin_amdgcn_sched_barrier(0);
#pragma unroll
        for (int c = 0; c < 4; ++c)
#pragma unroll
            for (int g = 0; g < 4; ++g) { const int dv = 32 * c + 8 * g + 4 * hh2; const f32x4 gg = ggv[c][g];
                const float y0 = O[c][4 * g] * rs * gg.x, y1 = O[c][4 * g + 1] * rs * gg.y, y2 = O[c][4 * g + 2] * rs * gg.z, y3 = O[c][4 * g + 3] * rs * gg.w;
                if (BR_FP8) *(unsigned*)(yo8 + dv) = pk_fp8x4(y0 * 8.f, y1 * 8.f, y2 * 8.f, y3 * 8.f);
                else *(u32x2*)(yo + dv) = (u32x2){cvt_pk_bf16(y0, y1), cvt_pk_bf16(y2, y3)}; }
    }
}

__device__ __forceinline__ void gqa_unit(Frame& F, int l, int b, int kvh, int half, int qb) {
    const bf16_t* P = (const bf16_t*)(F.ws + WS_P);
#define GImg(x) (F.lds + 16384 * (x))
    int lane_ = lane_now(); asm volatile("" : "+v"(lane_)); const int lane = lane_, w = F.wave, r32 = lane & 31, hh = lane >> 5;
    LA la = make_la(lane); la.rowb ^= 16u * hh;
    const int head = kvh * 4 + half * 2 + (w >> 2);
    const bool ctxq = qb >= 32;
    const int qpos = (ctxq ? (qb - 32) : qb) * 128 + (w & 3) * 32 + r32;
    const int qrow = (ctxq ? TL + b * 256 : b * 4096) + qpos;
    bf16x8 q[4];
#pragma unroll
    for (int ks = 0; ks < 4; ++ks) q[ks] = *(const bf16x8*)(P + (size_t)qrow * DIN + C_GQ + head * 64 + 16 * ks + 8 * hh);
    const int lo = ctxq ? 0 : (2 * qb - 2 < 0 ? 0 : 2 * qb - 2), hi = ctxq ? -1 : (2 * qb + 3 > 63 ? 63 : 2 * qb + 3);
    const int nkt = 4 + (hi - lo + 1);
    const char* kvbase = (const char*)(P + C_GKV + kvh * 128);
#define GQA_ROW(tt, i) ((tt) < 4 ? (size_t)(TL + b * 256 + (tt) * 64 + (i)) : (size_t)(b * 4096 + (lo + (tt) - 4) * 64 + (i)))
#define GQA_P(r_) (kvbase + GQA_ROW(ttn, (r_)) * (DIN * 2))
    f32x16 O[2]; ZERO16(O[0]); ZERO16(O[1]);
    SmState st = {-1e30f, 0.f};
    __syncthreads();
    { DMA_LANE(); const int ttn = 0; DMA4(GImg(0), 2 * w, GQA_P); DMA4(GImg(0), 2 * w + 1, GQA_P); }
    VMWAIT0(); __syncthreads();
    for (int t = 0; t < nkt; ++t) {
        const int cur = t & 1;
        if (t + 1 < nkt) { DMA_LANE(); const int ttn = t + 1; DMA4(GImg(cur ^ 1), 2 * w, GQA_P); DMA4(GImg(cur ^ 1), 2 * w + 1, GQA_P); }
        LAS unsigned char* Ic = GImg(cur);
        OPAQUE(la.rowb); OPAQUE(la.trp);
        f32x16 a0, a1; ZERO16(a0); ZERO16(a1);
        { bf16x8 kf[8];
#pragma unroll
          for (int ks = 0; ks < 4; ++ks) { kf[ks] = frag_row(Ic, la.rowb, 0, 2 * ks); kf[4 + ks] = frag_row(Ic, la.rowb, 32, 2 * ks); }
          __builtin_amdgcn_sched_barrier(0);
#pragma unroll
          for (int ks = 0; ks < 4; ++ks) { a0 = MFMA32(kf[ks], q[ks], a0); a1 = MFMA32(kf[4 + ks], q[ks], a1); } }
        if (t >= 4) {
            const int k0 = (lo + t - 4) * 64;
#pragma unroll
            for (int r = 0; r < 16; ++r) { const int d0 = qpos - (k0 + crow(r, hh)), d1 = d0 - 32;
                if (d0 > 128 || d0 < -128) a0[r] = -INFINITY; if (d1 > 128 || d1 < -128) a1[r] = -INFINITY; }
        }
        bf16x8 pf[4], vf[4][2];
#pragma unroll
        for (int kq = 0; kq < 4; ++kq)
#pragma unroll
            for (int c = 0; c < 2; ++c) vf[kq][c] = frag_trp(Ic, la.trp, 16 * kq, c, 8);
        __builtin_amdgcn_sched_barrier(0);
        softmax_head<2>(a0, a1, st, O);
        __builtin_amdgcn_sched_barrier(0);
        sm_exp_q(a0, st, pf[0], pf[1]);
        __builtin_amdgcn_sched_barrier(0);
#pragma unroll
        for (int kq = 0; kq < 2; ++kq)
#pragma unroll
            for (int c = 0; c < 2; ++c) O[c] = MFMA32(vf[kq][c], pf[kq], O[c]);
        sm_exp_q(a1, st, pf[2], pf[3]);
#pragma unroll
        for (int i_ = 0; i_ < 4; ++i_) { __builtin_amdgcn_sched_group_barrier(0x008, 1, 0); __builtin_amdgcn_sched_group_barrier(0x002, 12, 0); }
        __builtin_amdgcn_sched_barrier(0);
#pragma unroll
        for (int kq = 2; kq < 4; ++kq)
#pragma unroll
            for (int c = 0; c < 2; ++c) O[c] = MFMA32(vf[kq][c], pf[kq], O[c]);
        VMWAIT0(); __syncthreads();
    }
#undef GQA_P
#undef GQA_ROW
#undef GImg
    const float sink = F.in[I_SINK][l * 8 + head];
    const float inv = 1.f / (xsum(st.l) + fexp2(sink * LOG2E - st.m));
    bf16_t* yo = (bf16_t*)(F.ws + WS_Y) + (size_t)qrow * 2048 + 1536 + head * 64; unsigned char* yo8 = F.ws + WS_Y + (size_t)qrow * 2048 + 1536 + head * 64;
#pragma unroll
    for (int c = 0; c < 2; ++c)
#pragma unroll
        for (int g = 0; g < 4; ++g) { const int dv = 32 * c + 8 * g + 4 * hh;
            const float y0 = O[c][4 * g] * inv, y1 = O[c][4 * g + 1] * inv, y2 = O[c][4 * g + 2] * inv, y3 = O[c][4 * g + 3] * inv;
            if (BR_FP8) *(unsigned*)(yo8 + dv) = pk_fp8x4(y0 * 8.f, y1 * 8.f, y2 * 8.f, y3 * 8.f);
            else *(u32x2*)(yo + dv) = (u32x2){cvt_pk_bf16(y0, y1), cvt_pk_bf16(y2, y3)}; }
}

__device__ __forceinline__ size_t ret_row(int b, int cid, int i) { return cid < 2 ? (size_t)(TL + b * 256 + cid * 128 + i) : (size_t)(b * 4096 + (cid - 2) * 128 + i); }
__device__ __forceinline__ bf16_t* st_ptr(const Frame& F, int b, int h, int dir, int cid) { return (bf16_t*)(F.ws + WS_ST) + ((((size_t)b * 4 + h) * 2 + dir) * NCHUNK + cid) * (256 * 128); }
__device__ __forceinline__ void ret_scan_item(Frame& F, int l, int item) {
    const int eh = item & 1, dir = (item >> 1) & 1, h = (item >> 2) & 3, b = item >> 4;
    int lane_ = lane_now(); asm volatile("" : "+v"(lane_)); const int lane = lane_, w = F.wave, r32 = lane & 31, hh = lane >> 5;
    LA la = make_la(lane);
    const int db = w >> 1, eb0 = 2 * (w & 1);
#define RKimg(x) (F.lds + 65536 * (x))
#define RVimg(x) (F.lds + 32768 + 65536 * (x))
    const char* kbase = (const char*)((const bf16_t*)(F.ws + WS_P) + C_RK + h * 128);
    const char* vbase = (const char*)((const bf16_t*)(F.ws + WS_P) + C_RV + h * 256 + eh * 128);
    const float lg = ((const float*)(F.ws + WS_DEC))[l * 8 + dir * 4 + h];
    const float cd = fexp2(lg * 128.f);
    float dk[8];
#pragma unroll
    for (int j = 0; j < 8; ++j) dk[j] = dir == 0 ? fexp2(lg * (float)(127 - 8 * hh - j)) : fexp2(lg * (float)(8 * hh + j));
    const float lgs = dir == 0 ? -16.f * lg : 16.f * lg;
#define R1_CID(n) (dir == 0 ? (n) : ((n) == 0 ? 1 : ((n) == 1 ? 0 : 35 - (n))))
#define R1_KP(r_) (kbase + ret_row(b, cidn, (r_)) * (DIN * 2))
#define R1_VP(r_) (vbase + ret_row(b, cidn, (r_)) * (DIN * 2))
    f32x16 S0, S1; ZERO16(S0); ZERO16(S1);
    __syncthreads();
    { DMA_LANE(); const int cidn = R1_CID(0);
#pragma unroll
      for (int i = 0; i < 4; ++i) { DMA4(RKimg(0), 4 * w + i, R1_KP); DMA4(RVimg(0), 4 * w + i, R1_VP); } }
    VMWAIT0(); __syncthreads();
    for (int n = 0; n < NCHUNK; ++n) {
        const int cur = n & 1, cid = R1_CID(n);
        if (n + 1 < NCHUNK - 1) { DMA_LANE(); const int cidn = R1_CID(n + 1);
#pragma unroll
            for (int i = 0; i < 4; ++i) { DMA4(RKimg(cur ^ 1), 4 * w + i, R1_KP); DMA4(RVimg(cur ^ 1), 4 * w + i, R1_VP); } }
        bf16_t* sp = st_ptr(F, b, h, dir, cid);
#pragma unroll
        for (int g = 0; g < 4; ++g) { const int d = 32 * db + 8 * g + 4 * hh;
            *(u32x2*)(sp + (size_t)(eh * 128 + 32 * eb0 + r32) * 128 + d) = (u32x2){cvt_pk_bf16(S0[4 * g], S0[4 * g + 1]), cvt_pk_bf16(S0[4 * g + 2], S0[4 * g + 3])};
            *(u32x2*)(sp + (size_t)(eh * 128 + 32 * (eb0 + 1) + r32) * 128 + d) = (u32x2){cvt_pk_bf16(S1[4 * g], S1[4 * g + 1]), cvt_pk_bf16(S1[4 * g + 2], S1[4 * g + 3])}; }
        if (n < NCHUNK - 1) {
            S0 = S0 * cd; S1 = S1 * cd;
            OPAQUE(la.trn);
#pragma unroll
            for (int ks = 0; ks < 8; ++ks) {
                bf16x8 a = frag_trn(RKimg(cur), la.trn, 16 * ks, db, 0);
                { const float fk = fexp2(lgs * (float)ks); u32x4 aw = __builtin_bit_cast(u32x4, a);
                  aw.x = cvt_pk_bf16(bflo(aw.x) * (dk[0] * fk), bfhi(aw.x) * (dk[1] * fk)); aw.y = cvt_pk_bf16(bflo(aw.y) * (dk[2] * fk), bfhi(aw.y) * (dk[3] * fk));
                  aw.z = cvt_pk_bf16(bflo(aw.z) * (dk[4] * fk), bfhi(aw.z) * (dk[5] * fk)); aw.w = cvt_pk_bf16(bflo(aw.w) * (dk[6] * fk), bfhi(aw.w) * (dk[7] * fk));
                  a = __builtin_bit_cast(bf16x8, aw); }
                S0 = MFMA32(a, frag_trn(RVimg(cur), la.trn, 16 * ks, eb0, 0), S0);
                S1 = MFMA32(a, frag_trn(RVimg(cur), la.trn, 16 * ks, eb0 + 1, 0), S1); }
        }
        VMWAIT0(); __syncthreads();
    }
#undef R1_KP
#undef R1_VP
#undef R1_CID
#undef RKimg
#undef RVimg
    if (F.wave == 0 && lane_now() == 0) { __builtin_amdgcn_fence(__ATOMIC_RELEASE, "agent"); asm volatile("s_waitcnt vmcnt(0)" ::: "memory"); __hip_atomic_fetch_add(F.ctl + CW_R1 + l * 64, 1u, __ATOMIC_RELAXED, __HIP_MEMORY_SCOPE_AGENT); }
}
__device__ __forceinline__ void ret_out_unit(Frame& F, int l, int b, int h, int cid) {
    const bf16_t* P = (const bf16_t*)(F.ws + WS_P);
    int lane_ = lane_now(); asm volatile("" : "+v"(lane_)); const int lane = lane_, w = F.wave, r32 = lane & 31, hh = lane >> 5;
    LA la = make_la(lane); const unsigned rowb0 = la.rowb; la.rowb ^= 16u * hh;
    LAS unsigned char* Qimg = F.lds; LAS unsigned char* Kimg = F.lds + 32768; LAS unsigned char* Vimg0 = F.lds + 65536;
    LAS float* red = (LAS float*)(F.lds + 131072);
    const float lgf = ((const float*)(F.ws + WS_DEC))[l * 8 + h], lgb = ((const float*)(F.ws + WS_DEC))[l * 8 + 4 + h];
    const char* qbase = (const char*)(P + C_RQ + h * 128); const char* kbase = (const char*)(P + C_RK + h * 128); const char* vbase = (const char*)(P + C_RV + h * 256);
#define R2_QP(r_) (qbase + ret_row(b, cid, (r_)) * (DIN * 2))
#define R2_KP(r_) (kbase + ret_row(b, cid, (r_)) * (DIN * 2))
#define R2_V0(r_) (vbase + ret_row(b, cid, (r_)) * (DIN * 2))
#define R2_V1(r_) (vbase + 256 + ret_row(b, cid, (r_)) * (DIN * 2))
    __syncthreads();
    bf16x8 aff[8], afb[8];
    { const bf16_t* sf = st_ptr(F, b, h, 0, cid) + (size_t)(32 * w + r32) * 128 + 8 * hh; const bf16_t* sb = st_ptr(F, b, h, 1, cid) + (size_t)(32 * w + r32) * 128 + 8 * hh;
#pragma unroll
      for (int ks = 0; ks < 8; ++ks) { aff[ks] = *(const bf16x8*)(sf + 16 * ks); afb[ks] = *(const bf16x8*)(sb + 16 * ks); } }
    __builtin_amdgcn_sched_barrier(0);
    DMA_LANE();
#pragma unroll
    for (int i = 0; i < 4; ++i) { DMA4(Qimg, 4 * w + i, R2_QP); DMA4(Kimg, 4 * w + i, R2_KP); }
#pragma unroll
    for (int i = 0; i < 4; ++i) { DMA4(Vimg0, 4 * w + i, R2_V0); DMA4(Vimg0 + 32768, 4 * w + i, R2_V1); }
    asm volatile("s_waitcnt vmcnt(8)" ::: "memory"); asm volatile("" ::: "memory"); __builtin_amdgcn_s_barrier(); asm volatile("" ::: "memory");
#undef R2_QP
#undef R2_KP
#undef R2_V0
#undef R2_V1
    f32x16 at0, at1; ZERO16(at0); ZERO16(at1);
    const int ibw = w >> 1, jbw = 2 * (w & 1);
#pragma unroll
    for (int kh = 0; kh < 2; ++kh) { bf16x8 qf[4], k0[4], k1[4];
#pragma unroll
        for (int ks = 0; ks < 4; ++ks) { qf[ks] = frag_row(Qimg, la.rowb, 32 * ibw, 2 * (4 * kh + ks)); k0[ks] = frag_row(Kimg, la.rowb, 32 * jbw, 2 * (4 * kh + ks)); k1[ks] = frag_row(Kimg, la.rowb, 32 * jbw + 32, 2 * (4 * kh + ks)); }
        __builtin_amdgcn_sched_barrier(0);
#pragma unroll
        for (int ks = 0; ks < 4; ++ks) { at0 = MFMA32(k0[ks], qf[ks], at0); at1 = MFMA32(k1[ks], qf[ks], at1); } }
    { const int i = 32 * ibw + r32;
#pragma unroll
      for (int r = 0; r < 16; ++r) { const int j0 = 32 * jbw + crow(r, hh), j1 = j0 + 32;
          at0[r] *= i > j0 ? fexp2(lgf * (float)(i - j0)) : (i < j0 ? fexp2(lgb * (float)(j0 - i)) : 2.f);
          at1[r] *= i > j1 ? fexp2(lgf * (float)(i - j1)) : (i < j1 ? fexp2(lgb * (float)(j1 - i)) : 2.f); } }
    __syncthreads();
#pragma unroll
    for (int g = 0; g < 4; ++g) {
        *(LAS u32x2*)(Kimg + 8192 * ibw + ((rowb0 + 8u * hh) ^ (16u * (4u * jbw + g)))) = (u32x2){cvt_pk_bf16(at0[4 * g], at0[4 * g + 1]), cvt_pk_bf16(at0[4 * g + 2], at0[4 * g + 3])};
        *(LAS u32x2*)(Kimg + 8192 * ibw + ((rowb0 + 8u * hh) ^ (16u * (4u * jbw + 4u + g)))) = (u32x2){cvt_pk_bf16(at1[4 * g], at1[4 * g + 1]), cvt_pk_bf16(at1[4 * g + 2], at1[4 * g + 3])}; }
    __syncthreads();
    f32x16 o[4];
    const float dfl = fexp2(lgf * (float)(r32 + 1)), dbl = fexp2(lgb * (float)(128 - r32));
    {
        bf16x8 af[8];
#pragma unroll
        for (int ks = 0; ks < 8; ++ks) af[ks] = aff[ks];
#pragma unroll
        for (int ib = 0; ib < 4; ++ib) { f32x16 a; ZERO16(a); OPAQUE(la.rowb); bf16x8 bq[8];
#pragma unroll
            for (int ks = 0; ks < 8; ++ks) bq[ks] = frag_row(Qimg, la.rowb, 32 * ib, 2 * ks);
            __builtin_amdgcn_sched_barrier(0);
#pragma unroll
            for (int ks = 0; ks < 8; ++ks) a = MFMA32(af[ks], bq[ks], a);
            o[ib] = a * (dfl * fexp2(lgf * (float)(32 * ib))); }
#pragma unroll
        for (int ks = 0; ks < 8; ++ks) af[ks] = afb[ks];
#pragma unroll
        for (int ib = 0; ib < 4; ++ib) { f32x16 a; ZERO16(a); OPAQUE(la.rowb); bf16x8 bq[8];
#pragma unroll
            for (int ks = 0; ks < 8; ++ks) bq[ks] = frag_row(Qimg, la.rowb, 32 * ib, 2 * ks);
            __builtin_amdgcn_sched_barrier(0);
#pragma unroll
            for (int ks = 0; ks < 8; ++ks) a = MFMA32(af[ks], bq[ks], a);
            o[ib] += a * (dbl * fexp2(-lgb * (float)(32 * ib))); }
        LAS unsigned char* Vh = Vimg0 + 32768 * (w >> 2);
#pragma unroll
        for (int ks = 0; ks < 8; ++ks) af[ks] = frag_trn(Vh, la.trn, 16 * ks, w & 3, 0);
#pragma unroll
        for (int ib = 0; ib < 4; ++ib) { OPAQUE(la.rowb); bf16x8 bq[8];
#pragma unroll
            for (int ks = 0; ks < 8; ++ks) bq[ks] = frag_row(Kimg, la.rowb, 32 * ib, 2 * ks);
            __builtin_amdgcn_sched_barrier(0);
#pragma unroll
            for (int ks = 0; ks < 8; ++ks) o[ib] = MFMA32(af[ks], bq[ks], o[ib]); }
    }
#pragma unroll
    for (int ib = 0; ib < 4; ++ib) { float s = 0.f, s2 = 0.f;
#pragma unroll
        for (int r = 0; r < 16; ++r) { s += o[ib][r]; s2 += o[ib][r] * o[ib][r]; }
        s = xsum(s); s2 = xsum(s2);
        if (hh == 0) { red[(w * 128 + 32 * ib + r32) * 2] = s; red[(w * 128 + 32 * ib + r32) * 2 + 1] = s2; } }
    __syncthreads();
    const int ybase = h * 256 + 32 * w;
#pragma unroll
    for (int ib = 0; ib < 4; ++ib) { float s = 0.f, s2 = 0.f;
#pragma unroll
        for (int ww = 0; ww < 8; ++ww) { s += red[(ww * 128 + 32 * ib + r32) * 2]; s2 += red[(ww * 128 + 32 * ib + r32) * 2 + 1]; }
        const float mu = s * (1.f / 256.f), var = fmaxf(s2 * (1.f / 256.f) - mu * mu, 0.f), rs = 1.f / sqrtf(var + NORM_EPS);
        const size_t row = ret_row(b, cid, 32 * ib + r32);
        const bf16_t* gp = P + row * DIN + C_RG + ybase; bf16_t* yo = (bf16_t*)(F.ws + WS_Y) + row * 2048 + ybase;
#pragma unroll
        for (int g = 0; g < 4; ++g) { const int e = 8 * g + 4 * hh; const u32x2 gw = *(const u32x2*)(gp + e);
            const float y0 = (o[ib][4 * g] - mu) * rs * bflo(gw.x), y1 = (o[ib][4 * g + 1] - mu) * rs * bfhi(gw.x), y2 = (o[ib][4 * g + 2] - mu) * rs * bflo(gw.y), y3 = (o[ib][4 * g + 3] - mu) * rs * bfhi(gw.y);
            if (BR_FP8) *(unsigned*)(F.ws + WS_Y + row * 2048 + ybase + e) = pk_fp8x4(y0 * 8.f, y1 * 8.f, y2 * 8.f, y3 * 8.f);
            else *(u32x2*)(yo + e) = (u32x2){cvt_pk_bf16(y0, y1), cvt_pk_bf16(y2, y3)}; } }
}

__device__ __forceinline__ void p_norm2_router(Frame& F, int l, bool dry = false) {
    LAS int* lcount = (LAS int*)F.lds;
    LAS int* lbase = lcount + 32;
    LAS int* rec_e = lbase + 32;
    LAS float* rec_w = (LAS float*)(rec_e + 1024);
    LAS int* rec_a = (LAS int*)(rec_w + 1024);
    LAS int* nrec = rec_a + 1024;
    int lane_ = lane_now(); asm volatile("" : "+v"(lane_)); const int lane = lane_, w = F.wave, r32 = lane & 31, hh = lane >> 5;
    const int NGRP = (l < DEPTH - 1 ? TT : TL) / 32;
    float sink_acc = 0.f;
    if (F.tid < 32) lcount[F.tid] = 0;
    if (F.tid == 32) *nrec = 0;
    const Row16 g = ld_row_f32(F.in[I_GFFN] + (size_t)l * D, lane);
    bf16_t* H = (bf16_t*)(F.ws + WS_H); bf16_t* HLO = (bf16_t*)(F.ws + WS_MGB);
    for (int grp = F.bid; grp < NGRP; grp += F.G)
        for (int i = 0; i < 4; ++i) {
            const int row = grp * 32 + w * 4 + i;
            const Row16 x = ld_row_f32((const float*)(F.ws + WS_XRES) + (size_t)row * D, lane);
            const float rs = row_rstd(x); const int v = row_modv(row);
            const Row16 sh = ld_row_f32(modp(F, l, v, 3), lane), sc = ld_row_f32(modp(F, l, v, 4), lane);
            Row16 h, lo;
#pragma unroll
            for (int j = 0; j < 4; ++j) { h.v[j] = x.v[j] * rs * g.v[j] * (sc.v[j] + 1.f) + sh.v[j];
                const unsigned a = cvt_pk_bf16(h.v[j].x, h.v[j].y), b = cvt_pk_bf16(h.v[j].z, h.v[j].w);
                lo.v[j] = h.v[j] - (f32x4){bflo(a), bfhi(a), bflo(b), bfhi(b)}; }
            st_row_bf16(H + (size_t)row * D, lane, h); st_row_bf16(HLO + (size_t)row * D, lane, lo);
            { unsigned* h8 = (unsigned*)(F.ws + WS_MG + (size_t)row * D) + lane;
#pragma unroll
              for (int j = 0; j < 4; ++j) h8[64 * j] = pk_fp8x4(h.v[j].x * 8.f, h.v[j].y * 8.f, h.v[j].z * 8.f, h.v[j].w * 8.f); }
        }
    VMWAIT0(); __syncthreads();
    __builtin_amdgcn_fence(__ATOMIC_ACQUIRE, "agent");
    LAS float* part = (LAS float*)(F.lds + 16384);
    for (int g0 = 0; F.bid + g0 * F.G < NGRP; g0 += 3) {
        __syncthreads();
        for (int gi = 0; gi < 3; ++gi) { const int grp = F.bid + (g0 + gi) * F.G; if (grp >= NGRP) break;
            const bf16_t* wr = (const bf16_t*)(F.ws + WS_WRT) + (size_t)l * 2 * NEXP * D + (size_t)r32 * D + 8 * hh + 128 * w;
            const bf16_t* hp = H + (size_t)(grp * 32 + r32) * D + 8 * hh + 128 * w; const bf16_t* lp = HLO + (size_t)(grp * 32 + r32) * D + 8 * hh + 128 * w;
            f32x16 pacc; ZERO16(pacc);
            bf16x8 whi[8], wlo[8], xhi[8], xlo[8];
#pragma unroll
            for (int ks = 0; ks < 8; ++ks) { whi[ks] = *(const bf16x8*)(wr + 16 * ks); wlo[ks] = *(const bf16x8*)(wr + NEXP * D + 16 * ks); xhi[ks] = *(const bf16x8*)(hp + 16 * ks); xlo[ks] = *(const bf16x8*)(lp + 16 * ks); }
            __builtin_amdgcn_sched_barrier(0);
#pragma unroll
            for (int ks = 0; ks < 8; ++ks) { pacc = MFMA32(whi[ks], xhi[ks], pacc); pacc = MFMA32(whi[ks], xlo[ks], pacc); pacc = MFMA32(wlo[ks], xhi[ks], pacc); }
#pragma unroll
            for (int r = 0; r < 16; ++r) part[((gi * 8 + w) * 16 + r) * 64 + lane] = pacc[r];
        }
        __syncthreads();
        const int grp = F.bid + (g0 + w) * F.G;
        if (w < 3 && grp < NGRP) {
            f32x16 acc;
#pragma unroll
            for (int r = 0; r < 16; ++r) { float sum = 0.f;
#pragma unroll
                for (int ww = 0; ww < 8; ++ww) sum += part[((w * 8 + ww) * 16 + r) * 64 + lane];
                acc[r] = sum; }
            float mine[16], oth[16];
#pragma unroll
            for (int r = 0; r < 16; ++r) { mine[r] = acc[r] + F.in[I_BR][l * NEXP + crow(r, hh)]; oth[r] = xother(mine[r], hh); }
            float tv[4]; int ti[4];
#pragma unroll
            for (int k = 0; k < 4; ++k) {
                float best = -INFINITY; int bi = 1 << 20;
#pragma unroll
                for (int r = 0; r < 16; ++r) { const int e0 = crow(r, hh), e1 = crow(r, hh ^ 1);
                    if (mine[r] > best || (mine[r] == best && e0 < bi)) { best = mine[r]; bi = e0; }
                    if (oth[r] > best || (oth[r] == best && e1 < bi)) { best = oth[r]; bi = e1; } }
                tv[k] = best; ti[k] = bi;
#pragma unroll
                for (int r = 0; r < 16; ++r) { if (crow(r, hh) == bi) mine[r] = -INFINITY; if (crow(r, hh ^ 1) == bi) oth[r] = -INFINITY; }
            }
            if (dry) sink_acc += tv[0] + tv[1] + tv[2] + tv[3] + (float)(ti[0] + ti[1] + ti[2] + ti[3]);
            if (hh == 0 && !dry) {
                const float e1 = fexp2((tv[1] - tv[0]) * LOG2E), e2 = fexp2((tv[2] - tv[0]) * LOG2E), e3 = fexp2((tv[3] - tv[0]) * LOG2E), inv = 1.f / (1.f + e1 + e2 + e3);
                const float wk[4] = {inv, e1 * inv, e2 * inv, e3 * inv};
                const int token = grp * 32 + r32;
#pragma unroll
                for (int k = 0; k < 4; ++k) { const int pos = __hip_atomic_fetch_add(&lcount[ti[k]], 1, __ATOMIC_RELAXED, __HIP_MEMORY_SCOPE_WORKGROUP); const int slot = __hip_atomic_fetch_add(nrec, 1, __ATOMIC_RELAXED, __HIP_MEMORY_SCOPE_WORKGROUP);
                    rec_e[slot] = ti[k] | (pos << 8); rec_w[slot] = wk[k]; rec_a[slot] = token * 4 + k; }
            }
        }
    }
    __syncthreads();
    int* cnt = (int*)(F.ctl + CW_CNT + l * 64);
    if (dry) { if (sink_acc == 1.2345e33f) cnt[63] = 1; __syncthreads(); return; }
    if (F.tid < 32) lbase[F.tid] = atomicAdd(&cnt[F.tid], lcount[F.tid]);
    __syncthreads();
    int* list = (int*)(F.ws + WS_LIST); float* tw = (float*)(F.ws + WS_TW);
    const int n = *nrec;
    for (int i = F.tid; i < n; i += NTHR) { const int e = rec_e[i] & 255, pos = rec_e[i] >> 8, a = rec_a[i]; list[(size_t)e * TT + lbase[e] + pos] = a; tw[a] = rec_w[i]; }
}
__device__ __forceinline__ void moe_prefix(Frame& F, int l, LAS int* pref) {
    __syncthreads();
    if (F.tid == 0) { const int* cnt = (const int*)(F.ctl + CW_CNT + l * 64); int s = 0;
        for (int e = 0; e < NEXP; ++e) { pref[e] = s; s += (cnt[e] + 255) >> 8; } pref[NEXP] = s; }
    __syncthreads();
    { const int ntile = pref[NEXP]; const int* cnt = (const int*)(F.ctl + CW_CNT + l * 64);
      int t0_ = tid_now(F.wave); asm volatile("" : "+v"(t0_));
      for (int ti = t0_; ti < ntile; ti += NTHR) { int e = 0; for (int k = 1; k < NEXP; ++k) e += (pref[k] <= ti) ? 1 : 0;
          const int mt = ti - pref[e]; int valid = cnt[e] - mt * 256; valid = valid > 256 ? 256 : valid; pref[64 + ti] = e | (valid << 8) | (mt << 20); } }
    __syncthreads();
}

constexpr int NPH = 2 + 9 * DEPTH;
struct Args { const float* in[26]; float* out; unsigned char* ws; int ph_lo, ph_hi; };
__global__ void __launch_bounds__(NTHR, 2) mk_fwd(Args args) {
    extern __shared__ __attribute__((aligned(16))) unsigned char lds_raw[];
    Frame F;
    F.lds = (LAS unsigned char*)lds_raw;
    F.tid = threadIdx.x; F.lane = F.tid & 63; F.wave = __builtin_amdgcn_readfirstlane(F.tid >> 6);
    F.G = gridDim.x; F.bid = blockIdx.x;
    F.ws = args.ws; F.ctl = (unsigned*)(args.ws + WS_CTL); F.out = args.out;
    F.in = args.in;
    volatile LAS unsigned* MISC = (volatile LAS unsigned*)(F.lds + LDS_MISC);
    if (F.tid < 64) MISC[F.tid] = 0u;
    __syncthreads();
    const int lo = args.ph_lo, hi = args.ph_hi;
    XcdBarrier bar; bar.bar = F.ctl + CW_BAR; bar.x = 0; bar.wv = 0;
    if (hi - lo > 1) bar = xcd_barrier_post(F.ctl + CW_BAR, MISC);
    bar.wv = F.wave;
#ifdef ONLY_PH
#define IN(k) (ONLY_PH == ((k) == 0 ? 0 : 37) && lo <= (k) && (k) < hi)
#define INL(j) (ONLY_PH == 1 + (j) && lo <= pb + (j) && pb + (j) < hi)
#else
#define IN(k) (lo <= (k) && (k) < hi)
#define INL(j) IN(pb + (j))
#endif
#define SEAM(k) do { if (lo <= (k) + 1 && (k) + 1 < hi) { xcd_barrier(bar); if (DUP_MASK & 8192) xcd_barrier(bar); } } while (0)
    LAS int* pref = (LAS int*)(F.lds + 131072);
#define PHASE_BEGIN() do { WS_OPAQUE(); int _t = tid_now(F.wave); asm volatile("" : "+v"(_t)); F.tid = _t; F.lane = _t & 63; } while (0)
#define WS_OPAQUE() do { const unsigned long long _w = (unsigned long long)args.ws;        int _l = __builtin_amdgcn_readfirstlane((int)(unsigned)_w), _h = __builtin_amdgcn_readfirstlane((int)(unsigned)(_w >> 32)); \
        int _wv = F.wave, _bd = F.bid, _g = F.G; asm volatile("" : "+s"(_l), "+s"(_h), "+s"(_wv), "+s"(_bd), "+s"(_g)); F.wave = _wv; F.bid = _bd; F.G = _g; \
        F.ws = (unsigned char*)(((unsigned long long)(unsigned)_h << 32) | (unsigned)_l); F.ctl = (unsigned*)(F.ws + WS_CTL); } while (0)

#define BG_CONVERT(nwg_, which_) do { const int _maxn = ((nwg_) + F.G - 1) / F.G, _nb = F.bid < (nwg_) ? ((nwg_) - 1 - F.bid) / F.G + 1 : 0, _nlong = (nwg_) - (_maxn - 1) * F.G; \
        unsigned* _cnt = F.ctl + CW_LONG + l * 4 + (which_); PHASE_BEGIN(); \
        if (_nb == _maxn) { if (F.tid == 0) __hip_atomic_fetch_add(_cnt, 1u, __ATOMIC_RELAXED, __HIP_MEMORY_SCOPE_AGENT); } \
        else { while (conv_chunk(F, l + 1, _cnt, (unsigned)_nlong)) { } } } while (0)
    if (IN(0)) { PHASE_BEGIN(); p0_prologue(F); if (DUP_MASK & 512) { __syncthreads(); p0_prologue(F); } SEAM(0); }
    for (int l = 0; l < DEPTH; ++l) {
        const int pb = 1 + 9 * l;
        const bool need_ctx = l < DEPTH - 1;
        if (INL(0)) { PHASE_BEGIN(); if (DUP_MASK & 1) p_norm1(F, l, true); p_norm1(F, l); if (l > 0) { while (conv_chunk(F, l, nullptr, 0u)) { } } SEAM(pb + 0); }
        if (INL(1)) for (int rep_ = 0; rep_ < ((DUP_MASK >> 1) & 1) + 1; ++rep_) {
            WS_OPAQUE();
            SchedPlain S; S.o.init(TT / 256, DIN / 256, F.G, F.bid); S.A = (const char*)(F.ws + WS_H); S.B = (const char*)(F.ws + WS_WIN) + (size_t)l * DIN * D * (WIN_FP8 ? 1 : 2); S.lda = WIN_FP8 ? 1024 : 2048; S.ldb = S.lda; S.nt = WIN_FP8 ? 8 : 16;
            EpiIn E{(bf16_t*)(F.ws + WS_P), (const f32x4*)(F.ws + WS_ROPE128), (const f32x4*)(F.ws + WS_ROPE64)}; if (DUP_MASK & 16384) { S.dupk = 1; E.pre = 0.5f; } E.P = pin(E.P);
            gm::gemm_phase<EpiIn, SchedPlain, false, WIN_FP8 != 0>(F.lds, S, E, S.lda, S.ldb, F.wave);
            SEAM(pb + 1);
        }
        if (INL(2)) { WS_OPAQUE();
#if !defined(SUB) || SUB == 0
            for (int it = F.bid; it < 64 * (((DUP_MASK >> 10) & 1) + 1); it += F.G) ret_scan_item(F, l, it & 63);
#endif
#if !defined(SUB) || SUB == 1
            for (int u_ = F.bid; u_ < 512 * (((DUP_MASK >> 11) & 1) + 1); u_ += F.G) { const int u = u_ & 511; diff_unit(F, l, u >> 7, (u >> 5) & 3, 0, u & 31); }
            if (need_ctx) for (int u = (F.bid + F.G - 64 % F.G) % F.G; u < 32; u += F.G) diff_unit(F, l, u >> 3, (u >> 1) & 3, 1, u & 1);
#endif
#if !defined(SUB) || SUB == 2
            { const int nq = need_ctx ? 34 : 32, ngq = 16 * nq, g0 = F.G > 128 ? 64 : 0;
              if (F.bid >= g0) for (int u = F.bid - g0; u < ngq; u += F.G - g0) { const int qb = u % nq, r = u / nq; gqa_unit(F, l, r >> 2, (r >> 1) & 1, r & 1, qb); } }
#endif
            {
                __syncthreads();
                if (F.wave == 0) { unsigned* cw = F.ctl + CW_R1 + l * 64; unsigned sp_ = 0;
                    while ((unsigned)__builtin_amdgcn_readfirstlane((int)__hip_atomic_load(cw, __ATOMIC_RELAXED, __HIP_MEMORY_SCOPE_AGENT)) < 64u) { __builtin_amdgcn_s_sleep(2); if (++sp_ > (1u << 24)) break; }
                    __builtin_amdgcn_fence(__ATOMIC_ACQUIRE, "agent"); asm volatile("s_waitcnt vmcnt(0)" ::: "memory"); }
                __syncthreads();
                const int c0 = need_ctx ? 0 : 2, nc = NCHUNK - c0, nu = 16 * nc, g0 = F.G > 128 ? 64 : 0;
                if (F.bid < g0) { const int u = F.bid; if (u < nu) { const int cid = c0 + u % nc, r = u / nc; ret_out_unit(F, l, r >> 2, r & 3, cid); } }
                else for (int u = g0 + (F.bid - g0); u < nu; u += F.G - g0) { const int cid = c0 + u % nc, r = u / nc; ret_out_unit(F, l, r >> 2, r & 3, cid); }
            }
            SEAM(pb + 2);
        }
        if (INL(3)) { }
        const bool fused45 = (F.G == 256) && (hi - lo > 1);
        if (INL(4)) { WS_OPAQUE();
            EpiBranch E{pin((const bf16_t*)(F.ws + WS_P)), pin((bf16_t*)(F.ws + WS_MGB))};
            if (fused45) {
                SchedBranchX S{F.bid, need_ctx ? 1 : 0, (const char*)(F.ws + WS_Y), (const char*)(F.ws + WS_WBR) + (size_t)l * D * 2048 * 2, F.ctl + CW_PB + l * 2048, F.wave};
                gm::gemm_phase<EpiBranch, SchedBranchX, false, false>(F.lds, S, E, 4096, 4096, F.wave);
            } else {
                SchedBranch S; S.o.init(need_ctx ? TT / 256 : TL / 256, 4, F.G, F.bid); S.Y = (const char*)(F.ws + WS_Y); S.W = (const char*)(F.ws + WS_WBR) + (size_t)l * D * 2048 * (BR_FP8 ? 1 : 2);
                gm::gemm_phase<EpiBranch, SchedBranch, false, BR_FP8 != 0>(F.lds, S, E, BR_FP8 ? 2048 : 4096, BR_FP8 ? 2048 : 4096, F.wave);
                if (need_ctx) BG_CONVERT(S.o.nwg, 0);
                SEAM(pb + 4);
            }
        }
        if (INL(5)) { WS_OPAQUE();
            EpiOut E{pin((float*)(F.ws + WS_XRES)), pin((const float*)(F.ws + WS_MOD) + (size_t)l * 5 * 6144), pin((float*)(F.ws + WS_XRES))};
            if (fused45) {
                SchedOutX S{F.bid, need_ctx ? 1 : 0, (const char*)(F.ws + WS_MGB), (const char*)(F.ws + WS_WOUT) + (size_t)l * D * D * 2, F.ctl + CW_PB + l * 2048, F.wave};
                gm::gemm_phase<EpiOut, SchedOutX, false, false>(F.lds, S, E, 2048, 2048, F.wave);
                if (need_ctx) {
                    unsigned* cnt_ = F.ctl + CW_LONG + l * 4; PHASE_BEGIN();
                    if ((F.bid & 7) < 4 && (F.bid >> 3) < 4) { if (F.tid == 0) __hip_atomic_fetch_add(cnt_, 1u, __ATOMIC_RELAXED, __HIP_MEMORY_SCOPE_AGENT); }
                    else { while (conv_chunk(F, l + 1, cnt_, 16u)) { } }
                }
            } else {
                SchedPlain S; S.o.init(need_ctx ? TT / 256 : TL / 256, 4, F.G, F.bid); S.A = (const char*)(F.ws + WS_MGB); S.B = (const char*)(F.ws + WS_WOUT) + (size_t)l * D * D * (BR_FP8 ? 1 : 2); S.lda = BR_FP8 ? 1024 : 2048; S.ldb = S.lda; S.nt = BR_FP8 ? 8 : 16;
                gm::gemm_phase<EpiOut, SchedPlain, false, BR_FP8 != 0>(F.lds, S, E, S.lda, S.ldb, F.wave);
                if (need_ctx) BG_CONVERT(S.o.nwg, 1);
            }
            SEAM(pb + 5);
        }
        if (INL(6)) { PHASE_BEGIN(); if (DUP_MASK & 64) p_norm2_router(F, l, true); p_norm2_router(F, l); SEAM(pb + 6); }
        if (INL(7)) for (int rep_ = 0; rep_ < ((DUP_MASK >> 7) & 1) + 1; ++rep_) {
            PHASE_BEGIN(); moe_prefix(F, l, pref);
            SchedGU S{F.G, F.bid, pref, (const int*)(F.ctl + CW_CNT + l * 64), (const int*)(F.ws + WS_LIST), (const char*)(F.ws + WS_MG), (const char*)(F.ws + WS_WGU) + (size_t)l * NEXP * 2048 * D, F.wave};
            EpiGU E{pin((bf16_t*)(F.ws + WS_ACT)), pin(F.in[I_BGU] + (size_t)l * NEXP * 2048)}; S.cnt = pin(S.cnt); S.list = pin(S.list);
            gm::gemm_phase<EpiGU, SchedGU, true, true>(F.lds, S, E, 1024, 1024, F.wave);
            SEAM(pb + 7);
        }
        if (INL(8)) for (int rep_ = 0; rep_ < ((DUP_MASK >> 8) & 1) + 1; ++rep_) {
            PHASE_BEGIN(); moe_prefix(F, l, pref);
            SchedDN S{F.G, F.bid, pref, (const int*)(F.ctl + CW_CNT + l * 64), (const char*)(F.ws + WS_ACT), (const char*)(F.ws + WS_WDN) + (size_t)l * NEXP * D * D};
            EpiDN E{pin((bf16_t*)(F.ws + WS_YK)), pin(F.in[I_BDN] + (size_t)l * NEXP * D), pin((const int*)(F.ws + WS_LIST)), pin((const float*)(F.ws + WS_TW))};
            gm::gemm_phase<EpiDN, SchedDN, false, true>(F.lds, S, E, 1024, 1024, F.wave);
            SEAM(pb + 8);
        }
    }
    if (IN(NPH - 1)) { PHASE_BEGIN(); p_final(F); }
#undef IN
#undef INL
#undef SEAM
}


#ifdef DBG_CHECK
constexpr int CW_DBG = 12288;
__device__ __forceinline__ void dbg_err(unsigned* ctl, int k, float fast, float ref, float scale) {
    float e = fabsf(fast - ref) / (fabsf(ref) + scale); if (!(e == e)) e = 9.f; if (e > 9.f) e = 9.f;
    atomicMax(ctl + CW_DBG + k, __builtin_bit_cast(unsigned, e));
}
__device__ __forceinline__ unsigned dbg_hash(unsigned x) { x ^= x >> 16; x *= 0x7feb352du; x ^= x >> 15; x *= 0x846ca68bu; x ^= x >> 16; return x; }
__device__ __forceinline__ float dbg_bf(const bf16_t* p, size_t i) { return bf2f(p[i]); }
__device__ float dbg_block_sum(float v, float* sh) {
    __syncthreads(); sh[threadIdx.x] = v; __syncthreads();
    for (int o = 128; o > 0; o >>= 1) { if ((int)threadIdx.x < o) sh[threadIdx.x] += sh[threadIdx.x + o]; __syncthreads(); }
    const float r = sh[0]; __syncthreads(); return r;
}
__device__ int dbg_srcrow_latent(int smp) { const unsigned h = dbg_hash(smp * 7919u + 13u); const int b = h & 3; int s = (h >> 2) & 4095; if ((smp & 7) == 0) s = (s & ~127); if ((smp & 7) == 1) s |= 127; return b * 4096 + s; }
__device__ int dbg_srcrow_any(int smp) { if ((smp & 3) == 3) { const unsigned h = dbg_hash(smp * 31u + 5u); return TL + (h & 1023); } return dbg_srcrow_latent(smp); }
struct DbgArgs { const float* const* in; unsigned char* ws; float* out; int stage, l; };
__device__ int dbg_win_src(int c) {
    for (int n = (c & ~255); n < (c & ~255) + 256; ++n) if (rowmap<1>(n) == c) return n;
    return -1;
}
template <int stage> __global__ void __launch_bounds__(256) dbg_chk(Args a, int l) {
    __shared__ float sh[256]; __shared__ float shv[1024];
    unsigned char* ws = a.ws; unsigned* ctl = (unsigned*)(ws + WS_CTL);
    const int t = threadIdx.x, smp = blockIdx.x;
    const float* mod = (const float*)(ws + WS_MOD) + (size_t)l * 5 * 6144;
    const bf16_t* P = (const bf16_t*)(ws + WS_P); const bf16_t* H = (const bf16_t*)(ws + WS_H); const bf16_t* Y = (const bf16_t*)(ws + WS_Y);
    const float* dec = (const float*)(ws + WS_DEC);
    if (stage == 0) {
        const unsigned h = dbg_hash(smp + 77u); const int v = h % 5, n = (h >> 8) % 6144; float s = 0.f;
        for (int k = t; k < 1024; k += 256) { const float c = v < 4 ? a.in[I_C][v * 1024 + k] : a.in[I_CCTX][k]; s += (c / (1.f + expf(-c))) * a.in[I_WMOD][((size_t)l * 1024 + k) * 6144 + n]; }
        s = dbg_block_sum(s, sh) + a.in[I_BMOD][l * 6144 + n];
        if (t == 0) dbg_err(ctl, 0, mod[v * 6144 + n], s, 0.01f);
    } else if (stage == 1) {
        const int row = dbg_srcrow_any(smp); const float* x = row < TL ? a.in[I_X] + (size_t)row * D : a.in[I_CTX] + (size_t)(row - TL) * D; float ss = 0.f;
        for (int k = t; k < 1024; k += 256) ss += x[k] * x[k];
        ss = dbg_block_sum(ss, sh); const float rs = 1.f / sqrtf(ss / 1024.f + NORM_EPS); const int v = row_modv(row);
        for (int k = t; k < 1024; k += 256) { const float h = x[k] * rs * a.in[I_GMIX][l * 1024 + k] * (1.f + mod[v * 6144 + 1024 + k]) + mod[v * 6144 + k]; dbg_err(ctl, 1, dbg_bf(H, (size_t)row * D + k), h, 0.02f); }
    } else if (stage == 2) {
        const int row = dbg_srcrow_any(smp); const bool latent = row < TL; const int s = row & 4095;
        for (int k = t; k < 1024; k += 256) shv[k] = dbg_bf(H, (size_t)row * D + k);
        __syncthreads();
        for (int it = 0; it < 4; ++it) {
            const int c = (dbg_hash(smp * 1024u + it * 256u + t) % DIN) & ~1;
            float o0 = 0.f, o1 = 0.f;
            { const int n0 = dbg_win_src(c), n1 = dbg_win_src(c + 1); for (int k = 0; k < 1024; ++k) { o0 += shv[k] * a.in[I_WIN][((size_t)l * 1024 + k) * DIN + n0]; o1 += shv[k] * a.in[I_WIN][((size_t)l * 1024 + k) * DIN + n1]; } }
            int hd = 0; float scale = 1.f;
            if (c < C_RK) { hd = 128; scale = 0.08838834764831845f; } else if (c < C_RV) hd = 128; else if (c >= C_DQ && c < C_DK) { hd = 64; scale = 0.125f; } else if (c >= C_DK && c < C_DV) hd = 64;
            else if (c >= C_GQ && c < C_GKV) { hd = 64; scale = 0.125f; } else if (c >= C_GKV && c < C_GATE && ((c - C_GKV) & 127) < 64) hd = 64;
            if (hd && latent) { const int i = (hd == 128 ? (c & 127) : (c & 63)) >> 1, quarter = hd / 4; const int pos = i < quarter ? (s >> 6) : (s & 63), j = i < quarter ? i : i - quarter;
                const float ang = (float)pos * powf(10000.f, -(float)j / (float)quarter), cs = __cosf(ang), sn = __sinf(ang); const float x1 = o0, x2 = o1; o0 = x1 * cs - x2 * sn; o1 = x1 * sn + x2 * cs; }
            if (c >= C_RG && c < C_DQ) { o0 = o0 / (1.f + expf(-o0)); o1 = o1 / (1.f + expf(-o1)); }
            if (c >= C_GATE) { o0 = 1.f / (1.f + expf(-o0)); o1 = 1.f / (1.f + expf(-o1)); }
            o0 *= scale; o1 *= scale;
            { int cls = c < C_RK ? 0 : c < C_RV ? 1 : c < C_RG ? 2 : c < C_DQ ? 3 : c < C_DK ? 4 : c < C_DV ? 5 : c < C_GQ ? 6 : c < C_GKV ? 7 : c < C_GATE ? (((c - C_GKV) & 127) < 64 ? 8 : 9) : 10;
              const int slot = 20 + cls * 2 + (latent ? 0 : 1);
              const float esc = 0.5f * scale;
              dbg_err(ctl, slot, dbg_bf(P, (size_t)row * DIN + c), o0, esc); dbg_err(ctl, slot, dbg_bf(P, (size_t)row * DIN + c + 1), o1, esc); }
        }
    } else if (stage == 4) {
        const unsigned hsh = dbg_hash(smp + 999u); const int h = hsh & 3; const int row = dbg_srcrow_any(smp); const bool latent = row < TL; const int b = latent ? row >> 12 : (row - TL) >> 8; const int tq = latent ? (row & 4095) : ((row - TL) & 255);
        const float lgf = dec[l * 8 + h], lgb = dec[l * 8 + 4 + h];
        if (t < 128) shv[t] = dbg_bf(P, (size_t)row * DIN + C_RQ + h * 128 + t);
        __syncthreads();
        const int pfq = latent ? 256 + tq : tq, pbq = latent ? 256 + 4095 - tq : 255 - tq;
        float o = 0.f;
        for (int sidx = 0; sidx < 4352; ++sidx) { const bool sl = sidx >= 256; const int sp = sl ? sidx - 256 : sidx; const int srow = sl ? b * 4096 + sp : TL + b * 256 + sp;
            if (!latent && sl) continue;
            const int pfs = sl ? 256 + sp : sp, pbs = sl ? 256 + 4095 - sp : 255 - sp;
            float wgt = 0.f; if (pfs <= pfq) wgt += exp2f(lgf * (float)(pfq - pfs)); if (pbs <= pbq) wgt += exp2f(lgb * (float)(pbq - pbs));
            if (wgt == 0.f) continue;
            float dot = 0.f; for (int d = 0; d < 128; ++d) dot += shv[d] * dbg_bf(P, (size_t)srow * DIN + C_RK + h * 128 + d);
            o += wgt * dot * dbg_bf(P, (size_t)srow * DIN + C_RV + h * 256 + t); }
        const float mu = dbg_block_sum(o, sh) / 256.f; const float var = dbg_block_sum((o - mu) * (o - mu), sh) / 256.f;
        const float y = (o - mu) / sqrtf(var + NORM_EPS) * dbg_bf(P, (size_t)row * DIN + C_RG + h * 256 + t);
        dbg_err(ctl, 4, dbg_bf(Y, (size_t)row * 2048 + h * 256 + t), y, 0.3f);
    } else if (stage == 5) {
        const unsigned hsh = dbg_hash(smp + 555u); const int h = hsh & 3; const int row = dbg_srcrow_any(smp); const bool latent = row < TL; const int b = latent ? row >> 12 : (row - TL) >> 8;
        if (t < 128) shv[t] = dbg_bf(P, (size_t)row * DIN + C_DQ + h * 128 + t);
        __syncthreads();
        float m1 = -1e30f, m2 = -1e30f;
        const int s0 = latent ? 0 : 4096;
        for (int sidx = s0; sidx < 4352; ++sidx) { const int srow = sidx < 4096 ? b * 4096 + sidx : TL + b * 256 + sidx - 4096; float d1 = 0.f, d2 = 0.f;
            for (int d = 0; d < 64; ++d) { d1 += shv[d] * dbg_bf(P, (size_t)srow * DIN + C_DK + h * 128 + d); d2 += shv[64 + d] * dbg_bf(P, (size_t)srow * DIN + C_DK + h * 128 + 64 + d); }
            m1 = fmaxf(m1, d1); m2 = fmaxf(m2, d2); }
        float l1 = 0.f, l2 = 0.f, o1 = 0.f, o2 = 0.f;
        for (int sidx = s0; sidx < 4352; ++sidx) { const int srow = sidx < 4096 ? b * 4096 + sidx : TL + b * 256 + sidx - 4096; float d1 = 0.f, d2 = 0.f;
            for (int d = 0; d < 64; ++d) { d1 += shv[d] * dbg_bf(P, (size_t)srow * DIN + C_DK + h * 128 + d); d2 += shv[64 + d] * dbg_bf(P, (size_t)srow * DIN + C_DK + h * 128 + 64 + d); }
            const float p1 = expf(d1 - m1), p2 = expf(d2 - m2); l1 += p1; l2 += p2; const float v = t < 128 ? dbg_bf(P, (size_t)srow * DIN + C_DV + h * 128 + t) : 0.f; o1 += p1 * v; o2 += p2 * v; }
        const float lam = dec[32 + l], li = dec[40 + l]; const float o = t < 128 ? o1 / l1 - lam * o2 / l2 : 0.f;
        const float ms = dbg_block_sum(o * o, sh) / 128.f;
        if (t < 128) { const float y = o / sqrtf(ms + NORM_EPS) * a.in[I_SUBLN][l * 128 + t] * (1.f - li); dbg_err(ctl, 5, dbg_bf(Y, (size_t)row * 2048 + 1024 + h * 128 + t), y, 0.4f); }
    } else if (stage == 6) {
        const unsigned hsh = dbg_hash(smp + 333u); const int head = hsh & 7, kvh = head >> 2; const int row = dbg_srcrow_any(smp); const bool latent = row < TL; const int b = latent ? row >> 12 : (row - TL) >> 8; const int tq = row & 4095;
        if (t < 64) shv[t] = dbg_bf(P, (size_t)row * DIN + C_GQ + head * 64 + t);
        __syncthreads();
        const float sink = a.in[I_SINK][l * 8 + head];
        float m = sink;
        for (int pass = 0; pass < 2; ++pass) { float lsum = 0.f, o = 0.f;
            for (int sidx = 0; sidx < 4352; ++sidx) { const bool sl = sidx >= 256; const int sp = sl ? sidx - 256 : sidx; if (sl && (!latent || sp < tq - 128 || sp > tq + 128)) continue;
                const int srow = sl ? b * 4096 + sp : TL + b * 256 + sp; float d = 0.f;
                for (int k = 0; k < 64; ++k) d += shv[k] * dbg_bf(P, (size_t)srow * DIN + C_GKV + kvh * 128 + k);
                if (pass == 0) m = fmaxf(m, d); else { const float p = expf(d - m); lsum += p; o += p * (t < 64 ? dbg_bf(P, (size_t)srow * DIN + C_GKV + kvh * 128 + 64 + t) : 0.f); } }
            if (pass == 1 && t < 64) { lsum += expf(sink - m); dbg_err(ctl, 6, dbg_bf(Y, (size_t)row * 2048 + 1536 + head * 64 + t), o / lsum, 0.15f); } }
    } else if (stage == 7) {
        const int row = dbg_srcrow_any(smp);
        for (int it = 0; it < 4; ++it) { const int col = it * 256 + t; float r = 0.f;
            for (int seg = 0; seg < 3; ++seg) { const int k0 = seg == 0 ? 0 : (seg == 1 ? 1024 : 1536), k1 = seg == 0 ? 1024 : (seg == 1 ? 1536 : 2048); float acc = 0.f;
                for (int k = k0; k < k1; ++k) acc += dbg_bf(Y, (size_t)row * 2048 + k) * a.in[I_WBR][((size_t)l * 2048 + k) * D + col];
                r += acc * dbg_bf(P, (size_t)row * DIN + C_GATE + seg * 1024 + col); }
            dbg_err(ctl, 7, dbg_bf((const bf16_t*)(ws + WS_MGB), (size_t)row * D + col), r, 0.25f); }
    } else if (stage == 8) {
        const int row = dbg_srcrow_any(smp); const float* x = row < TL ? a.in[I_X] + (size_t)row * D : a.in[I_CTX] + (size_t)(row - TL) * D; const int v = row_modv(row);
        for (int it = 0; it < 4; ++it) { const int col = it * 256 + t; float acc = 0.f;
            for (int k = 0; k < 1024; ++k) acc += dbg_bf((const bf16_t*)(ws + WS_MGB), (size_t)row * D + k) * a.in[I_WOUT][((size_t)l * D + k) * D + col];
            dbg_err(ctl, 8, ((const float*)(ws + WS_XRES))[(size_t)row * D + col], x[col] + mod[v * 6144 + 2048 + col] * acc, 0.5f); }
    } else if (stage == 9) {
        const int row = dbg_srcrow_any(smp); const float* x = (const float*)(ws + WS_XRES) + (size_t)row * D; const int v = row_modv(row);
        __shared__ float hx[1024]; __shared__ float act[1024]; __shared__ float totsh[1024]; __shared__ float lg[32]; __shared__ int tix[4]; __shared__ float twt[4];
        float ss = 0.f; for (int k = t; k < 1024; k += 256) ss += x[k] * x[k];
        ss = dbg_block_sum(ss, sh); const float rs = 1.f / sqrtf(ss / 1024.f + NORM_EPS);
        for (int k = t; k < 1024; k += 256) hx[k] = x[k] * rs * a.in[I_GFFN][l * 1024 + k] * (1.f + mod[v * 6144 + 4096 + k]) + mod[v * 6144 + 3072 + k];
        __syncthreads();
        if (t < 32) { float s = a.in[I_BR][l * 32 + t]; for (int k = 0; k < 1024; ++k) s += hx[k] * a.in[I_WR][((size_t)l * D + k) * 32 + t]; lg[t] = s; }
        __syncthreads();
        if (t == 0) { for (int k = 0; k < 4; ++k) { int bi = 0; float bv = -1e30f; for (int e = 0; e < 32; ++e) if (lg[e] > bv) { bv = lg[e]; bi = e; } tix[k] = bi; twt[k] = bv; lg[bi] = -1e30f; }
            float sm = 0.f; const float t0 = twt[0]; for (int k = 0; k < 4; ++k) { twt[k] = expf(twt[k] - t0); sm += twt[k]; } for (int k = 0; k < 4; ++k) twt[k] /= sm; }
        __syncthreads();
        for (int c = t; c < 1024; c += 256) totsh[c] = 0.f;
        for (int k = 0; k < 4; ++k) { const int e = tix[k]; const float wk_ = twt[k]; const float* wgu = a.in[I_WGU] + ((size_t)l * 32 + e) * 1024 * 2048; const float* wdn = a.in[I_WDN] + ((size_t)l * 32 + e) * 1024 * 1024;
            for (int it = 0; it < 4; ++it) { const int j = it * 256 + t; float g = a.in[I_BGU][((size_t)l * 32 + e) * 2048 + j], li = a.in[I_BGU][((size_t)l * 32 + e) * 2048 + 1024 + j];
                for (int kk = 0; kk < 1024; ++kk) { g += hx[kk] * wgu[(size_t)kk * 2048 + j]; li += hx[kk] * wgu[(size_t)kk * 2048 + 1024 + j]; }
                g = fminf(g, 7.f); li = fminf(fmaxf(li, -7.f), 7.f); act[j] = g / (1.f + expf(-1.702f * g)) * (li + 1.f); }
            __syncthreads();
#pragma unroll
            for (int it = 0; it < 4; ++it) { const int c = it * 256 + t; float y = a.in[I_BDN][((size_t)l * 32 + e) * 1024 + c]; for (int kk = 0; kk < 1024; ++kk) y += act[kk] * wdn[(size_t)kk * 1024 + c]; totsh[c] += wk_ * y; }
            __syncthreads(); }
#pragma unroll
        for (int it = 0; it < 4; ++it) { const int c = it * 256 + t; float f = 0.f; for (int k = 0; k < 4; ++k) f += dbg_bf((const bf16_t*)(ws + WS_YK), ((size_t)row * 4 + k) * D + c); dbg_err(ctl, 9, f, totsh[c], 0.3f); }
    }
}
__global__ void dbg_prim(Args a) {
    unsigned* ctl = (unsigned*)(a.ws + WS_CTL); const int lane = threadIdx.x & 63; const float v = (float)(lane * lane + 1);
    float tot = 0.f; for (int i = 0; i < 64; ++i) tot += (float)(i * i + 1);
    dbg_err(ctl, 10, wave_sum(v), tot, 0.f);
    const float ov = (float)((lane ^ 32) * (lane ^ 32) + 1);
    dbg_err(ctl, 11, xsum(v), v + ov, 0.f); dbg_err(ctl, 12, xmax(v), fmaxf(v, ov), 0.f); dbg_err(ctl, 13, xother(v, lane >> 5), ov, 0.f);
}
__global__ void dbg_report(Args a, int nstage) {
    unsigned* ctl = (unsigned*)(a.ws + WS_CTL);
    int idx = nstage; float ev = 0.f;
    const int order[36] = {10, 11, 12, 13, 0, 1, 20, 21, 22, 23, 24, 25, 26, 27, 28, 29, 30, 31, 32, 33, 34, 35, 36, 37, 38, 39, 40, 41, 3, 4, 5, 6, 7, 8, 9, -1};
    idx = 35;
    for (int kk = 0; kk < 35; ++kk) { const float e = __builtin_bit_cast(float, ctl[CW_DBG + order[kk]]); if (e > 0.08f) { idx = kk; ev = e; break; } }
    const float X = 100.f * (float)(1 + idx);
    const float c = sqrtf(X);
    for (size_t i = (size_t)blockIdx.x * blockDim.x + threadIdx.x; i < (size_t)TL * D; i += (size_t)gridDim.x * blockDim.x) a.out[i] = c;
}
#endif

extern "C" void kernel_launch(void* const* d_in, const int* in_sizes, int n_in, void* d_out, int out_size, void* d_ws, size_t ws_size, hipStream_t stream) {
    static int grid = 0;
    if (grid == 0) {
        if (n_in != 26 || out_size != TL * D || ws_size < WS_END) { fprintf(stderr, "kernel_launch: unexpected shapes (n_in %d out %d ws %zu need %zu)\n", n_in, out_size, ws_size, (size_t)WS_END); grid = -1; return; }
        int dev = 0, cus = 0, per_cu = 0;
        if (hipGetDevice(&dev) != hipSuccess || hipDeviceGetAttribute(&cus, hipDeviceAttributeMultiprocessorCount, dev) != hipSuccess) { grid = -1; return; }
        if (hipFuncSetAttribute((const void*)mk_fwd, hipFuncAttributeMaxDynamicSharedMemorySize, LDS_BYTES) != hipSuccess) { fprintf(stderr, "kernel_launch: hipFuncSetAttribute failed\n"); grid = -1; return; }
        if (hipOccupancyMaxActiveBlocksPerMultiprocessor(&per_cu, (const void*)mk_fwd, NTHR, LDS_BYTES) != hipSuccess || per_cu < 1) { fprintf(stderr, "kernel_launch: occupancy query says %d\n", per_cu); (void)hipGetLastError(); per_cu = 1; }
        grid = cus;
    }
    if (grid < 0) return;
    (void)hipMemsetAsync((char*)d_ws + WS_CTL, 0, CTL_ZERO_BYTES, stream);
    Args a{};
    for (int i = 0; i < 26; ++i) a.in[i] = (const float*)d_in[i];
    a.out = (float*)d_out; a.ws = (unsigned char*)d_ws;
#if MK_MULTI
    for (int p = 0; p < NPH; ++p) { a.ph_lo = p; a.ph_hi = p + 1; hipLaunchKernelGGL(mk_fwd, dim3(grid), dim3(NTHR), LDS_BYTES, stream, a);
#ifdef DBG_CHECK
        const int L = DBG_CHECK - 1, pb = 1 + 9 * L;
        if (p == 0) hipLaunchKernelGGL(dbg_prim, dim3(1), dim3(64), 0, stream, a);
        if (p == 0) hipLaunchKernelGGL(dbg_chk<0>, dim3(64), dim3(256), 0, stream, a, L);
        if (p == pb + 0 && L == 0) hipLaunchKernelGGL(dbg_chk<1>, dim3(64), dim3(256), 0, stream, a, L);
        if (p == pb + 1) hipLaunchKernelGGL(dbg_chk<2>, dim3(256), dim3(256), 0, stream, a, L);
        if (p == pb + 3) { hipLaunchKernelGGL(dbg_chk<4>, dim3(48), dim3(256), 0, stream, a, L); hipLaunchKernelGGL(dbg_chk<5>, dim3(48), dim3(256), 0, stream, a, L); hipLaunchKernelGGL(dbg_chk<6>, dim3(48), dim3(256), 0, stream, a, L); }
        if (p == pb + 4) hipLaunchKernelGGL(dbg_chk<7>, dim3(32), dim3(256), 0, stream, a, L);
        if (p == pb + 5 && L == 0) hipLaunchKernelGGL(dbg_chk<8>, dim3(32), dim3(256), 0, stream, a, L);
        if (p == pb + 8) hipLaunchKernelGGL(dbg_chk<9>, dim3(24), dim3(256), 0, stream, a, L);
        if (p == NPH - 1) hipLaunchKernelGGL(dbg_report, dim3(256), dim3(256), 0, stream, a, 10);
#endif
    }
#else
    a.ph_lo = 0; a.ph_hi = NPH;
    hipLaunchKernelGGL(mk_fwd, dim3(grid), dim3(NTHR), LDS_BYTES, stream, a);
#endif
}
```

```cpp
#include <hip/hip_runtime.h>
#include <cstdio>
#include <cstdint>

#define LAS __attribute__((address_space(3)))
#define GAS __attribute__((address_space(1)))
typedef unsigned short bf16_t;
typedef short bf16x8 __attribute__((ext_vector_type(8)));
typedef short s16x4 __attribute__((ext_vector_type(4)));
typedef float f32x2 __attribute__((ext_vector_type(2)));
typedef float f32x4 __attribute__((ext_vector_type(4)));
typedef float f32x16 __attribute__((ext_vector_type(16)));
typedef unsigned u32x2 __attribute__((ext_vector_type(2)));
typedef unsigned u32x4 __attribute__((ext_vector_type(4)));
typedef int v4i32 __attribute__((ext_vector_type(4)));
typedef int v8i32 __attribute__((ext_vector_type(8)));

#ifndef WIN_FP8
#define WIN_FP8 1
#endif
#ifndef BR_FP8
#define BR_FP8 0
#endif
#ifndef DUP_MASK
#define DUP_MASK 0
#endif
#ifndef MK_MULTI
#define MK_MULTI 0
#endif

constexpr int D = 1024, NB = 4, SEQ = 4096, DEPTH = 4, CTXL = 256;
constexpr int TL = NB * SEQ, TC = NB * CTXL, TT = TL + TC;
constexpr int DIN = 8448;
constexpr int C_RQ = 0, C_RK = 512, C_RV = 1024, C_RG = 2048, C_DQ = 3072, C_DK = 3584, C_DV = 4096, C_GQ = 4608, C_GKV = 5120, C_GATE = 5376;
constexpr int NEXP = 32, TOPK = 4, NASG = TT * TOPK;
constexpr int SLOT_TILES = 304, NSLOT = SLOT_TILES * 256;
constexpr int NCHUNK = 34;
constexpr float NORM_EPS = 1e-6f;
constexpr float LOG2E = 1.4426950408889634f;

constexpr size_t al256(size_t x) { return (x + 255) & ~(size_t)255; }
constexpr size_t WS_CTL = 0, CTL_ZERO_BYTES = 1u << 20;
constexpr size_t WS_MOD = CTL_ZERO_BYTES;
constexpr size_t WS_ROPE128 = al256(WS_MOD + (size_t)DEPTH * 5 * 6144 * 4);
constexpr size_t WS_ROPE64 = al256(WS_ROPE128 + 64 * 32 * 8);
constexpr size_t WS_DEC = al256(WS_ROPE64 + 64 * 16 * 8);
constexpr size_t WS_XRES = al256(WS_DEC + 1024);
constexpr size_t WS_H = al256(WS_XRES + (size_t)TT * D * 4);
constexpr size_t WS_P = al256(WS_H + (size_t)TT * D * 2);
constexpr size_t WS_KDF = al256(WS_P + (size_t)TT * DIN * 2);
constexpr size_t WS_KDB = al256(WS_KDF + (size_t)TT * 512 * 2);
constexpr size_t WS_ST = al256(WS_KDB + (size_t)TT * 512 * 2);
constexpr size_t WS_Y = al256(WS_ST + (size_t)NB * 4 * 2 * NCHUNK * 256 * 128 * 2);
constexpr size_t WS_MG = al256(WS_Y + (size_t)TT * 2048 * 2);
constexpr size_t WS_MGB = al256(WS_MG + (size_t)TT * D * 4);
constexpr size_t WS_ACT = al256(WS_MGB + (size_t)TT * D * 2);
constexpr size_t WS_YK = al256(WS_ACT + (size_t)NSLOT * D * 2);
constexpr size_t WS_LIST = al256(WS_YK + (size_t)NASG * D * 2);
constexpr size_t WS_TW = al256(WS_LIST + (size_t)NEXP * TT * 4);
constexpr size_t WS_WIN = al256(WS_TW + (size_t)NASG * 4);
constexpr size_t WS_WBR = al256(WS_WIN + (size_t)DEPTH * DIN * D * 2);
constexpr size_t WS_WOUT = al256(WS_WBR + (size_t)DEPTH * D * 2048 * 2);
constexpr size_t WS_WGU = al256(WS_WOUT + (size_t)DEPTH * D * D * 2);
constexpr size_t WS_WDN = al256(WS_WGU + (size_t)DEPTH * NEXP * 2048 * D * 2);
constexpr size_t WS_WRT = al256(WS_WDN + (size_t)DEPTH * NEXP * D * D * 2);
constexpr size_t WS_END = al256(WS_WRT + (size_t)DEPTH * 2 * NEXP * D * 2);
constexpr int CW_BAR = 4096;
constexpr int CW_CNT = 8192;

constexpr int LDS_MAIN = 139264;
constexpr int LDS_MISC = LDS_MAIN;
constexpr int LDS_BYTES = LDS_MAIN + 256;
constexpr int NTHR = 512;

typedef __bf16 bf16x2_t __attribute__((ext_vector_type(2)));
__device__ __forceinline__ unsigned cvt_pk_bf16(float lo, float hi) { const f32x2 v = {lo, hi}; return __builtin_bit_cast(unsigned, __builtin_convertvector(v, bf16x2_t)); }
__device__ __forceinline__ unsigned pk_fp8x4(float a, float b, float c, float d) { unsigned w = 0u; w = __builtin_amdgcn_cvt_pk_fp8_f32(a, b, w, false); w = __builtin_amdgcn_cvt_pk_fp8_f32(c, d, w, true); return w; }
__device__ __forceinline__ float bf2f(unsigned short x) { return __builtin_bit_cast(float, (unsigned)x << 16); }
__device__ __forceinline__ float bflo(unsigned x) { return __builtin_bit_cast(float, x << 16); }
__device__ __forceinline__ float bfhi(unsigned x) { return __builtin_bit_cast(float, x & 0xffff0000u); }
__device__ __forceinline__ float fexp2(float x) { return __builtin_amdgcn_exp2f(x); }
__device__ __forceinline__ float frcp(float x) { return __builtin_amdgcn_rcpf(x); }
__device__ __forceinline__ float sigmoidf_(float x) { return frcp(1.f + fexp2(-x * LOG2E)); }
template <int CTRL> __device__ __forceinline__ float dpp_f(float v) { return __builtin_bit_cast(float, __builtin_amdgcn_update_dpp(0, __builtin_bit_cast(int, v), CTRL, 0xf, 0xf, false)); }
__device__ __forceinline__ f32x2 halves(float v) {
    unsigned va = __builtin_bit_cast(unsigned, v), vb = va;
    asm volatile("v_nop\n\tv_nop\n\tv_permlane32_swap_b32 %0, %1" : "+v"(va), "+v"(vb));
    return (f32x2){__builtin_bit_cast(float, va), __builtin_bit_cast(float, vb)}; }
__device__ __forceinline__ float xsum(float v) { const f32x2 h = halves(v); return h.x + h.y; }
__device__ __forceinline__ float xmax(float v) { const f32x2 h = halves(v); return fmaxf(h.x, h.y); }
__device__ __forceinline__ int lane_now() { int l; asm volatile("v_mbcnt_lo_u32_b32 %0, -1, 0\n\tv_mbcnt_hi_u32_b32 %0, -1, %0" : "=v"(l)); return l; }
__device__ __forceinline__ int tid_now(int wave) { return (wave << 6) | lane_now(); }
__device__ __forceinline__ int opaque_lane() { int l = lane_now(); asm volatile("" : "+v"(l)); return l; }
__device__ __forceinline__ float shx(float v, int mask, int lane) { return __builtin_bit_cast(float, __builtin_amdgcn_ds_bpermute((lane ^ mask) << 2, __builtin_bit_cast(int, v))); }
__device__ __forceinline__ float xother(float v, int) { return shx(v, 32, opaque_lane()); }
__device__ __forceinline__ float wave_sum(float v) {
    const int l = opaque_lane();
#pragma unroll
    for (int o = 1; o < 64; o <<= 1) v += shx(v, o, l);
    return v;
}
#define XB_TMO      128
#define XB_XCNT(j)  (256  + 64 * (j))
#define XB_XSUB(j)  (1280 + 64 * (j))
#define XB_XGEN(j)  (2304 + 64 * (j))
#define XB_TOP      3328
#define XB_TOPGEN   3392
#define XCD_BAR_WORDS 3456
#define XB_SPIN_CAP (1u << 27)
__device__ __forceinline__ unsigned xb_ld(unsigned* p)              { return __hip_atomic_load(p, __ATOMIC_RELAXED, __HIP_MEMORY_SCOPE_AGENT); }
__device__ __forceinline__ unsigned xb_add(unsigned* p, unsigned v) { return __hip_atomic_fetch_add(p, v, __ATOMIC_RELAXED, __HIP_MEMORY_SCOPE_AGENT); }
__device__ __forceinline__ unsigned xb_xcc_id() { return (unsigned)__builtin_amdgcn_s_getreg((3 << 11) | 20) & 0xFu; }
#define XB_SPIN(cond, bar) do { unsigned _sp = 0; while (cond) { __builtin_amdgcn_s_sleep(1); \
    if ((++_sp & 255u) == 0u) { if (xb_ld(&(bar)[XB_TMO])) break; if (_sp > XB_SPIN_CAP) { atomicAdd(&(bar)[XB_TMO], 1u); break; } } } } while (0)
extern __shared__ __attribute__((aligned(16))) unsigned char lds_dyn_base[];
struct XcdBarrier { unsigned* bar; unsigned x; int wv; };
#define XB_ST ((volatile LAS unsigned*)((LAS unsigned char*)lds_dyn_base + LDS_MISC))
__device__ __forceinline__ XcdBarrier xcd_barrier_post(unsigned* bar, volatile LAS unsigned* st) {
    XcdBarrier b; b.bar = bar; b.x = xb_xcc_id(); b.wv = 0; (void)st;
    if (threadIdx.x == 0) (void)xb_add(&bar[XB_XCNT(b.x)], 1u);
    return b;
}
__device__ __forceinline__ void xcd_barrier_complete(unsigned* bar, unsigned x, unsigned& nloc, unsigned& nx) {
    const unsigned G = gridDim.x * gridDim.y * gridDim.z;
    unsigned sum, cnt, mine, sp = 0u;
    for (;;) {
        sum = 0u; cnt = 0u; mine = 0u;
#pragma unroll
        for (unsigned j = 0; j < 16; ++j) { const unsigned c = xb_ld(&bar[XB_XCNT(j)]); sum += c; cnt += (c > 0u) ? 1u : 0u; mine = (j == x) ? c : mine; }
        if (sum == G) break;
        __builtin_amdgcn_s_sleep(1);
        if ((++sp & 255u) == 0u) { if (xb_ld(&bar[XB_TMO])) break; if (sp > XB_SPIN_CAP) { atomicAdd(&bar[XB_TMO], 1u); break; } }
    }
    nloc = mine > 0u ? mine : 1u; nx = cnt > 0u ? cnt : 1u;
}
__device__ __forceinline__ void xcd_barrier(const XcdBarrier& b) {
    asm volatile("s_waitcnt vmcnt(0)" ::: "memory");
    __syncthreads();
    if (b.wv == 0 && lane_now() == 0) {
        unsigned* bar = b.bar;
        __builtin_amdgcn_s_waitcnt(0);
        unsigned nloc = XB_ST[0], nx = XB_ST[1];
        if (nloc == 0u) { xcd_barrier_complete(bar, b.x, nloc, nx); XB_ST[0] = nloc; XB_ST[1] = nx; }
        const unsigned old = xb_add(&bar[XB_XSUB(b.x)], 1u);
        const unsigned gen = old / nloc;
        if (old + 1u == (gen + 1u) * nloc) {
            __builtin_amdgcn_fence(__ATOMIC_RELEASE, "agent");
            asm volatile("s_waitcnt vmcnt(0)" ::: "memory");
            const unsigned og = xb_add(&bar[XB_TOP], 1u);
            const unsigned tg = og / nx;
            if (og + 1u == (tg + 1u) * nx) xb_add(&bar[XB_TOPGEN], 1u);
            else XB_SPIN(xb_ld(&bar[XB_TOPGEN]) == tg, bar);
            __builtin_amdgcn_fence(__ATOMIC_ACQUIRE, "agent");
            xb_add(&bar[XB_XGEN(b.x)], 1u);
            asm volatile("s_waitcnt vmcnt(0)" ::: "memory");
        } else {
            XB_SPIN(xb_ld(&bar[XB_XGEN(b.x)]) == gen, bar);
            __builtin_amdgcn_fence(__ATOMIC_ACQUIRE, "agent");
            asm volatile("s_waitcnt vmcnt(0)" ::: "memory");
        }
    }
    __syncthreads();
}

template <class T> __device__ __forceinline__ T* pin(T* p_) { const unsigned long long v_ = (unsigned long long)p_;
    return (T*)(((unsigned long long)(unsigned)__builtin_amdgcn_readfirstlane((int)(unsigned)(v_ >> 32)) << 32) | (unsigned)__builtin_amdgcn_readfirstlane((int)(unsigned)v_)); }
namespace gm {
constexpr int BM = 256, BK = 64, HALF = 128, HTB = HALF * BK * 2, STAGE_BYTES = 8 * HTB;
__device__ __forceinline__ int lds_byte(int r, int c) { const int st = (r >> 4) * 2 + (c >> 5), rr = r & 15, cc = c & 31, ob = rr * 64 + cc * 2; return st * 1024 + (ob ^ (((ob >> 9) & 1) << 5)); }
__device__ __forceinline__ void stage_rc(int b, int& R, int& C) { const int st = b / 1024, sb = b % 1024, swz = sb ^ (((sb >> 9) & 1) << 5); R = (st >> 1) * 16 + swz / 64; C = (st & 1) * 32 + (swz % 64) / 2; }
__device__ __forceinline__ int perm32(int rho) { const int n = rho >> 4, i = rho & 15; return 8 * (i >> 2) + 4 * n + (i & 3); }

struct GU {
    unsigned A;
    unsigned B;
    int nt;
    int pm, pn, e0, e1;
};

template <class Epi, class Sched, bool GATHER, bool FP8 = false>
__device__ __forceinline__ void gemm_phase(LAS unsigned char* lds, const Sched& S, const Epi& E, const int lda, const int ldb, const int wv) {
    int tid_ = tid_now(wv); asm volatile("" : "+v"(tid_));
    const int tid = tid_, wid = __builtin_amdgcn_readfirstlane(tid >> 6), lane = tid & 63, wr = wid >> 2, wc = wid & 3, fr = lane & 15, fq = lane >> 4;
    int sR[2], sC[2];
    unsigned voffB[2], cvA[2][2], nvA[2][2];
#pragma unroll
    for (int i = 0; i < 2; ++i) { stage_rc(tid * 16 + i * 8192, sR[i], sC[i]); const int Rb = (sR[i] & ~31) + perm32(sR[i] & 31);
        voffB[i] = (unsigned)(Rb * ldb + sC[i] * 2); cvA[0][i] = (unsigned)(sR[i] * lda + sC[i] * 2); cvA[1][i] = cvA[0][i]; nvA[0][i] = cvA[0][i]; nvA[1][i] = cvA[0][i]; }
    const unsigned kstep = (unsigned)(BK * 2);
    const unsigned hstepB = (unsigned)(HALF * ldb), hstepA = GATHER ? 0u : (unsigned)(HALF * lda);
    const unsigned ldsw = (unsigned)wid * 1024u;
    const int aoff = lds_byte(wr * 64 + fr, fq * (FP8 ? 16 : 8)), boff = lds_byte(wc * 32 + fr, fq * (FP8 ? 16 : 8));
    auto rfl64 = [](const char* p_) { const unsigned long long v_ = (unsigned long long)p_; return (const char*)(((unsigned long long)(unsigned)__builtin_amdgcn_readfirstlane((int)(unsigned)(v_ >> 32)) << 32) | (unsigned)__builtin_amdgcn_readfirstlane((int)(unsigned)v_)); };
    const char* const baseA = rfl64(S.baseA()); const char* const baseB = rfl64(S.baseB());
    int nr_, fl_; asm volatile("s_mov_b32 %0, 0x7fffffff\n\ts_mov_b32 %1, 0x20000" : "=s"(nr_), "=s"(fl_));
    const __amdgpu_buffer_rsrc_t rsA = __builtin_amdgcn_make_buffer_rsrc((void*)baseA, 0, nr_, fl_), rsB = __builtin_amdgcn_make_buffer_rsrc((void*)baseB, 0, nr_, fl_);
#define G_SA(b, h) (((b) * 2 + (h)) * HTB)
#define G_SB(b, h) ((4 + (b) * 2 + (h)) * HTB)
#define G_STAGE2(bufoff, rs, so, o0, o1) do { \
        __builtin_amdgcn_raw_ptr_buffer_load_lds(rs, (LAS void*)(lds + (bufoff) + ldsw), 16, (int)(o0), (int)(so), 0, 0); \
        __builtin_amdgcn_raw_ptr_buffer_load_lds(rs, (LAS void*)(lds + (bufoff) + ldsw + 8192), 16, (int)(o1), (int)(so), 0, 0); } while (0)
#define G_STB(bufoff, so) G_STAGE2(bufoff, rsB, so, voffB[0], voffB[1])
#define G_STA(bufoff, so, h, o0, o1) G_STAGE2(bufoff, rsA, (so) + (h) * hstepA, o0, o1)
#define G_LD16(off_) (*(const LAS v4i32*)(lds + (off_)))
#define G_LDA(dst, b, h) do { if constexpr (FP8) { LAS unsigned char* pa_ = lds + G_SA(b, h) + aoff; asm volatile("" : "+v"(pa_));   \
            _Pragma("unroll") for (int m = 0; m < 4; ++m) dst##8[m] = __builtin_shufflevector(*(const LAS v4i32*)(pa_ + m * 2048), *(const LAS v4i32*)(pa_ + m * 2048 + 16), 0, 1, 2, 3, 4, 5, 6, 7); } \
        else { _Pragma("unroll") for (int m = 0; m < 4; ++m) _Pragma("unroll") for (int k = 0; k < 2; ++k) dst[m][k] = *(const LAS bf16x8*)(lds + G_SA(b, h) + aoff + m * 2048 + k * 1024); } } while (0)
#define G_LDB(dst, b, h) do { if constexpr (FP8) { LAS unsigned char* pb_ = lds + G_SB(b, h) + boff; asm volatile("" : "+v"(pb_)); \
            _Pragma("unroll") for (int n = 0; n < 2; ++n) dst##8[n] = __builtin_shufflevector(*(const LAS v4i32*)(pb_ + n * 2048), *(const LAS v4i32*)(pb_ + n * 2048 + 16), 0, 1, 2, 3, 4, 5, 6, 7); } \
        else { _Pragma("unroll") for (int n = 0; n < 2; ++n) _Pragma("unroll") for (int k = 0; k < 2; ++k) dst[n][k] = *(const LAS bf16x8*)(lds + G_SB(b, h) + boff + n * 2048 + k * 1024); } } while (0)
#define G_MMA(ai, bj, At, Bt) do { __builtin_amdgcn_s_setprio(1); \
        if constexpr (FP8) { _Pragma("unroll") for (int m = 0; m < 4; ++m) _Pragma("unroll") for (int n = 0; n < 2; ++n) \
            acc[ai][bj][m][n] = __builtin_amdgcn_mfma_scale_f32_16x16x128_f8f6f4(Bt##8[n], At##8[m], acc[ai][bj][m][n], 0, 0, 0, 0x7F7F7F7F, 0, 0x7F7F7F7F); } \
        else { _Pragma("unroll") for (int m = 0; m < 4; ++m) _Pragma("unroll") for (int n = 0; n < 2; ++n) _Pragma("unroll") for (int k = 0; k < 2; ++k) \
            acc[ai][bj][m][n] = __builtin_amdgcn_mfma_f32_16x16x32_bf16(Bt[n][k], At[m][k], acc[ai][bj][m][n], 0, 0, 0); } \
        __builtin_amdgcn_s_setprio(0); } while (0)
#define G_WAIT_V(n) asm volatile("s_waitcnt vmcnt(" #n ")" ::: "memory")
#define G_WAIT_L(n) asm volatile("s_waitcnt lgkmcnt(" #n ")" ::: "memory")
#define G_BAR __builtin_amdgcn_s_barrier()
#define G_SCHED __builtin_amdgcn_sched_barrier(0)
    GU cur, nxt; int ui = 0;
    if (!S.next(0, cur)) return;
    if constexpr (GATHER) { S.gather(cur, cvA); }
    S.a_ready(cur);
    f32x4 acc[2][2][4][2];
#pragma unroll
    for (int a = 0; a < 2; ++a)
#pragma unroll
        for (int b = 0; b < 2; ++b)
#pragma unroll
            for (int m = 0; m < 4; ++m)
#pragma unroll
                for (int n = 0; n < 2; ++n) acc[a][b][m][n] = (f32x4){0.f, 0.f, 0.f, 0.f};
    bf16x8 At[4][2], B0[2][2], B1[2][2];
    v8i32 At8[4], B08[2], B18[2];
    (void)At; (void)B0; (void)B1; (void)At8; (void)B08; (void)B18;
    unsigned cA = (unsigned)__builtin_amdgcn_readfirstlane((int)cur.A), cB = (unsigned)__builtin_amdgcn_readfirstlane((int)cur.B);
    G_STB(G_SB(0, 0), cB); G_STB(G_SB(0, 1), cB + hstepB); G_STA(G_SA(0, 0), cA, 0, cvA[0][0], cvA[0][1]); G_STA(G_SA(0, 1), cA, 1, cvA[1][0], cvA[1][1]);
    if (wr == 1) G_BAR;
    G_WAIT_V(2); G_BAR;
    G_STB(G_SB(1, 0), cB + kstep); G_STA(G_SA(1, 0), cA + kstep, 0, cvA[0][0], cvA[0][1]); G_STB(G_SB(1, 1), cB + hstepB + kstep);
    G_WAIT_V(6); G_BAR;
    for (;;) {
        const bool has_next = S.next(ui + 1, nxt);
        if (has_next) { if constexpr (GATHER) S.gather(nxt, nvA); }
        const unsigned nA = (unsigned)__builtin_amdgcn_readfirstlane((int)(has_next ? nxt.A : cA)), nB = (unsigned)__builtin_amdgcn_readfirstlane((int)(has_next ? nxt.B : cB));
        int nt = cur.nt; asm volatile("" : "+s"(nt));
#pragma unroll 1
        for (int t = 0; t < nt; t += 2) {
            const bool last = (t == nt - 2);
            const int km = ((DUP_MASK & 16384) && Epi::DUPK) ? (nt >> 1) - 1 : 0x7fff;
            const unsigned a1 = cA + (unsigned)((t + 1) & km) * kstep;
            const unsigned a2 = last ? nA : cA + (unsigned)((t + 2) & km) * kstep, b2 = last ? nB : cB + (unsigned)((t + 2) & km) * kstep;
            const unsigned a3 = a2 + kstep, b3 = b2 + kstep;
            unsigned x00, x01, x10, x11;
            if (last && has_next) S.a_ready(nxt);
            if (GATHER && last && has_next) { x00 = nvA[0][0]; x01 = nvA[0][1]; x10 = nvA[1][0]; x11 = nvA[1][1]; } else { x00 = cvA[0][0]; x01 = cvA[0][1]; x10 = cvA[1][0]; x11 = cvA[1][1]; }
            G_LDB(B0, 0, 0); G_LDB(B1, 0, 1); G_SCHED; G_LDA(At, 0, 0); G_STA(G_SA(1, 1), a1, 1, cvA[1][0], cvA[1][1]);
            G_WAIT_V(8); G_WAIT_L(0); G_BAR; G_MMA(0, 0, At, B0); G_MMA(0, 1, At, B1); G_BAR; G_SCHED;
            G_LDA(At, 0, 1); G_STB(G_SB(0, 0), b2); G_STB(G_SB(0, 1), b2 + hstepB); G_STA(G_SA(0, 0), a2, 0, x00, x01);
            G_WAIT_V(8); G_WAIT_L(0); G_BAR; G_MMA(1, 0, At, B0); G_MMA(1, 1, At, B1); G_BAR; G_SCHED;
            G_LDB(B0, 1, 0); G_LDB(B1, 1, 1); G_SCHED; G_LDA(At, 1, 0); G_STA(G_SA(0, 1), a2, 1, x10, x11);
            G_WAIT_V(8); G_WAIT_L(0); G_BAR; G_MMA(0, 0, At, B0); G_MMA(0, 1, At, B1); G_BAR; G_SCHED;
            G_LDA(At, 1, 1); G_STB(G_SB(1, 0), b3); G_STB(G_SB(1, 1), b3 + hstepB); G_STA(G_SA(1, 0), a3, 0, x00, x01);
            G_WAIT_V(8); G_WAIT_L(0); G_BAR; G_MMA(1, 0, At, B0); G_MMA(1, 1, At, B1); G_BAR; G_SCHED;
        }
        if (wr == 0) G_BAR;
        { int t2_ = lane_now(); asm volatile("" : "+v"(t2_)); const int fr_ = t2_ & 15, fq_ = (t2_ & 63) >> 4; E(acc, cur, wr, wc, fr_, fq_);
          if (Epi::DUPE) { asm volatile("" : "+v"(t2_)); const int fr2_ = t2_ & 15, fq2_ = (t2_ & 63) >> 4; E(acc, cur, wr, wc, fr2_, fq2_); } }
        S.done(cur);
        if (!has_next) break;
        if (!(Epi::CHAIN && cur.e1)) {
#pragma unroll
        for (int a = 0; a < 2; ++a)
#pragma unroll
            for (int b = 0; b < 2; ++b)
#pragma unroll
                for (int m = 0; m < 4; ++m)
#pragma unroll
                    for (int n = 0; n < 2; ++n) acc[a][b][m][n] = (f32x4){0.f, 0.f, 0.f, 0.f};
        }
        cur = nxt; cA = nA; cB = nB; ++ui;
        if constexpr (GATHER) {
#pragma unroll
            for (int h = 0; h < 2; ++h)
#pragma unroll
                for (int i = 0; i < 2; ++i) cvA[h][i] = nvA[h][i];
        }
        if (wr == 1) G_BAR;
    }
    G_WAIT_V(0);
    G_BAR;
#undef G_SA
#undef G_SB
#undef G_STAGE2
#undef G_STB
#undef G_STA
#undef G_LDA
#undef G_LDB
#undef G_MMA
#undef G_WAIT_V
#undef G_WAIT_L
#undef G_BAR
#undef G_SCHED
}
}

struct Frame {
    LAS unsigned char* lds;
    int tid, lane, wave, G, bid;
    unsigned char* ws;
    unsigned* ctl;
    const float* const* in;
    float* out;
};
enum { I_X = 0, I_C, I_CTX, I_CCTX, I_WMOD, I_BMOD, I_GMIX, I_GFFN, I_WIN, I_RDF, I_RDB, I_LQ1, I_LK1, I_LQ2, I_LK2, I_SUBLN, I_SINK, I_WBR, I_WOUT, I_WR, I_BR, I_WGU, I_BGU, I_WDN, I_BDN, I_GFIN };

__device__ __forceinline__ int row_modv(int row) { return row < TL ? (row >> 12) : 4; }
__device__ __forceinline__ const float* modp(const Frame& F, int l, int v, int part) { return (const float*)(F.ws + WS_MOD) + ((size_t)(l * 5 + v) * 6 + part) * 1024; }

__device__ __forceinline__ unsigned swz(unsigned r) { return ((r & 3u) << 2) | ((r >> 2) & 3u); }
__device__ __forceinline__ unsigned img_off(unsigned row, unsigned ch) { return 256u * row + 16u * (ch ^ swz(row)); }
__device__ __forceinline__ void dma4(LAS unsigned char* img, int idx, const char* g0, unsigned stride, int lane) {
    const unsigned q4 = (unsigned)lane >> 4, ch = (((unsigned)lane & 15u) ^ (q4 << 2)) ^ ((unsigned)idx & 3u);
    __builtin_amdgcn_global_load_lds((const unsigned*)(g0 + (q4 * stride + 16u * ch)), (LAS unsigned*)(img + 1024u * (unsigned)idx), 16, 0, 0);
}
#define DMA4(img, idx, ROWPTR) dma4((img), (idx), (const char*)(ROWPTR(4 * (idx))), DIN * 2, dl)
#define DMA4S(img, idx, ROWPTR, stride) dma4((img), (idx), (const char*)(ROWPTR(4 * (idx))), (stride), dl)
#define DMA_LANE() int dl = lane; asm volatile("" : "+v"(dl))
struct LA { unsigned rowb, trn, trp; };
__device__ __forceinline__ LA make_la(int lane) {
    const unsigned r32 = lane & 31, hh = (unsigned)lane >> 5, blk = ((unsigned)lane >> 4) & 1u, q = ((unsigned)lane & 15u) >> 2, p = (unsigned)lane & 3u;
    LA a; a.rowb = 256u * r32 + 16u * swz(r32);
    a.trn = 256u * (8u * hh + q) + 16u * ((2u * blk + (p >> 1)) ^ ((q << 2) | (2u * hh))) + 8u * (p & 1u);
    a.trp = 256u * (4u * hh + q) + 16u * ((2u * blk + (p >> 1)) ^ ((q << 2) | hh)) + 8u * (p & 1u);
    return a;
}
#define OPAQUE(x) asm volatile("" : "+v"(x))
__device__ __forceinline__ bf16x8 frag_row(LAS unsigned char* img, unsigned rowb, unsigned R0, unsigned ch) { return *(const LAS bf16x8*)(img + 256u * R0 + (rowb ^ (16u * ch))); }
__device__ __forceinline__ s16x4 tr4(LAS unsigned char* p) { return __builtin_bit_cast(s16x4, __builtin_amdgcn_ds_read_tr16_b64_v4i16((LAS s16x4*)p)); }
__device__ __forceinline__ bf16x8 frag_trn(LAS unsigned char* img, unsigned trn, unsigned R0, unsigned c, unsigned cb0) {
    const s16x4 lo = tr4(img + 256u * R0 + (trn ^ (16u * (cb0 + 4u * c)))), hi = tr4(img + 256u * (R0 + 4u) + (trn ^ (16u * ((cb0 + 4u * c) ^ 1u))));
    return (bf16x8){lo[0], lo[1], lo[2], lo[3], hi[0], hi[1], hi[2], hi[3]};
}
__device__ __forceinline__ bf16x8 frag_trp(LAS unsigned char* img, unsigned trp, unsigned R0, unsigned c, unsigned cb0) {
    const s16x4 lo = tr4(img + 256u * R0 + (trp ^ (16u * (cb0 + 4u * c)))), hi = tr4(img + 256u * (R0 + 8u) + (trp ^ (16u * ((cb0 + 4u * c) ^ 2u))));
    return (bf16x8){lo[0], lo[1], lo[2], lo[3], hi[0], hi[1], hi[2], hi[3]};
}
__device__ __forceinline__ bf16x8 pack8(const f32x16& v, int o) {
    u32x4 w; w.x = cvt_pk_bf16(v[o], v[o + 1]); w.y = cvt_pk_bf16(v[o + 2], v[o + 3]); w.z = cvt_pk_bf16(v[o + 4], v[o + 5]); w.w = cvt_pk_bf16(v[o + 6], v[o + 7]);
    return __builtin_bit_cast(bf16x8, w);
}
__device__ __forceinline__ int crow(int r, int hh) { return (r & 3) + 8 * (r >> 2) + 4 * hh; }
#define MFMA32(a, b, c) __builtin_amdgcn_mfma_f32_32x32x16_bf16((a), (b), (c), 0, 0, 0)
#define VMWAIT0() asm volatile("s_waitcnt vmcnt(0)" ::: "memory")

template <int MAP>
__device__ __forceinline__ int rowmap(int n) {
    if (MAP == 1) {
        if (n < 1024) { const int i = n & 127; return (n & ~127) + (i < 64 ? 2 * i : 2 * (i - 64) + 1); }
        if ((n >= C_DQ && n < C_DV) || (n >= C_GQ && n < C_GKV)) { const int i = n & 63; return (n & ~63) + (i < 32 ? 2 * i : 2 * (i - 32) + 1); }
        if (n >= C_GKV && n < C_GKV + 128) { const int kvh = (n - C_GKV) >> 6, i = n & 63; return C_GKV + kvh * 128 + (i < 32 ? 2 * i : 2 * (i - 32) + 1); }
        if (n >= C_GKV + 128 && n < C_GATE) { const int kvh = (n - C_GKV - 128) >> 6, i = n & 63; return C_GKV + kvh * 128 + 64 + i; }
        return n;
    }
    if (MAP == 2) return n < 1024 ? 2 * n : 2 * (n - 1024) + 1;
    return n;
}
template <int MAP, bool OUT8 = false>
__device__ __forceinline__ void transpose_item(const float* W, int K, int N, bf16_t* WT, LAS float* scr, int item, int lane) {
    const int nblk = N / 64, kb = item / nblk, nb = item % nblk, k0 = 64 * kb, n0 = 64 * nb;
    const int lr = lane >> 4, lc = (lane & 15) * 4;
    f32x4 v[16];
#pragma unroll
    for (int i = 0; i < 16; ++i) v[i] = *(const f32x4*)(W + (size_t)(k0 + 4 * i + lr) * N + n0 + lc);
#pragma unroll
    for (int i = 0; i < 16; ++i) *(LAS f32x4*)(scr + (4 * i + lr) * 64 + (lc ^ (8 * ((i >> 1) & 3)))) = v[i];
    asm volatile("s_waitcnt lgkmcnt(0)" ::: "memory");
    const int c = lane & 7;
#pragma unroll
    for (int j = 0; j < 8; ++j) { const int n = (lane >> 3) + 8 * j; const LAS float* s_ = scr + (8 * c) * 64 + (n ^ (8 * (c & 3)));
        if constexpr (OUT8) {
            *(u32x2*)((unsigned char*)WT + (size_t)rowmap<MAP>(n0 + n) * K + k0 + 8 * c) = (u32x2){pk_fp8x4(s_[0 * 64] * 32.f, s_[1 * 64] * 32.f, s_[2 * 64] * 32.f, s_[3 * 64] * 32.f), pk_fp8x4(s_[4 * 64] * 32.f, s_[5 * 64] * 32.f, s_[6 * 64] * 32.f, s_[7 * 64] * 32.f)};
        } else {
        u32x4 o; o.x = cvt_pk_bf16(s_[0 * 64], s_[1 * 64]); o.y = cvt_pk_bf16(s_[2 * 64], s_[3 * 64]); o.z = cvt_pk_bf16(s_[4 * 64], s_[5 * 64]); o.w = cvt_pk_bf16(s_[6 * 64], s_[7 * 64]);
        *(u32x4*)(WT + (size_t)rowmap<MAP>(n0 + n) * K + k0 + 8 * c) = o; } }
    asm volatile("s_waitcnt lgkmcnt(0)" ::: "memory");
}
constexpr int CV_IN = 16 * (DIN / 64), CV_BRN = 32 * 16, CV_OUT = 16 * 16, CV_GU = 16 * 32, CV_DN = 16 * 16;
constexpr int CV_PER_L = CV_IN + CV_BRN + CV_OUT + NEXP * (CV_GU + CV_DN);
constexpr int CW_R1 = 8192 + 1024;
constexpr int CW_Q = 8192 + 512;
constexpr int CW_LONG = CW_Q + 64;
__device__ __forceinline__ void conv_item(Frame& F, int l, int r, LAS float* scr) {
    if (r < CV_IN) { if (WIN_FP8) transpose_item<1, true>(F.in[I_WIN] + (size_t)l * D * DIN, D, DIN, (bf16_t*)(F.ws + WS_WIN + (size_t)l * DIN * D), scr, r, F.lane);
        else transpose_item<1>(F.in[I_WIN] + (size_t)l * D * DIN, D, DIN, (bf16_t*)(F.ws + WS_WIN) + (size_t)l * DIN * D, scr, r, F.lane); return; } r -= CV_IN;
    if (r < CV_BRN) { if (BR_FP8) transpose_item<0, true>(F.in[I_WBR] + (size_t)l * 2048 * D, 2048, D, (bf16_t*)(F.ws + WS_WBR + (size_t)l * D * 2048), scr, r, F.lane);
        else transpose_item<0>(F.in[I_WBR] + (size_t)l * 2048 * D, 2048, D, (bf16_t*)(F.ws + WS_WBR) + (size_t)l * D * 2048, scr, r, F.lane); return; } r -= CV_BRN;
    if (r < CV_OUT) { if (BR_FP8) transpose_item<0, true>(F.in[I_WOUT] + (size_t)l * D * D, D, D, (bf16_t*)(F.ws + WS_WOUT + (size_t)l * D * D), scr, r, F.lane);
        else transpose_item<0>(F.in[I_WOUT] + (size_t)l * D * D, D, D, (bf16_t*)(F.ws + WS_WOUT) + (size_t)l * D * D, scr, r, F.lane); return; } r -= CV_OUT;
    const int e = r / (CV_GU + CV_DN); r %= (CV_GU + CV_DN);
    if (r < CV_GU) transpose_item<2, true>(F.in[I_WGU] + ((size_t)l * NEXP + e) * D * 2048, D, 2048, (bf16_t*)(F.ws + WS_WGU + ((size_t)l * NEXP + e) * 2048 * D), scr, r, F.lane);
    else transpose_item<0, true>(F.in[I_WDN] + ((size_t)l * NEXP + e) * D * D, D, D, (bf16_t*)(F.ws + WS_WDN + ((size_t)l * NEXP + e) * D * D), scr, r - CV_GU, F.lane);
}
__device__ __forceinline__ bool conv_chunk(Frame& F, int l, const unsigned* stop, unsigned stop_at) {
    volatile LAS int* slot = (volatile LAS int*)(F.lds + LDS_MISC + 64);
    __syncthreads();
    if (F.tid == 0) { int base = -1;
        if (!(stop && __hip_atomic_load(stop, __ATOMIC_RELAXED, __HIP_MEMORY_SCOPE_AGENT) >= stop_at)) { base = (int)__hip_atomic_fetch_add(F.ctl + CW_Q + l, 8u, __ATOMIC_RELAXED, __HIP_MEMORY_SCOPE_AGENT); if (base >= CV_PER_L) base = -1; }
        *slot = base; }
    __syncthreads();
    const int base = *slot;
    if (base < 0) return false;
    if (base + F.wave < CV_PER_L) conv_item(F, l, base + F.wave, (LAS float*)(F.lds + F.wave * 16384));
    return true;
}
__device__ __forceinline__ void p0_prologue(Frame& F) {
    const int gw = F.bid * 8 + F.wave, NGW = F.G * 8;
    {
        LAS float* sc = (LAS float*)F.lds;
        LAS float* red = sc + 5 * 1024;
        for (int i = F.tid; i < 5 * 1024; i += NTHR) { const int v = i >> 10, k = i & 1023; const float c = v < 4 ? F.in[I_C][v * 1024 + k] : F.in[I_CCTX][k]; sc[i] = c * sigmoidf_(c); }
        __syncthreads();
        for (int u = F.bid; u < DEPTH * 96; u += F.G) {
            const int l = u / 96, n0 = (u % 96) * 64;
            const float* W = F.in[I_WMOD] + (size_t)l * 1024 * 6144 + n0 + F.lane;
            float a0 = 0.f, a1 = 0.f, a2 = 0.f, a3 = 0.f, a4 = 0.f;
            const int kb = F.wave * 128;
#pragma unroll 8
            for (int k = 0; k < 128; ++k) { const float w = W[(size_t)(kb + k) * 6144];
                a0 += w * sc[kb + k]; a1 += w * sc[1024 + kb + k]; a2 += w * sc[2048 + kb + k]; a3 += w * sc[3072 + kb + k]; a4 += w * sc[4096 + kb + k]; }
            red[(F.wave * 5 + 0) * 64 + F.lane] = a0; red[(F.wave * 5 + 1) * 64 + F.lane] = a1; red[(F.wave * 5 + 2) * 64 + F.lane] = a2;
            red[(F.wave * 5 + 3) * 64 + F.lane] = a3; red[(F.wave * 5 + 4) * 64 + F.lane] = a4;
            __syncthreads();
            if (F.tid < 320) { const int v = F.tid >> 6, c = F.tid & 63; float s = F.in[I_BMOD][l * 6144 + n0 + c];
#pragma unroll
                for (int w = 0; w < 8; ++w) s += red[(w * 5 + v) * 64 + c];
                ((float*)(F.ws + WS_MOD))[(size_t)(l * 5 + v) * 6144 + n0 + c] = s; }
            __syncthreads();
        }
    }
    if (F.bid == 0) {
        for (int i = F.tid; i < 64 * 32; i += NTHR) { const int pos = i >> 5, j = i & 31; const float inv = powf(10000.f, -(float)j / 32.f), a = (float)pos * inv;
            ((f32x2*)(F.ws + WS_ROPE128))[i] = (f32x2){cosf(a), sinf(a)}; }
        for (int i = F.tid; i < 64 * 16; i += NTHR) { const int pos = i >> 4, j = i & 15; const float inv = powf(10000.f, -(float)j / 16.f), a = (float)pos * inv;
            ((f32x2*)(F.ws + WS_ROPE64))[i] = (f32x2){cosf(a), sinf(a)}; }
        if (F.tid < DEPTH * 8) { const int l = F.tid >> 3, dir = (F.tid >> 2) & 1, h = F.tid & 3; const float x = (dir ? F.in[I_RDB] : F.in[I_RDF])[l * 4 + h];
            const float ls = -log1pf(expf(-x));
            ((float*)(F.ws + WS_DEC))[F.tid] = ls * LOG2E; }
        if (F.tid >= 64 && F.tid < 64 + DEPTH) { const int l = F.tid - 64; float s1 = 0.f, s2 = 0.f;
            for (int i = 0; i < 64; ++i) { s1 += F.in[I_LQ1][l * 64 + i] * F.in[I_LK1][l * 64 + i]; s2 += F.in[I_LQ2][l * 64 + i] * F.in[I_LK2][l * 64 + i]; }
            const float lam_init = 0.8f - 0.6f * expf(-0.3f * (float)l);
            ((float*)(F.ws + WS_DEC))[32 + l] = expf(s1) - expf(s2) + lam_init; ((float*)(F.ws + WS_DEC))[40 + l] = lam_init; }
    }
    for (int i = F.bid * NTHR + F.tid; i < DEPTH * NEXP * D; i += F.G * NTHR) { const int l = i / (NEXP * D), e = (i / D) % NEXP, k = i % D;
        const float w = F.in[I_WR][((size_t)l * D + k) * NEXP + e]; const unsigned hi = cvt_pk_bf16(w, 0.f) & 0xffffu; const float lo = w - bf2f((unsigned short)hi);
        bf16_t* o = (bf16_t*)(F.ws + WS_WRT) + (size_t)l * 2 * NEXP * D; o[(size_t)e * D + k] = (bf16_t)hi; o[(size_t)(NEXP + e) * D + k] = (bf16_t)(cvt_pk_bf16(lo, 0.f) & 0xffffu); }
    __syncthreads();
    while (conv_chunk(F, 0, nullptr, 0u)) { }
}
struct Row16 { f32x4 v[4]; };
__device__ __forceinline__ Row16 ld_row_f32(const float* p, int lane) { Row16 r; const f32x4* q = (const f32x4*)p + lane;
#pragma unroll
    for (int j = 0; j < 4; ++j) r.v[j] = q[64 * j];
    return r; }
__device__ __forceinline__ void st_row_f32(float* p, int lane, const Row16& r) { f32x4* q = (f32x4*)p + lane;
#pragma unroll
    for (int j = 0; j < 4; ++j) q[64 * j] = r.v[j]; }
__device__ __forceinline__ void st_row_bf16(bf16_t* p, int lane, const Row16& r) { u32x2* q = (u32x2*)p + lane;
#pragma unroll
    for (int j = 0; j < 4; ++j) q[64 * j] = (u32x2){cvt_pk_bf16(r.v[j].x, r.v[j].y), cvt_pk_bf16(r.v[j].z, r.v[j].w)}; }
__device__ __forceinline__ float row_rstd(const Row16& r) { float s = 0.f;
#pragma unroll
    for (int j = 0; j < 4; ++j) s += (r.v[j].x * r.v[j].x + r.v[j].y * r.v[j].y) + (r.v[j].z * r.v[j].z + r.v[j].w * r.v[j].w);
    return 1.f / sqrtf(wave_sum(s) * (1.f / D) + NORM_EPS); }
__device__ __forceinline__ Row16 x_row_combined(const Frame& F, int l, int row) {
    if (l == 0) return ld_row_f32(row < TL ? F.in[I_X] + (size_t)row * D : F.in[I_CTX] + (size_t)(row - TL) * D, F.lane);
    Row16 x = ld_row_f32((const float*)(F.ws + WS_XRES) + (size_t)row * D, F.lane);
    const Row16 ga = ld_row_f32(modp(F, l - 1, row_modv(row), 5), F.lane);
    const u32x2* yk = (const u32x2*)(F.ws + WS_YK) + (size_t)row * 4 * (D / 4) + F.lane;
#pragma unroll
    for (int j = 0; j < 4; ++j) { f32x4 s = (f32x4){0.f, 0.f, 0.f, 0.f};
#pragma unroll
        for (int k = 0; k < 4; ++k) { const u32x2 w = yk[(size_t)k * (D / 4) + 64 * j]; s += (f32x4){bflo(w.x), bfhi(w.x), bflo(w.y), bfhi(w.y)}; }
        x.v[j] += ga.v[j] * s; }
    return x;
}
__device__ __forceinline__ void p_norm1(Frame& F, int l, bool dry = false) {
    const int gw = F.bid * 8 + F.wave, NGW = F.G * 8;
    const Row16 g = ld_row_f32(F.in[I_GMIX] + (size_t)l * D, F.lane);
    for (int row = gw; row < TT; row += NGW) {
        const Row16 x = x_row_combined(F, l, row);
        if (!dry) st_row_f32((float*)(F.ws + WS_XRES) + (size_t)row * D, F.lane, x);
        const float rs = row_rstd(x); const int v = row_modv(row);
        const Row16 sh = ld_row_f32(modp(F, l, v, 0), F.lane), sc = ld_row_f32(modp(F, l, v, 1), F.lane);
        Row16 h;
#pragma unroll
        for (int j = 0; j < 4; ++j) h.v[j] = x.v[j] * rs * g.v[j] * (sc.v[j] + 1.f) + sh.v[j];
        if (!WIN_FP8) st_row_bf16((bf16_t*)(F.ws + WS_H) + (size_t)row * D, F.lane, h);
        else { unsigned* h8 = (unsigned*)(F.ws + WS_H + (size_t)row * D) + F.lane;
#pragma unroll
          for (int j = 0; j < 4; ++j) h8[64 * j] = pk_fp8x4(h.v[j].x * 8.f, h.v[j].y * 8.f, h.v[j].z * 8.f, h.v[j].w * 8.f); }
    }
}
__device__ __forceinline__ void p_final(Frame& F) {
    const int gw = F.bid * 8 + F.wave, NGW = F.G * 8;
    const Row16 g = ld_row_f32(F.in[I_GFIN], F.lane);
    for (int row = gw; row < TL; row += NGW) {
        const Row16 x = x_row_combined(F, DEPTH, row);
        const float rs = row_rstd(x); Row16 o;
#pragma unroll
        for (int j = 0; j < 4; ++j) o.v[j] = x.v[j] * rs * g.v[j];
        st_row_f32(F.out + (size_t)row * D, F.lane, o);
    }
}

struct OrderMN {
    int nM, nN, nwg, G, c;
    __device__ __forceinline__ void init(int nM_, int nN_, int G_, int c_) { nM = nM_; nN = nN_; nwg = nM * nN; G = G_; c = c_; }
    __device__ __forceinline__ bool tile(int i, int& pm, int& pn) const {
        const long L = (long)i * G + c; if (L >= nwg) return false;
        int wgid = (int)L; { const int q = nwg / 8, r = nwg % 8, xcd = wgid % 8, off = wgid / 8; wgid = (xcd < r ? xcd * (q + 1) : r * (q + 1) + (xcd - r) * q) + off; }
        const int nig = 8 * nN, gid = wgid / nig, fm = gid * 8, gsz = (nM - fm) < 8 ? (nM - fm) : 8;
        pm = fm + ((wgid % nig) % gsz); pn = (wgid % nig) / gsz; return true;
    }
};
struct SchedPlain {
    __device__ __forceinline__ void a_ready(const gm::GU&) const {}
    __device__ __forceinline__ void done(const gm::GU&) const {}
    OrderMN o; const char* A; const char* B; int lda, ldb, nt; int dupk = 0;
    __device__ __forceinline__ const char* baseA() const { return A; }
    __device__ __forceinline__ const char* baseB() const { return B; }
    __device__ __forceinline__ bool next(int i, gm::GU& u) const { int pm, pn; const int j = i; if (!o.tile(j, pm, pn)) return false;
        u.A = (unsigned)(pm * 256 * lda); u.B = (unsigned)(pn * 256 * ldb); u.nt = dupk ? 2 * nt : nt; u.pm = pm; u.pn = pn; u.e0 = 0; u.e1 = 0; return true; }
};
struct EpiIn {
    static constexpr bool CHAIN = false; static constexpr bool DUPK = true; static constexpr bool DUPE = (DUP_MASK & 32768) != 0;
    bf16_t* P; const f32x4* rope128; const f32x4* rope64; float pre = 1.f;
    template <int MODE, int BJ>
    __device__ __forceinline__ void rows(const f32x4 (&acc)[2][2][4][2], const gm::GU& u, int wr, int fr, int ct, int cl, float scale) const {
        int j0 = 0, usecol = 0;
        if (MODE == 1) { const int i0 = cl >> 1; usecol = i0 >= 32; j0 = i0 & 31; } else if (MODE == 2) { const int i0 = (cl & 63) >> 1; usecol = i0 >= 16; j0 = i0 & 15; }
        f32x4 frq = {0.f, 0.f, 0.f, 0.f};
        if (MODE == 1 || MODE == 2) { const float lstep = (MODE == 1 ? -13.287712379549449f / 32.f : -13.287712379549449f / 16.f);
#pragma unroll
            for (int q = 0; q < 4; ++q) frq[q] = fexp2(lstep * (float)(j0 + q)) * 0.15915494309189535f; }
        const float sc = (WIN_FP8 ? scale * (1.f / 256.f) : scale) * pre;
#pragma unroll
        for (int ai = 0; ai < 2; ++ai)
#pragma unroll
            for (int m = 0; m < 4; ++m) {
                const int row = u.pm * 256 + ai * 128 + wr * 64 + m * 16 + fr;
                f32x4 v0 = acc[ai][BJ][m][0] * sc, v1 = acc[ai][BJ][m][1] * sc;
                if (MODE == 1 || MODE == 2) {
                    const int s = row & 4095; const float pos = (float)(usecol ? (s & 63) : (s >> 6));
                    f32x4 cs, sn;
#pragma unroll
                    for (int q = 0; q < 4; ++q) { const float rev = pos * frq[q]; cs[q] = __builtin_amdgcn_cosf(rev); sn[q] = __builtin_amdgcn_sinf(rev); }
                    f32x4 r0, r1;
                    r0.x = v0.x * cs[0] - v0.y * sn[0]; r0.y = v0.x * sn[0] + v0.y * cs[0]; r0.z = v0.z * cs[1] - v0.w * sn[1]; r0.w = v0.z * sn[1] + v0.w * cs[1];
                    r1.x = v1.x * cs[2] - v1.y * sn[2]; r1.y = v1.x * sn[2] + v1.y * cs[2]; r1.z = v1.z * cs[3] - v1.w * sn[3]; r1.w = v1.z * sn[3] + v1.w * cs[3];
                    v0 = r0; v1 = r1;
                }
                if (MODE == 3) {
#pragma unroll
                    for (int q = 0; q < 4; ++q) { v0[q] = v0[q] * sigmoidf_(v0[q]); v1[q] = v1[q] * sigmoidf_(v1[q]); }
                } else if (MODE == 4) {
#pragma unroll
                    for (int q = 0; q < 4; ++q) { v0[q] = sigmoidf_(v0[q]); v1[q] = sigmoidf_(v1[q]); }
                }
                u32x4 w; w.x = cvt_pk_bf16(v0[0], v0[1]); w.y = cvt_pk_bf16(v0[2], v0[3]); w.z = cvt_pk_bf16(v1[0], v1[1]); w.w = cvt_pk_bf16(v1[2], v1[3]);
                *(u32x4*)(P + (size_t)row * DIN + ct + cl) = w;
            }
    }
    template <int BJ>
    __device__ __forceinline__ void half(const f32x4 (&acc)[2][2][4][2], const gm::GU& u, int wr, int wc, int fr, int fq) const {
        const bool latent = u.pm < (TL / 256);
        const int ct = u.pn * 256 + BJ * 128;
        const int cl = wc * 32 + fq * 8;
        int mode = 0; float scale = 1.f;
        if (ct < C_RK) { mode = 1; scale = 0.08838834764831845f; }
        else if (ct < C_RV) mode = 1;
        else if (ct < C_RG) mode = 0;
        else if (ct < C_DQ) mode = 3;
        else if (ct < C_DK) { mode = 2; scale = 0.125f * LOG2E; }
        else if (ct < C_DV) mode = 2;
        else if (ct < C_GQ) mode = 0;
        else if (ct < C_GKV) { mode = 2; scale = 0.125f * LOG2E; }
        else if (ct < C_GATE) mode = (wc < 2) ? 2 : 0;
        else mode = 4;
        if (!latent && (mode == 1 || mode == 2)) mode = 0;
        switch (mode) {
            case 0: rows<0, BJ>(acc, u, wr, fr, ct, cl, scale); break;
            case 1: rows<1, BJ>(acc, u, wr, fr, ct, cl, scale); break;
            case 2: rows<2, BJ>(acc, u, wr, fr, ct, cl, scale); break;
            case 3: rows<3, BJ>(acc, u, wr, fr, ct, cl, scale); break;
            default: rows<4, BJ>(acc, u, wr, fr, ct, cl, scale); break;
        }
    }
    __device__ __forceinline__ void operator()(const f32x4 (&acc)[2][2][4][2], const gm::GU& u, int wr, int wc, int fr, int fq) const {
        half<0>(acc, u, wr, wc, fr, fq); half<1>(acc, u, wr, wc, fr, fq);
    }
};
struct SchedBranch {
    __device__ __forceinline__ void a_ready(const gm::GU&) const {}
    __device__ __forceinline__ void done(const gm::GU&) const {}
    OrderMN o; const char* Y; const char* W;
    __device__ __forceinline__ const char* baseA() const { return Y; }
    __device__ __forceinline__ const char* baseB() const { return W; }
    __device__ __forceinline__ bool next(int i, gm::GU& u) const { int pm, pn; const int ti = i / 3, seg = i - 3 * ti; if (!o.tile(ti, pm, pn)) return false;
        const int koff = seg == 0 ? 0 : (seg == 1 ? 1024 : 1536), eb = BR_FP8 ? 1 : 2;
        u.A = (unsigned)(pm * 256 * 2048 * eb + koff * eb); u.B = (unsigned)(pn * 256 * 2048 * eb + koff * eb); u.nt = (seg == 0 ? 16 : 8) / (BR_FP8 ? 2 : 1); u.pm = pm; u.pn = pn; u.e0 = seg; u.e1 = seg < 2; return true; }
};
constexpr int CW_PB = 32768;
struct SchedBranchX {
    int c, ctx; const char* Y; const char* W; unsigned* cnt; int wv;
    __device__ __forceinline__ const char* baseA() const { return Y; }
    __device__ __forceinline__ const char* baseB() const { return W; }
    __device__ __forceinline__ bool next(int i, gm::GU& u) const { const int ti = i / 3, seg = i - 3 * ti, x = c & 7, r = c >> 3; int pm, pn;
        if (ti == 0) { pm = x + 8 * (r >> 2); pn = r & 3; } else if (ti == 1 && ctx && x < 4 && r < 4) { pm = 64 + x; pn = r; } else return false;
        const int koff = seg == 0 ? 0 : (seg == 1 ? 1024 : 1536);
        u.A = (unsigned)(pm * 256 * 4096 + koff * 2); u.B = (unsigned)(pn * 256 * 4096 + koff * 2); u.nt = seg == 0 ? 16 : 8; u.pm = pm; u.pn = pn; u.e0 = seg; u.e1 = seg < 2; return true; }
    __device__ __forceinline__ void a_ready(const gm::GU&) const {}
    __device__ __forceinline__ void done(const gm::GU& u) const {
        if (u.e0 != 2) return;
        asm volatile("s_waitcnt vmcnt(0)" ::: "memory");
        __builtin_amdgcn_s_barrier();
        if (wv == 0 && lane_now() == 0) { __builtin_amdgcn_fence(__ATOMIC_RELEASE, "agent"); asm volatile("s_waitcnt vmcnt(0)" ::: "memory");
            __hip_atomic_fetch_add(cnt + 16 * u.pm, 1u, __ATOMIC_RELAXED, __HIP_MEMORY_SCOPE_AGENT); }
    }
};
struct SchedOutX {
    int c, ctx; const char* A; const char* B; const unsigned* cnt; int wv;
    __device__ __forceinline__ const char* baseA() const { return A; }
    __device__ __forceinline__ const char* baseB() const { return B; }
    __device__ __forceinline__ bool next(int i, gm::GU& u) const { const int x = c & 7, r = c >> 3; const bool lng = ctx && x < 4 && r < 4; int pm, pn;
        if (i == 0) { if (lng) { pm = 64 + x; pn = r; } else { pm = x + 8 * (r >> 2); pn = r & 3; } }
        else if (i == 1 && ctx && x < 4 && r >= 4 && r < 8) { pm = x; pn = r - 4; }
        else return false;
        u.A = (unsigned)(pm * 256 * 2048); u.B = (unsigned)(pn * 256 * 2048); u.nt = 16; u.pm = pm; u.pn = pn; u.e0 = 0; u.e1 = 0; return true; }
    __device__ __forceinline__ void a_ready(const gm::GU& u) const {
        if (wv == 0) { const unsigned* w_ = cnt + 16 * u.pm; unsigned sp_ = 0;
            while ((unsigned)__builtin_amdgcn_readfirstlane((int)__hip_atomic_load(w_, __ATOMIC_RELAXED, __HIP_MEMORY_SCOPE_AGENT)) < 4u) { __builtin_amdgcn_s_sleep(2); if (++sp_ > (1u << 22)) break; }
            __builtin_amdgcn_fence(__ATOMIC_ACQUIRE, "agent"); asm volatile("s_waitcnt vmcnt(0)" ::: "memory"); }
        asm volatile("" ::: "memory"); __builtin_amdgcn_s_barrier(); asm volatile("" ::: "memory");
    }
    __device__ __forceinline__ void done(const gm::GU&) const {}
};
struct EpiBranch {
    static constexpr bool DUPK = false; static constexpr bool DUPE = false;
    static constexpr bool CHAIN = true;
    const bf16_t* P; bf16_t* MGB;
    __device__ __forceinline__ void operator()(f32x4 (&acc)[2][2][4][2], const gm::GU& u, int wr, int wc, int fr, int fq) const {
        const bool last = u.e0 == 2;
        const bf16_t* gbase = P + C_GATE + u.e0 * 1024 + u.pn * 256 + wc * 32 + fq * 8;
        const int nxt = last ? 0 : 1024;
#pragma unroll
        for (int ai = 0; ai < 2; ++ai)
#pragma unroll
            for (int m = 0; m < 4; ++m) {
                const int row = u.pm * 256 + ai * 128 + wr * 64 + m * 16 + fr;
                const bf16_t* gp = gbase + (size_t)row * DIN;
                u32x4 ga[2], gb[2];
#pragma unroll
                for (int bj = 0; bj < 2; ++bj) { ga[bj] = *(const u32x4*)(gp + bj * 128); gb[bj] = *(const u32x4*)(gp + nxt + bj * 128); }
                __builtin_amdgcn_sched_barrier(0);
#pragma unroll
                for (int bj = 0; bj < 2; ++bj) {
                    const int col = u.pn * 256 + bj * 128 + wc * 32 + fq * 8;
                    const u32x4 g = ga[bj], h = gb[bj];
                    f32x4 f0 = (f32x4){bflo(g.x), bfhi(g.x), bflo(g.y), bfhi(g.y)}, f1 = (f32x4){bflo(g.z), bfhi(g.z), bflo(g.w), bfhi(g.w)};
                    const f32x4 d0 = (f32x4){bflo(h.x), bfhi(h.x), bflo(h.y), bfhi(h.y)}, d1 = (f32x4){bflo(h.z), bfhi(h.z), bflo(h.w), bfhi(h.w)};
#pragma unroll
                    for (int q = 0; q < 4; ++q) { f0[q] *= frcp(last ? 1.f : fmaxf(d0[q], 1e-20f)); f1[q] *= frcp(last ? 1.f : fmaxf(d1[q], 1e-20f)); }
                    const f32x4 v0 = acc[ai][bj][m][0] * f0, v1 = acc[ai][bj][m][1] * f1;
                    acc[ai][bj][m][0] = v0; acc[ai][bj][m][1] = v1;
                    if (last) { u32x4 w; w.x = cvt_pk_bf16(v0[0], v0[1]); w.y = cvt_pk_bf16(v0[2], v0[3]); w.z = cvt_pk_bf16(v1[0], v1[1]); w.w = cvt_pk_bf16(v1[2], v1[3]);
                        *(u32x4*)(MGB + (size_t)row * D + col) = w; }
                }
                __builtin_amdgcn_sched_barrier(0);
            }
    }
};
struct EpiOut {
    static constexpr bool DUPK = false; static constexpr bool DUPE = false;
    static constexpr bool CHAIN = false;
    float* X; const float* mod; float* XO;
    __device__ __forceinline__ void operator()(const f32x4 (&acc)[2][2][4][2], const gm::GU& u, int wr, int wc, int fr, int fq) const {
        const int v = u.pm < (TL / 256) ? (u.pm >> 4) : 4;
#pragma unroll
        for (int bj = 0; bj < 2; ++bj) {
            const int col = u.pn * 256 + bj * 128 + wc * 32 + fq * 8;
            const f32x4 g0 = *(const f32x4*)(mod + (size_t)v * 6144 + 2048 + col), g1 = *(const f32x4*)(mod + (size_t)v * 6144 + 2048 + col + 4);
#pragma unroll
            for (int ai = 0; ai < 2; ++ai) {
                f32x4 x0[4], x1[4];
#pragma unroll
                for (int m = 0; m < 4; ++m) { const float* x = X + (size_t)(u.pm * 256 + ai * 128 + wr * 64 + m * 16 + fr) * D + col; x0[m] = *(const f32x4*)x; x1[m] = *(const f32x4*)(x + 4); }
                __builtin_amdgcn_sched_barrier(0);
#pragma unroll
                for (int m = 0; m < 4; ++m) {
                    float* xo = XO + (size_t)(u.pm * 256 + ai * 128 + wr * 64 + m * 16 + fr) * D + col;
                    constexpr float SCO = BR_FP8 ? 1.f / 256.f : 1.f;
                    *(f32x4*)xo = x0[m] + g0 * (acc[ai][bj][m][0] * SCO);
                    *(f32x4*)(xo + 4) = x1[m] + g1 * (acc[ai][bj][m][1] * SCO);
                }
                __builtin_amdgcn_sched_barrier(0);
            }
        }
    }
};
struct SchedGU {
    __device__ __forceinline__ void a_ready(const gm::GU&) const {}
    __device__ __forceinline__ void done(const gm::GU&) const {}
    int G, c; const LAS int* pref; const int* cnt; const int* list; const char* H; const char* W; int wv;
    __device__ __forceinline__ const char* baseA() const { return H; }
    __device__ __forceinline__ const char* baseB() const { return W; }
    __device__ __forceinline__ bool next(int i, gm::GU& u) const {
        const int ntile = __builtin_amdgcn_readfirstlane(pref[NEXP]); int ti, pn;
        if ((G & 7) == 0) {
            const int x = c & 7, j = c >> 3, t0 = x * ntile / 8, t1 = (x + 1) * ntile / 8, m = j + (G >> 3) * i; if (m >= (t1 - t0) * 8) return false; ti = t0 + (m >> 3); pn = m & 7;
        } else { const long L = (long)i * G + c; if (L >= (long)ntile * 8) return false; ti = (int)(L >> 3); pn = (int)(L & 7); }
        const int rec = __builtin_amdgcn_readfirstlane(pref[64 + ti]); const int e = rec & 255, valid = (rec >> 8) & 4095, mt = rec >> 20;
        u.A = 0u; u.B = (unsigned)((e * 2048 + pn * 256) * 1024); u.nt = 8; u.pm = ti; u.pn = pn; u.e0 = e | (mt << 8); u.e1 = valid; return true;
    }
    __device__ __forceinline__ void gather(const gm::GU& u, unsigned (&o)[2][2]) const {
        const int e = u.e0 & 255, mt = u.e0 >> 8;
        int tid = tid_now(wv); asm volatile("" : "+v"(tid));
#pragma unroll
        for (int i = 0; i < 2; ++i) { int R, C; gm::stage_rc(tid * 16 + i * 8192, R, C);
#pragma unroll
            for (int h = 0; h < 2; ++h) { const int r = h * 128 + R; const int idx = mt * 256 + (r < u.e1 ? r : 0); const int a = list[(size_t)e * TT + idx];
                o[h][i] = (unsigned)(a >> 2) * 1024u + (unsigned)C * 2u; } }
    }
};
struct EpiGU {
    static constexpr bool DUPK = false; static constexpr bool DUPE = (DUP_MASK & 65536) != 0;
    static constexpr bool CHAIN = false;
    bf16_t* ACT; const float* bgu;
    __device__ __forceinline__ void operator()(const f32x4 (&acc)[2][2][4][2], const gm::GU& u, int wr, int wc, int fr, int fq) const {
        const int e = u.e0 & 255;
#pragma unroll
        for (int bj = 0; bj < 2; ++bj) {
            const int j0 = u.pn * 128 + bj * 64 + wc * 16 + fq * 4;
            const f32x4 bg = *(const f32x4*)(bgu + (size_t)e * 2048 + j0), bl = *(const f32x4*)(bgu + (size_t)e * 2048 + 1024 + j0);
#pragma unroll
            for (int ai = 0; ai < 2; ++ai)
#pragma unroll
                for (int m = 0; m < 4; ++m) {
                    const int r = ai * 128 + wr * 64 + m * 16 + fr;
                    const f32x4 v0 = acc[ai][bj][m][0], v1 = acc[ai][bj][m][1];
                    constexpr float SC = 1.f / 256.f;
                    float gl[4] = {v0[0] * SC + bg[0], v0[2] * SC + bg[1], v1[0] * SC + bg[2], v1[2] * SC + bg[3]};
                    float li[4] = {v0[1] * SC + bl[0], v0[3] * SC + bl[1], v1[1] * SC + bl[2], v1[3] * SC + bl[3]};
                    float o[4];
#pragma unroll
                    for (int q = 0; q < 4; ++q) { const float g = fminf(gl[q], 7.f), ln = fminf(fmaxf(li[q], -7.f), 7.f); o[q] = g * sigmoidf_(1.702f * g) * (ln + 1.f); }
                    *(unsigned*)((unsigned char*)ACT + ((size_t)u.pm * 256 + r) * D + j0) = pk_fp8x4(o[0] * 4.f, o[1] * 4.f, o[2] * 4.f, o[3] * 4.f);
                }
        }
    }
};
struct SchedDN {
    __device__ __forceinline__ void a_ready(const gm::GU&) const {}
    __device__ __forceinline__ void done(const gm::GU&) const {}
    int G, c; const LAS int* pref; const int* cnt; const char* ACT; const char* W;
    __device__ __forceinline__ const char* baseA() const { return ACT; }
    __device__ __forceinline__ const char* baseB() const { return W; }
    __device__ __forceinline__ bool next(int i, gm::GU& u) const {
        const int ntile = __builtin_amdgcn_readfirstlane(pref[NEXP]); int ti, pn;
        if ((G & 7) == 0) { const int x = c & 7, j = c >> 3, t0 = x * ntile / 8, t1 = (x + 1) * ntile / 8, m = j + (G >> 3) * i; if (m >= (t1 - t0) * 4) return false; ti = t0 + (m >> 2); pn = m & 3; }
        else { const long L = (long)i * G + c; if (L >= (long)ntile * 4) return false; ti = (int)(L >> 2); pn = (int)(L & 3); }
        const int rec = __builtin_amdgcn_readfirstlane(pref[64 + ti]); const int e = rec & 255, valid = (rec >> 8) & 4095, mt = rec >> 20;
        u.A = (unsigned)(ti * 256 * 1024); u.B = (unsigned)((e * 1024 + pn * 256) * 1024); u.nt = 8; u.pm = ti; u.pn = pn; u.e0 = e | (mt << 8); u.e1 = valid; return true;
    }
};
struct EpiDN {
    static constexpr bool DUPK = false; static constexpr bool DUPE = (DUP_MASK & 131072) != 0;
    static constexpr bool CHAIN = false;
    bf16_t* YK; const float* bdn; const int* list; const float* tw;
    __device__ __forceinline__ void operator()(const f32x4 (&acc)[2][2][4][2], const gm::GU& u, int wr, int wc, int fr, int fq) const {
        const int e = u.e0 & 255, mt = u.e0 >> 8;
        int aid[8]; float wgt[8];
#pragma unroll
        for (int k = 0; k < 8; ++k) { const int r = (k >> 2) * 128 + wr * 64 + (k & 3) * 16 + fr; aid[k] = list[(size_t)e * TT + mt * 256 + (r < u.e1 ? r : 0)]; }
#pragma unroll
        for (int k = 0; k < 8; ++k) wgt[k] = tw[aid[k]];
#pragma unroll
        for (int bj = 0; bj < 2; ++bj) {
            const int col = u.pn * 256 + bj * 128 + wc * 32 + fq * 8;
            const f32x4 b0 = *(const f32x4*)(bdn + (size_t)e * 1024 + col), b1 = *(const f32x4*)(bdn + (size_t)e * 1024 + col + 4);
#pragma unroll
            for (int ai = 0; ai < 2; ++ai)
#pragma unroll
                for (int m = 0; m < 4; ++m) {
                    const int r = ai * 128 + wr * 64 + m * 16 + fr; const int k = ai * 4 + m;
                    if (r < u.e1) {
                        const float w = wgt[k];
                        const f32x4 v0 = (acc[ai][bj][m][0] * (1.f / 128.f) + b0) * w, v1 = (acc[ai][bj][m][1] * (1.f / 128.f) + b1) * w;
                        u32x4 o; o.x = cvt_pk_bf16(v0[0], v0[1]); o.y = cvt_pk_bf16(v0[2], v0[3]); o.z = cvt_pk_bf16(v1[0], v1[1]); o.w = cvt_pk_bf16(v1[2], v1[3]);
                        *(u32x4*)(YK + (size_t)aid[k] * D + col) = o;
                    }
                }
        }
    }
};

struct SmState { float m, l; };
constexpr float SM_DEFER = 8.f;
__device__ __forceinline__ float max3f(float a, float b, float c) { float r; asm("v_max3_f32 %0, %1, %2, %3" : "=v"(r) : "v"(a), "v"(b), "v"(c)); return r; }
template <int NC>
__device__ __forceinline__ void softmax_tile(f32x16& s0, f32x16& s1, SmState& st, f32x16 (&O)[NC], bf16x8 (&pf)[4]) {
    float ma, mb;
    asm volatile("s_nop 15\n\ts_nop 3\n\tv_max3_f32 %0, %2, %3, %4\n\tv_max3_f32 %1, %5, %6, %7" : "=&v"(ma), "=&v"(mb) : "v"(s0[0]), "v"(s0[1]), "v"(s1[0]), "v"(s0[2]), "v"(s0[3]), "v"(s1[1]));
    ma = max3f(ma, s1[2], s1[3]);
#pragma unroll
    for (int r = 4; r < 16; r += 4) { ma = max3f(ma, s0[r], s0[r + 1]); mb = max3f(mb, s0[r + 2], s0[r + 3]); ma = max3f(ma, s1[r], s1[r + 1]); mb = max3f(mb, s1[r + 2], s1[r + 3]); }
    const float mx = xmax(max3f(ma, mb, mb));
    if (!__all(mx <= st.m)) {
        const float mn = max3f(st.m, mx, mx); const float alpha = fexp2(st.m - mn);
        st.m = mn; st.l *= alpha;
#pragma unroll
        for (int c = 0; c < NC; ++c) O[c] = O[c] * alpha;
    }
    const float mn = st.m;
    s0 = s0 - mn; s1 = s1 - mn;
#pragma unroll
    for (int r = 0; r < 16; ++r) { s0[r] = fexp2(s0[r]); s1[r] = fexp2(s1[r]); }
    const f32x16 ssum = s0 + s1;
    float sum = 0.f;
#pragma unroll
    for (int r = 0; r < 16; ++r) sum += ssum[r];
    st.l += sum;
    pf[0] = pack8(s0, 0); pf[1] = pack8(s0, 8); pf[2] = pack8(s1, 0); pf[3] = pack8(s1, 8);
}
template <int NC>
__device__ __forceinline__ void softmax_pre(f32x16& s0, f32x16& s1, f32x16& p0, f32x16& p1, bool shift_p, SmState& st, f32x16& negm, f32x16 (&O)[NC], bf16x8 (&pf)[4], bool first) {
    float ma, mb;
    asm volatile("s_nop 15\n\ts_nop 3\n\tv_max3_f32 %0, %2, %3, %4\n\tv_max3_f32 %1, %5, %6, %7" : "=&v"(ma), "=&v"(mb) : "v"(s0[0]), "v"(s0[1]), "v"(s1[0]), "v"(s0[2]), "v"(s0[3]), "v"(s1[1]));
    ma = max3f(ma, s1[2], s1[3]);
#pragma unroll
    for (int r = 4; r < 16; r += 4) { ma = max3f(ma, s0[r], s0[r + 1]); mb = max3f(mb, s0[r + 2], s0[r + 3]); ma = max3f(ma, s1[r], s1[r + 1]); mb = max3f(mb, s1[r + 2], s1[r + 3]); }
    const float mx = xmax(max3f(ma, mb, mb));
    if (first || !__all(mx <= 0.f)) {
        const float d = first ? mx : fmaxf(mx, 0.f); const float alpha = first ? 1.f : fexp2(-d);
        st.m += d; st.l *= alpha;
#pragma unroll
        for (int c = 0; c < NC; ++c) O[c] = O[c] * alpha;
        s0 = s0 - d; s1 = s1 - d;
        if (shift_p) { p0 = p0 - d; p1 = p1 - d; }
        const float nm = -st.m;
#pragma unroll
        for (int r = 0; r < 16; ++r) negm[r] = nm;
    }
#pragma unroll
    for (int r = 0; r < 16; ++r) { s0[r] = fexp2(s0[r]); s1[r] = fexp2(s1[r]); }
    const f32x16 ssum = s0 + s1;
    float sum = 0.f;
#pragma unroll
    for (int r = 0; r < 16; ++r) sum += ssum[r];
    st.l += sum;
    pf[0] = pack8(s0, 0); pf[1] = pack8(s0, 8); pf[2] = pack8(s1, 0); pf[3] = pack8(s1, 8);
}
template <int NC>
__device__ __forceinline__ void softmax_head(f32x16& s0, f32x16& s1, SmState& st, f32x16 (&O)[NC]) {
    float ma, mb;
    asm volatile("s_nop 15\n\ts_nop 3\n\tv_max3_f32 %0, %2, %3, %4\n\tv_max3_f32 %1, %5, %6, %7" : "=&v"(ma), "=&v"(mb) : "v"(s0[0]), "v"(s0[1]), "v"(s1[0]), "v"(s0[2]), "v"(s0[3]), "v"(s1[1]));
    ma = max3f(ma, s1[2], s1[3]);
#pragma unroll
    for (int r = 4; r < 16; r += 4) { ma = max3f(ma, s0[r], s0[r + 1]); mb = max3f(mb, s0[r + 2], s0[r + 3]); ma = max3f(ma, s1[r], s1[r + 1]); mb = max3f(mb, s1[r + 2], s1[r + 3]); }
    const float mx = xmax(max3f(ma, mb, mb));
    if (!__all(mx <= st.m + SM_DEFER)) {
        const float mn = max3f(st.m, mx, mx); const float alpha = fexp2(st.m - mn);
        st.m = mn; st.l *= alpha;
#pragma unroll
        for (int c = 0; c < NC; ++c) O[c] = O[c] * alpha;
    }
    const float mn = st.m;
    s0 = s0 - mn; s1 = s1 - mn;
}
template <int NC>
__device__ __forceinline__ void sm_max2(f32x16& a0, f32x16& a1, f32x16& b0, f32x16& b1, SmState& st, f32x16& negm, f32x16 (&O)[NC], bool first) {
    float ma, mb;
    asm volatile("s_nop 15\n\ts_nop 3\n\tv_max3_f32 %0, %2, %3, %4\n\tv_max3_f32 %1, %5, %6, %7" : "=&v"(ma), "=&v"(mb) : "v"(a0[0]), "v"(a0[1]), "v"(a1[0]), "v"(a0[2]), "v"(a0[3]), "v"(a1[1]));
    ma = max3f(ma, a1[2], a1[3]);
#pragma unroll
    for (int r = 4; r < 16; r += 4) { ma = max3f(ma, a0[r], a0[r + 1]); mb = max3f(mb, a0[r + 2], a0[r + 3]); ma = max3f(ma, a1[r], a1[r + 1]); mb = max3f(mb, a1[r + 2], a1[r + 3]); }
#pragma unroll
    for (int r = 0; r < 16; r += 4) { ma = max3f(ma, b0[r], b0[r + 1]); mb = max3f(mb, b0[r + 2], b0[r + 3]); ma = max3f(ma, b1[r], b1[r + 1]); mb = max3f(mb, b1[r + 2], b1[r + 3]); }
    const float mx = xmax(max3f(ma, mb, mb));
    if (first || !__all(mx <= SM_DEFER)) {
        const float d = first ? mx : fmaxf(mx, 0.f); const float alpha = first ? 1.f : fexp2(-d);
        st.m += d; st.l *= alpha;
#pragma unroll
        for (int c = 0; c < NC; ++c) O[c] = O[c] * alpha;
        a0 = a0 - d; a1 = a1 - d; b0 = b0 - d; b1 = b1 - d;
        const float nm = -st.m;
#pragma unroll
        for (int r = 0; r < 16; ++r) negm[r] = nm;
    }
}
__device__ __forceinline__ void sm_exp_q(f32x16& s, SmState& st, bf16x8& p0, bf16x8& p1) {
#pragma unroll
    for (int r = 0; r < 16; ++r) s[r] = fexp2(s[r]);
    float su0 = s[0] + s[1], su1 = s[2] + s[3];
#pragma unroll
    for (int r = 4; r < 16; r += 4) { su0 += s[r] + s[r + 1]; su1 += s[r + 2] + s[r + 3]; }
    st.l += su0 + su1;
    p0 = pack8(s, 0); p1 = pack8(s, 8);
}
__device__ __forceinline__ void sm_exp(f32x16& s0, f32x16& s1, SmState& st, bf16x8 (&pf)[4]) {
#pragma unroll
    for (int r = 0; r < 16; ++r) { s0[r] = fexp2(s0[r]); s1[r] = fexp2(s1[r]); }
    const f32x16 ssum = s0 + s1;
    float sum = 0.f;
#pragma unroll
    for (int r = 0; r < 16; ++r) sum += ssum[r];
    st.l += sum;
    pf[0] = pack8(s0, 0); pf[1] = pack8(s0, 8); pf[2] = pack8(s1, 0); pf[3] = pack8(s1, 8);
}
#define ZERO16(x) do { _Pragma("unroll") for (int _r = 0; _r < 16; ++_r) (x)[_r] = 0.f; } while (0)

__device__ __forceinline__ void diff_unit(Frame& F, int l, int b, int h, int ctxq, int qblk) {
    const bf16_t* P = (const bf16_t*)(F.ws + WS_P);
#define DKimg(x) (F.lds + 65536 * (x))
#define DVimg(x) (F.lds + 32768 + 65536 * (x))
    int lane_ = lane_now(); asm volatile("" : "+v"(lane_)); const int lane = lane_, w = F.wave, r32 = lane & 31, hh = lane >> 5;
    LA la = make_la(lane); la.rowb ^= 16u * hh;
    const int sm = w >> 2;
    const int qrow0 = ctxq ? TL + b * 256 + qblk * 128 : b * 4096 + qblk * 128;
    const int kt0 = ctxq ? 32 : 0, nkt = ctxq ? 2 : 34;
    const char* kbase = (const char*)(P + C_DK + h * 128); const char* vbase = (const char*)(P + C_DV + h * 128);
#define DIFF_KROW(kt, i) ((kt) < 32 ? (size_t)(b * 4096 + (kt) * 128 + (i)) : (size_t)(TL + b * 256 + ((kt) - 32) * 128 + (i)))
#define DIFF_KP(r_) (kbase + DIFF_KROW(ktn, (r_)) * (DIN * 2))
#define DIFF_VP(r_) (vbase + DIFF_KROW(ktn, (r_)) * (DIN * 2))
    bf16x8 qf[4];
    { const bf16_t* qp = P + (size_t)(qrow0 + 32 * (w & 3) + r32) * DIN + C_DQ + h * 128 + 64 * sm + 8 * hh;
#pragma unroll
      for (int ks = 0; ks < 4; ++ks) qf[ks] = *(const bf16x8*)(qp + 16 * ks); }
    f32x16 O[4];
#pragma unroll
    for (int c = 0; c < 4; ++c) ZERO16(O[c]);
    SmState st = {0.f, 0.f};
    f32x16 negm; ZERO16(negm);
    __syncthreads();
    { DMA_LANE(); const int ktn = kt0;
#pragma unroll
      for (int i = 0; i < 4; ++i) { DMA4(DKimg(0), 4 * w + i, DIFF_KP); DMA4(DVimg(0), 4 * w + i, DIFF_VP); } }
    VMWAIT0(); __syncthreads();
    for (int t = 0; t < nkt; ++t) {
        const int cur = t & 1;
        LAS unsigned char* Kc = DKimg(cur); LAS unsigned char* Vc = DVimg(cur);
        OPAQUE(la.rowb); OPAQUE(la.trp);
#define SB() __builtin_amdgcn_sched_barrier(0)
        bf16x8 kfa[8], kfb[8], pfa[4], pfb[4], vf[2][4];
        f32x16 a0, a1, b0, b1;
#define LOAD_K(dst, R0_) do { _Pragma("unroll") for (int ks = 0; ks < 4; ++ks) { dst[ks] = frag_row(Kc, la.rowb, (R0_), 8 * sm + 2 * ks); dst[4 + ks] = frag_row(Kc, la.rowb, (R0_) + 32, 8 * sm + 2 * ks); } } while (0)
#define QK(kf_, s0_, s1_) do { s0_ = MFMA32(kf_[0], qf[0], negm); s1_ = MFMA32(kf_[4], qf[0], negm); _Pragma("unroll") for (int ks = 1; ks < 4; ++ks) { s0_ = MFMA32(kf_[ks], qf[ks], s0_); s1_ = MFMA32(kf_[4 + ks], qf[ks], s1_); } } while (0)
#define LOAD_V(slot_, R0_) do { _Pragma("unroll") for (int c = 0; c < 4; ++c) vf[slot_][c] = frag_trp(Vc, la.trp, (R0_), c, 0); } while (0)
#define PV(pf_, R0_) do { _Pragma("unroll") for (int kq = 0; kq < 4; ++kq) { \
            _Pragma("unroll") for (int c = 0; c < 4; ++c) { O[c] = MFMA32(vf[kq & 1][c], pf_[kq], O[c]); if (DUP_MASK & 262144) O[c] = MFMA32(vf[kq & 1][c], pf_[kq], O[c]); } \
            SB(); if (kq + 2 < 4) { LOAD_V(kq & 1, (R0_) + 16 * (kq + 2)); SB(); } } } while (0)
        LOAD_K(kfa, 0); SB();
        LOAD_K(kfb, 64); QK(kfa, a0, a1); SB();
        QK(kfb, b0, b1); SB();
        LOAD_V(0, 0); LOAD_V(1, 16); SB();
        sm_max2<4>(a0, a1, b0, b1, st, negm, O, t == 0); SB();
        sm_exp(a0, a1, st, pfa); SB();
        if (t + 1 < nkt) { DMA_LANE(); const int ktn = kt0 + t + 1;
#pragma unroll
            for (int i = 0; i < 4; ++i) { DMA4(DKimg(cur ^ 1), 4 * w + i, DIFF_KP); DMA4(DVimg(cur ^ 1), 4 * w + i, DIFF_VP); } }
        SB();
#pragma unroll
        for (int kq = 0; kq < 4; ++kq) {
#pragma unroll
            for (int c = 0; c < 4; ++c) O[c] = MFMA32(vf[kq & 1][c], pfa[kq], O[c]);
            if (kq + 2 < 4) LOAD_V(kq & 1, 16 * (kq + 2)); }
        sm_exp(b0, b1, st, pfb);
#pragma unroll
        for (int i_ = 0; i_ < 16; ++i_) { __builtin_amdgcn_sched_group_barrier(0x008, 1, 0); __builtin_amdgcn_sched_group_barrier(0x002, 5, 0); __builtin_amdgcn_sched_group_barrier(0x100, 1, 0); }
        SB();
        LOAD_V(0, 64); LOAD_V(1, 80); SB();
        PV(pfb, 64);
#undef LOAD_K
#undef QK
#undef LOAD_V
#undef PV
#undef SB
        VMWAIT0(); __syncthreads();
    }
#undef DIFF_KP
#undef DIFF_VP
#undef DIFF_KROW
#undef DKimg
#undef DVimg
    const float lam = ((const float*)(F.ws + WS_DEC))[32 + l], li = ((const float*)(F.ws + WS_DEC))[40 + l];
    int lane2_ = lane_now(); asm volatile("" : "+v"(lane2_));
    LAS float* ex = (LAS float*)F.lds + (size_t)(w & 3) * 4096 + lane2_;
    const float inv = (sm ? lam : 1.f) * ((DUP_MASK & 262144) ? 0.5f : 1.f) / xsum(st.l);
    if (sm) {
#pragma unroll
        for (int c = 0; c < 4; ++c)
#pragma unroll
            for (int r = 0; r < 16; ++r) ex[(c * 16 + r) * 64] = O[c][r] * inv;
    }
    __syncthreads();
    if (!sm) {
        const int hh2 = lane2_ >> 5; const int qrow2 = qrow0 + 32 * w + (lane2_ & 31);
        float ss = 0.f;
#pragma unroll
        for (int c = 0; c < 4; ++c)
#pragma unroll
            for (int r = 0; r < 16; ++r) { const float o = O[c][r] * inv - ex[(c * 16 + r) * 64]; O[c][r] = o; ss += o * o; }
        ss = xsum(ss);
        const float rs = (1.f / sqrtf(ss * (1.f / 128.f) + NORM_EPS)) * (1.f - li);
        const float* gs = F.in[I_SUBLN] + l * 128;
        bf16_t* yo = (bf16_t*)(F.ws + WS_Y) + (size_t)qrow2 * 2048 + 1024 + h * 128; unsigned char* yo8 = F.ws + WS_Y + (size_t)qrow2 * 2048 + 1024 + h * 128;
        f32x4 ggv[4][4];
#pragma unroll
        for (int c = 0; c < 4; ++c)
#pragma unroll
            for (int g = 0; g < 4; ++g) ggv[c][g] = *(const f32x4*)(gs + 32 * c + 8 * g + 4 * hh2);
        __builtin_amdgcn_sched_barrier(0);
#pragma unroll
        for (int c = 0; c < 4; ++c)
#pragma unroll
            for (int g = 0; g < 4; ++g) { const int dv = 32 * c + 8 * g + 4 * hh2; const f32x4 gg = ggv[c][g];
                const float y0 = O[c][4 * g] * rs * gg.x, y1 = O[c][4 * g + 1] * rs * gg.y, y2 = O[c][4 * g + 2] * rs * gg.z, y3 = O[c][4 * g + 3] * rs * gg.w;
                if (BR_FP8) *(unsigned*)(yo8 + dv) = pk_fp8x4(y0 * 8.f, y1 * 8.f, y2 * 8.f, y3 * 8.f);
                else *(u32x2*)(yo + dv) = (u32x2){cvt_pk_bf16(y0, y1), cvt_pk_bf16(y2, y3)}; }
    }
}

__device__ __forceinline__ void gqa_unit(Frame& F, int l, int b, int kvh, int half, int qb) {
    const bf16_t* P = (const bf16_t*)(F.ws + WS_P);
#define GImg(x) (F.lds + 16384 * (x))
    int lane_ = lane_now(); asm volatile("" : "+v"(lane_)); const int lane = lane_, w = F.wave, r32 = lane & 31, hh = lane >> 5;
    LA la = make_la(lane); la.rowb ^= 16u * hh;
    const int head = kvh * 4 + half * 2 + (w >> 2);
    const bool ctxq = qb >= 32;
    const int qpos = (ctxq ? (qb - 32) : qb) * 128 + (w & 3) * 32 + r32;
    const int qrow = (ctxq ? TL + b * 256 : b * 4096) + qpos;
    bf16x8 q[4];
#pragma unroll
    for (int ks = 0; ks < 4; ++ks) q[ks] = *(const bf16x8*)(P + (size_t)qrow * DIN + C_GQ + head * 64 + 16 * ks + 8 * hh);
    const int lo = ctxq ? 0 : (2 * qb - 2 < 0 ? 0 : 2 * qb - 2), hi = ctxq ? -1 : (2 * qb + 3 > 63 ? 63 : 2 * qb + 3);
    const int nkt = 4 + (hi - lo + 1);
    const char* kvbase = (const char*)(P + C_GKV + kvh * 128);
#define GQA_ROW(tt, i) ((tt) < 4 ? (size_t)(TL + b * 256 + (tt) * 64 + (i)) : (size_t)(b * 4096 + (lo + (tt) - 4) * 64 + (i)))
#define GQA_P(r_) (kvbase + GQA_ROW(ttn, (r_)) * (DIN * 2))
    f32x16 O[2]; ZERO16(O[0]); ZERO16(O[1]);
    SmState st = {-1e30f, 0.f};
    __syncthreads();
    { DMA_LANE(); const int ttn = 0; DMA4(GImg(0), 2 * w, GQA_P); DMA4(GImg(0), 2 * w + 1, GQA_P); }
    VMWAIT0(); __syncthreads();
    for (int t = 0; t < nkt; ++t) {
        const int cur = t & 1;
        if (t + 1 < nkt) { DMA_LANE(); const int ttn = t + 1; DMA4(GImg(cur ^ 1), 2 * w, GQA_P); DMA4(GImg(cur ^ 1), 2 * w + 1, GQA_P); }
        LAS unsigned char* Ic = GImg(cur);
        OPAQUE(la.rowb); OPAQUE(la.trp);
        f32x16 a0, a1; ZERO16(a0); ZERO16(a1);
        { bf16x8 kf[8];
#pragma unroll
          for (int ks = 0; ks < 4; ++ks) { kf[ks] = frag_row(Ic, la.rowb, 0, 2 * ks); kf[4 + ks] = frag_row(Ic, la.rowb, 32, 2 * ks); }
          __builtin_amdgcn_sched_barrier(0);
#pragma unroll
          for (int ks = 0; ks < 4; ++ks) { a0 = MFMA32(kf[ks], q[ks], a0); a1 = MFMA32(kf[4 + ks], q[ks], a1); } }
        if (t >= 4) {
            const int k0 = (lo + t - 4) * 64;
#pragma unroll
            for (int r = 0; r < 16; ++r) { const int d0 = qpos - (k0 + crow(r, hh)), d1 = d0 - 32;
                if (d0 > 128 || d0 < -128) a0[r] = -INFINITY; if (d1 > 128 || d1 < -128) a1[r] = -INFINITY; }
        }
        bf16x8 pf[4], vf[4][2];
#pragma unroll
        for (int kq = 0; kq < 4; ++kq)
#pragma unroll
            for (int c = 0; c < 2; ++c) vf[kq][c] = frag_trp(Ic, la.trp, 16 * kq, c, 8);
        __builtin_amdgcn_sched_barrier(0);
        softmax_head<2>(a0, a1, st, O);
        __builtin_amdgcn_sched_barrier(0);
        sm_exp_q(a0, st, pf[0], pf[1]);
        __builtin_amdgcn_sched_barrier(0);
#pragma unroll
        for (int kq = 0; kq < 2; ++kq)
#pragma unroll
            for (int c = 0; c < 2; ++c) O[c] = MFMA32(vf[kq][c], pf[kq], O[c]);
        sm_exp_q(a1, st, pf[2], pf[3]);
#pragma unroll
        for (int i_ = 0; i_ < 4; ++i_) { __builtin_amdgcn_sched_group_barrier(0x008, 1, 0); __builtin_amdgcn_sched_group_barrier(0x002, 12, 0); }
        __builtin_amdgcn_sched_barrier(0);
#pragma unroll
        for (int kq = 2; kq < 4; ++kq)
#pragma unroll
            for (int c = 0; c < 2; ++c) O[c] = MFMA32(vf[kq][c], pf[kq], O[c]);
        VMWAIT0(); __syncthreads();
    }
#undef GQA_P
#undef GQA_ROW
#undef GImg
    const float sink = F.in[I_SINK][l * 8 + head];
    const float inv = 1.f / (xsum(st.l) + fexp2(sink * LOG2E - st.m));
    bf16_t* yo = (bf16_t*)(F.ws + WS_Y) + (size_t)qrow * 2048 + 1536 + head * 64; unsigned char* yo8 = F.ws + WS_Y + (size_t)qrow * 2048 + 1536 + head * 64;
#pragma unroll
    for (int c = 0; c < 2; ++c)
#pragma unroll
        for (int g = 0; g < 4; ++g) { const int dv = 32 * c + 8 * g + 4 * hh;
            const float y0 = O[c][4 * g] * inv, y1 = O[c][4 * g + 1] * inv, y2 = O[c][4 * g + 2] * inv, y3 = O[c][4 * g + 3] * inv;
            if (BR_FP8) *(unsigned*)(yo8 + dv) = pk_fp8x4(y0 * 8.f, y1 * 8.f, y2 * 8.f, y3 * 8.f);
            else *(u32x2*)(yo + dv) = (u32x2){cvt_pk_bf16(y0, y1), cvt_pk_bf16(y2, y3)}; }
}

__device__ __forceinline__ size_t ret_row(int b, int cid, int i) { return cid < 2 ? (size_t)(TL + b * 256 + cid * 128 + i) : (size_t)(b * 4096 + (cid - 2) * 128 + i); }
__device__ __forceinline__ bf16_t* st_ptr(const Frame& F, int b, int h, int dir, int cid) { return (bf16_t*)(F.ws + WS_ST) + ((((size_t)b * 4 + h) * 2 + dir) * NCHUNK + cid) * (256 * 128); }
__device__ __forceinline__ void ret_scan_item(Frame& F, int l, int item) {
    const int eh = item & 1, dir = (item >> 1) & 1, h = (item >> 2) & 3, b = item >> 4;
    int lane_ = lane_now(); asm volatile("" : "+v"(lane_)); const int lane = lane_, w = F.wave, r32 = lane & 31, hh = lane >> 5;
    LA la = make_la(lane);
    const int db = w >> 1, eb0 = 2 * (w & 1);
#define RKimg(x) (F.lds + 65536 * (x))
#define RVimg(x) (F.lds + 32768 + 65536 * (x))
    const char* kbase = (const char*)((const bf16_t*)(F.ws + WS_P) + C_RK + h * 128);
    const char* vbase = (const char*)((const bf16_t*)(F.ws + WS_P) + C_RV + h * 256 + eh * 128);
    const float lg = ((const float*)(F.ws + WS_DEC))[l * 8 + dir * 4 + h];
    const float cd = fexp2(lg * 128.f);
    float dk[8];
#pragma unroll
    for (int j = 0; j < 8; ++j) dk[j] = dir == 0 ? fexp2(lg * (float)(127 - 8 * hh - j)) : fexp2(lg * (float)(8 * hh + j));
    const float lgs = dir == 0 ? -16.f * lg : 16.f * lg;
#define R1_CID(n) (dir == 0 ? (n) : ((n) == 0 ? 1 : ((n) == 1 ? 0 : 35 - (n))))
#define R1_KP(r_) (kbase + ret_row(b, cidn, (r_)) * (DIN * 2))
#define R1_VP(r_) (vbase + ret_row(b, cidn, (r_)) * (DIN * 2))
    f32x16 S0, S1; ZERO16(S0); ZERO16(S1);
    __syncthreads();
    { DMA_LANE(); const int cidn = R1_CID(0);
#pragma unroll
      for (int i = 0; i < 4; ++i) { DMA4(RKimg(0), 4 * w + i, R1_KP); DMA4(RVimg(0), 4 * w + i, R1_VP); } }
    VMWAIT0(); __syncthreads();
    for (int n = 0; n < NCHUNK; ++n) {
        const int cur = n & 1, cid = R1_CID(n);
        if (n + 1 < NCHUNK - 1) { DMA_LANE(); const int cidn = R1_CID(n + 1);
#pragma unroll
            for (int i = 0; i < 4; ++i) { DMA4(RKimg(cur ^ 1), 4 * w + i, R1_KP); DMA4(RVimg(cur ^ 1), 4 * w + i, R1_VP); } }
        bf16_t* sp = st_ptr(F, b, h, dir, cid);
#pragma unroll
        for (int g = 0; g < 4; ++g) { const int d = 32 * db + 8 * g + 4 * hh;
            *(u32x2*)(sp + (size_t)(eh * 128 + 32 * eb0 + r32) * 128 + d) = (u32x2){cvt_pk_bf16(S0[4 * g], S0[4 * g + 1]), cvt_pk_bf16(S0[4 * g + 2], S0[4 * g + 3])};
            *(u32x2*)(sp + (size_t)(eh * 128 + 32 * (eb0 + 1) + r32) * 128 + d) = (u32x2){cvt_pk_bf16(S1[4 * g], S1[4 * g + 1]), cvt_pk_bf16(S1[4 * g + 2], S1[4 * g + 3])}; }
        if (n < NCHUNK - 1) {
            S0 = S0 * cd; S1 = S1 * cd;
            OPAQUE(la.trn);
#pragma unroll
            for (int ks = 0; ks < 8; ++ks) {
                bf16x8 a = frag_trn(RKimg(cur), la.trn, 16 * ks, db, 0);
                { const float fk = fexp2(lgs * (float)ks); u32x4 aw = __builtin_bit_cast(u32x4, a);
                  aw.x = cvt_pk_bf16(bflo(aw.x) * (dk[0] * fk), bfhi(aw.x) * (dk[1] * fk)); aw.y = cvt_pk_bf16(bflo(aw.y) * (dk[2] * fk), bfhi(aw.y) * (dk[3] * fk));
                  aw.z = cvt_pk_bf16(bflo(aw.z) * (dk[4] * fk), bfhi(aw.z) * (dk[5] * fk)); aw.w = cvt_pk_bf16(bflo(aw.w) * (dk[6] * fk), bfhi(aw.w) * (dk[7] * fk));
                  a = __builtin_bit_cast(bf16x8, aw); }
                S0 = MFMA32(a, frag_trn(RVimg(cur), la.trn, 16 * ks, eb0, 0), S0);
                S1 = MFMA32(a, frag_trn(RVimg(cur), la.trn, 16 * ks, eb0 + 1, 0), S1); }
        }
        VMWAIT0(); __syncthreads();
    }
#undef R1_KP
#undef R1_VP
#undef R1_CID
#undef RKimg
#undef RVimg
    if (F.wave == 0 && lane_now() == 0) { __builtin_amdgcn_fence(__ATOMIC_RELEASE, "agent"); asm volatile("s_waitcnt vmcnt(0)" ::: "memory"); __hip_atomic_fetch_add(F.ctl + CW_R1 + l * 64, 1u, __ATOMIC_RELAXED, __HIP_MEMORY_SCOPE_AGENT); }
}
__device__ __forceinline__ void ret_out_unit(Frame& F, int l, int b, int h, int cid) {
    const bf16_t* P = (const bf16_t*)(F.ws + WS_P);
    int lane_ = lane_now(); asm volatile("" : "+v"(lane_)); const int lane = lane_, w = F.wave, r32 = lane & 31, hh = lane >> 5;
    LA la = make_la(lane); const unsigned rowb0 = la.rowb; la.rowb ^= 16u * hh;
    LAS unsigned char* Qimg = F.lds; LAS unsigned char* Kimg = F.lds + 32768; LAS unsigned char* Vimg0 = F.lds + 65536;
    LAS float* red = (LAS float*)(F.lds + 131072);
    const float lgf = ((const float*)(F.ws + WS_DEC))[l * 8 + h], lgb = ((const float*)(F.ws + WS_DEC))[l * 8 + 4 + h];
    const char* qbase = (const char*)(P + C_RQ + h * 128); const char* kbase = (const char*)(P + C_RK + h * 128); const char* vbase = (const char*)(P + C_RV + h * 256);
#define R2_QP(r_) (qbase + ret_row(b, cid, (r_)) * (DIN * 2))
#define R2_KP(r_) (kbase + ret_row(b, cid, (r_)) * (DIN * 2))
#define R2_V0(r_) (vbase + ret_row(b, cid, (r_)) * (DIN * 2))
#define R2_V1(r_) (vbase + 256 + ret_row(b, cid, (r_)) * (DIN * 2))
    __syncthreads();
    DMA_LANE();
#pragma unroll
    for (int i = 0; i < 4; ++i) { DMA4(Qimg, 4 * w + i, R2_QP); DMA4(Kimg, 4 * w + i, R2_KP); DMA4(Vimg0, 4 * w + i, R2_V0); DMA4(Vimg0 + 32768, 4 * w + i, R2_V1); }
    VMWAIT0(); __syncthreads();
#undef R2_QP
#undef R2_KP
#undef R2_V0
#undef R2_V1
    f32x16 at0, at1; ZERO16(at0); ZERO16(at1);
    const int ibw = w >> 1, jbw = 2 * (w & 1);
#pragma unroll
    for (int kh = 0; kh < 2; ++kh) { bf16x8 qf[4], k0[4], k1[4];
#pragma unroll
        for (int ks = 0; ks < 4; ++ks) { qf[ks] = frag_row(Qimg, la.rowb, 32 * ibw, 2 * (4 * kh + ks)); k0[ks] = frag_row(Kimg, la.rowb, 32 * jbw, 2 * (4 * kh + ks)); k1[ks] = frag_row(Kimg, la.rowb, 32 * jbw + 32, 2 * (4 * kh + ks)); }
        __builtin_amdgcn_sched_barrier(0);
#pragma unroll
        for (int ks = 0; ks < 4; ++ks) { at0 = MFMA32(k0[ks], qf[ks], at0); at1 = MFMA32(k1[ks], qf[ks], at1); } }
    { const int i = 32 * ibw + r32;
#pragma unroll
      for (int r = 0; r < 16; ++r) { const int j0 = 32 * jbw + crow(r, hh), j1 = j0 + 32;
          at0[r] *= i > j0 ? fexp2(lgf * (float)(i - j0)) : (i < j0 ? fexp2(lgb * (float)(j0 - i)) : 2.f);
          at1[r] *= i > j1 ? fexp2(lgf * (float)(i - j1)) : (i < j1 ? fexp2(lgb * (float)(j1 - i)) : 2.f); } }
    __syncthreads();
#pragma unroll
    for (int g = 0; g < 4; ++g) {
        *(LAS u32x2*)(Kimg + 8192 * ibw + ((rowb0 + 8u * hh) ^ (16u * (4u * jbw + g)))) = (u32x2){cvt_pk_bf16(at0[4 * g], at0[4 * g + 1]), cvt_pk_bf16(at0[4 * g + 2], at0[4 * g + 3])};
        *(LAS u32x2*)(Kimg + 8192 * ibw + ((rowb0 + 8u * hh) ^ (16u * (4u * jbw + 4u + g)))) = (u32x2){cvt_pk_bf16(at1[4 * g], at1[4 * g + 1]), cvt_pk_bf16(at1[4 * g + 2], at1[4 * g + 3])}; }
    __syncthreads();
    f32x16 o[4];
    const float dfl = fexp2(lgf * (float)(r32 + 1)), dbl = fexp2(lgb * (float)(128 - r32));
    {
        const bf16_t* sf = st_ptr(F, b, h, 0, cid) + (size_t)(32 * w + r32) * 128 + 8 * hh;
        const bf16_t* sb = st_ptr(F, b, h, 1, cid) + (size_t)(32 * w + r32) * 128 + 8 * hh;
        bf16x8 af[8];
#pragma unroll
        for (int ks = 0; ks < 8; ++ks) af[ks] = *(const bf16x8*)(sf + 16 * ks);
#pragma unroll
        for (int ib = 0; ib < 4; ++ib) { f32x16 a; ZERO16(a); OPAQUE(la.rowb); bf16x8 bq[8];
#pragma unroll
            for (int ks = 0; ks < 8; ++ks) bq[ks] = frag_row(Qimg, la.rowb, 32 * ib, 2 * ks);
            __builtin_amdgcn_sched_barrier(0);
#pragma unroll
            for (int ks = 0; ks < 8; ++ks) a = MFMA32(af[ks], bq[ks], a);
            o[ib] = a * (dfl * fexp2(lgf * (float)(32 * ib))); }
#pragma unroll
        for (int ks = 0; ks < 8; ++ks) af[ks] = *(const bf16x8*)(sb + 16 * ks);
#pragma unroll
        for (int ib = 0; ib < 4; ++ib) { f32x16 a; ZERO16(a); OPAQUE(la.rowb); bf16x8 bq[8];
#pragma unroll
            for (int ks = 0; ks < 8; ++ks) bq[ks] = frag_row(Qimg, la.rowb, 32 * ib, 2 * ks);
            __builtin_amdgcn_sched_barrier(0);
#pragma unroll
            for (int ks = 0; ks < 8; ++ks) a = MFMA32(af[ks], bq[ks], a);
            o[ib] += a * (dbl * fexp2(-lgb * (float)(32 * ib))); }
        LAS unsigned char* Vh = Vimg0 + 32768 * (w >> 2);
#pragma unroll
        for (int ks = 0; ks < 8; ++ks) af[ks] = frag_trn(Vh, la.trn, 16 * ks, w & 3, 0);
#pragma unroll
        for (int ib = 0; ib < 4; ++ib) { OPAQUE(la.rowb); bf16x8 bq[8];
#pragma unroll
            for (int ks = 0; ks < 8; ++ks) bq[ks] = frag_row(Kimg, la.rowb, 32 * ib, 2 * ks);
            __builtin_amdgcn_sched_barrier(0);
#pragma unroll
            for (int ks = 0; ks < 8; ++ks) o[ib] = MFMA32(af[ks], bq[ks], o[ib]); }
    }
#pragma unroll
    for (int ib = 0; ib < 4; ++ib) { float s = 0.f, s2 = 0.f;
#pragma unroll
        for (int r = 0; r < 16; ++r) { s += o[ib][r]; s2 += o[ib][r] * o[ib][r]; }
        s = xsum(s); s2 = xsum(s2);
        if (hh == 0) { red[(w * 128 + 32 * ib + r32) * 2] = s; red[(w * 128 + 32 * ib + r32) * 2 + 1] = s2; } }
    __syncthreads();
    const int ybase = h * 256 + 32 * w;
#pragma unroll
    for (int ib = 0; ib < 4; ++ib) { float s = 0.f, s2 = 0.f;
#pragma unroll
        for (int ww = 0; ww < 8; ++ww) { s += red[(ww * 128 + 32 * ib + r32) * 2]; s2 += red[(ww * 128 + 32 * ib + r32) * 2 + 1]; }
        const float mu = s * (1.f / 256.f), var = fmaxf(s2 * (1.f / 256.f) - mu * mu, 0.f), rs = 1.f / sqrtf(var + NORM_EPS);
        const size_t row = ret_row(b, cid, 32 * ib + r32);
        const bf16_t* gp = P + row * DIN + C_RG + ybase; bf16_t* yo = (bf16_t*)(F.ws + WS_Y) + row * 2048 + ybase;
#pragma unroll
        for (int g = 0; g < 4; ++g) { const int e = 8 * g + 4 * hh; const u32x2 gw = *(const u32x2*)(gp + e);
            const float y0 = (o[ib][4 * g] - mu) * rs * bflo(gw.x), y1 = (o[ib][4 * g + 1] - mu) * rs * bfhi(gw.x), y2 = (o[ib][4 * g + 2] - mu) * rs * bflo(gw.y), y3 = (o[ib][4 * g + 3] - mu) * rs * bfhi(gw.y);
            if (BR_FP8) *(unsigned*)(F.ws + WS_Y + row * 2048 + ybase + e) = pk_fp8x4(y0 * 8.f, y1 * 8.f, y2 * 8.f, y3 * 8.f);
            else *(u32x2*)(yo + e) = (u32x2){cvt_pk_bf16(y0, y1), cvt_pk_bf16(y2, y3)}; } }
}

__device__ __forceinline__ void p_norm2_router(Frame& F, int l, bool dry = false) {
    LAS int* lcount = (LAS int*)F.lds;
    LAS int* lbase = lcount + 32;
    LAS int* rec_e = lbase + 32;
    LAS float* rec_w = (LAS float*)(rec_e + 1024);
    LAS int* rec_a = (LAS int*)(rec_w + 1024);
    LAS int* nrec = rec_a + 1024;
    int lane_ = lane_now(); asm volatile("" : "+v"(lane_)); const int lane = lane_, w = F.wave, r32 = lane & 31, hh = lane >> 5;
    const int NGRP = (l < DEPTH - 1 ? TT : TL) / 32;
    float sink_acc = 0.f;
    if (F.tid < 32) lcount[F.tid] = 0;
    if (F.tid == 32) *nrec = 0;
    const Row16 g = ld_row_f32(F.in[I_GFFN] + (size_t)l * D, lane);
    bf16_t* H = (bf16_t*)(F.ws + WS_H); bf16_t* HLO = (bf16_t*)(F.ws + WS_MGB);
    for (int grp = F.bid; grp < NGRP; grp += F.G)
        for (int i = 0; i < 4; ++i) {
            const int row = grp * 32 + w * 4 + i;
            const Row16 x = ld_row_f32((const float*)(F.ws + WS_XRES) + (size_t)row * D, lane);
            const float rs = row_rstd(x); const int v = row_modv(row);
            const Row16 sh = ld_row_f32(modp(F, l, v, 3), lane), sc = ld_row_f32(modp(F, l, v, 4), lane);
            Row16 h, lo;
#pragma unroll
            for (int j = 0; j < 4; ++j) { h.v[j] = x.v[j] * rs * g.v[j] * (sc.v[j] + 1.f) + sh.v[j];
                const unsigned a = cvt_pk_bf16(h.v[j].x, h.v[j].y), b = cvt_pk_bf16(h.v[j].z, h.v[j].w);
                lo.v[j] = h.v[j] - (f32x4){bflo(a), bfhi(a), bflo(b), bfhi(b)}; }
            st_row_bf16(H + (size_t)row * D, lane, h); st_row_bf16(HLO + (size_t)row * D, lane, lo);
            { unsigned* h8 = (unsigned*)(F.ws + WS_MG + (size_t)row * D) + lane;
#pragma unroll
              for (int j = 0; j < 4; ++j) h8[64 * j] = pk_fp8x4(h.v[j].x * 8.f, h.v[j].y * 8.f, h.v[j].z * 8.f, h.v[j].w * 8.f); }
        }
    VMWAIT0(); __syncthreads();
    __builtin_amdgcn_fence(__ATOMIC_ACQUIRE, "agent");
    LAS float* part = (LAS float*)(F.lds + 16384);
    for (int g0 = 0; F.bid + g0 * F.G < NGRP; g0 += 3) {
        __syncthreads();
        for (int gi = 0; gi < 3; ++gi) { const int grp = F.bid + (g0 + gi) * F.G; if (grp >= NGRP) break;
            const bf16_t* wr = (const bf16_t*)(F.ws + WS_WRT) + (size_t)l * 2 * NEXP * D + (size_t)r32 * D + 8 * hh + 128 * w;
            const bf16_t* hp = H + (size_t)(grp * 32 + r32) * D + 8 * hh + 128 * w; const bf16_t* lp = HLO + (size_t)(grp * 32 + r32) * D + 8 * hh + 128 * w;
            f32x16 pacc; ZERO16(pacc);
            bf16x8 whi[8], wlo[8], xhi[8], xlo[8];
#pragma unroll
            for (int ks = 0; ks < 8; ++ks) { whi[ks] = *(const bf16x8*)(wr + 16 * ks); wlo[ks] = *(const bf16x8*)(wr + NEXP * D + 16 * ks); xhi[ks] = *(const bf16x8*)(hp + 16 * ks); xlo[ks] = *(const bf16x8*)(lp + 16 * ks); }
            __builtin_amdgcn_sched_barrier(0);
#pragma unroll
            for (int ks = 0; ks < 8; ++ks) { pacc = MFMA32(whi[ks], xhi[ks], pacc); pacc = MFMA32(whi[ks], xlo[ks], pacc); pacc = MFMA32(wlo[ks], xhi[ks], pacc); }
#pragma unroll
            for (int r = 0; r < 16; ++r) part[((gi * 8 + w) * 16 + r) * 64 + lane] = pacc[r];
        }
        __syncthreads();
        const int grp = F.bid + (g0 + w) * F.G;
        if (w < 3 && grp < NGRP) {
            f32x16 acc;
#pragma unroll
            for (int r = 0; r < 16; ++r) { float sum = 0.f;
#pragma unroll
                for (int ww = 0; ww < 8; ++ww) sum += part[((w * 8 + ww) * 16 + r) * 64 + lane];
                acc[r] = sum; }
            float mine[16], oth[16];
#pragma unroll
            for (int r = 0; r < 16; ++r) { mine[r] = acc[r] + F.in[I_BR][l * NEXP + crow(r, hh)]; oth[r] = xother(mine[r], hh); }
            float tv[4]; int ti[4];
#pragma unroll
            for (int k = 0; k < 4; ++k) {
                float best = -INFINITY; int bi = 1 << 20;
#pragma unroll
                for (int r = 0; r < 16; ++r) { const int e0 = crow(r, hh), e1 = crow(r, hh ^ 1);
                    if (mine[r] > best || (mine[r] == best && e0 < bi)) { best = mine[r]; bi = e0; }
                    if (oth[r] > best || (oth[r] == best && e1 < bi)) { best = oth[r]; bi = e1; } }
                tv[k] = best; ti[k] = bi;
#pragma unroll
                for (int r = 0; r < 16; ++r) { if (crow(r, hh) == bi) mine[r] = -INFINITY; if (crow(r, hh ^ 1) == bi) oth[r] = -INFINITY; }
            }
            if (dry) sink_acc += tv[0] + tv[1] + tv[2] + tv[3] + (float)(ti[0] + ti[1] + ti[2] + ti[3]);
            if (hh == 0 && !dry) {
                const float e1 = fexp2((tv[1] - tv[0]) * LOG2E), e2 = fexp2((tv[2] - tv[0]) * LOG2E), e3 = fexp2((tv[3] - tv[0]) * LOG2E), inv = 1.f / (1.f + e1 + e2 + e3);
                const float wk[4] = {inv, e1 * inv, e2 * inv, e3 * inv};
                const int token = grp * 32 + r32;
#pragma unroll
                for (int k = 0; k < 4; ++k) { const int pos = __hip_atomic_fetch_add(&lcount[ti[k]], 1, __ATOMIC_RELAXED, __HIP_MEMORY_SCOPE_WORKGROUP); const int slot = __hip_atomic_fetch_add(nrec, 1, __ATOMIC_RELAXED, __HIP_MEMORY_SCOPE_WORKGROUP);
                    rec_e[slot] = ti[k] | (pos << 8); rec_w[slot] = wk[k]; rec_a[slot] = token * 4 + k; }
            }
        }
    }
    __syncthreads();
    int* cnt = (int*)(F.ctl + CW_CNT + l * 64);
    if (dry) { if (sink_acc == 1.2345e33f) cnt[63] = 1; __syncthreads(); return; }
    if (F.tid < 32) lbase[F.tid] = atomicAdd(&cnt[F.tid], lcount[F.tid]);
    __syncthreads();
    int* list = (int*)(F.ws + WS_LIST); float* tw = (float*)(F.ws + WS_TW);
    const int n = *nrec;
    for (int i = F.tid; i < n; i += NTHR) { const int e = rec_e[i] & 255, pos = rec_e[i] >> 8, a = rec_a[i]; list[(size_t)e * TT + lbase[e] + pos] = a; tw[a] = rec_w[i]; }
}
__device__ __forceinline__ void moe_prefix(Frame& F, int l, LAS int* pref) {
    __syncthreads();
    if (F.tid == 0) { const int* cnt = (const int*)(F.ctl + CW_CNT + l * 64); int s = 0;
        for (int e = 0; e < NEXP; ++e) { pref[e] = s; s += (cnt[e] + 255) >> 8; } pref[NEXP] = s; }
    __syncthreads();
    { const int ntile = pref[NEXP]; const int* cnt = (const int*)(F.ctl + CW_CNT + l * 64);
      int t0_ = tid_now(F.wave); asm volatile("" : "+v"(t0_));
      for (int ti = t0_; ti < ntile; ti += NTHR) { int e = 0; for (int k = 1; k < NEXP; ++k) e += (pref[k] <= ti) ? 1 : 0;
          const int mt = ti - pref[e]; int valid = cnt[e] - mt * 256; valid = valid > 256 ? 256 : valid; pref[64 + ti] = e | (valid << 8) | (mt << 20); } }
    __syncthreads();
}

constexpr int NPH = 2 + 9 * DEPTH;
struct Args { const float* in[26]; float* out; unsigned char* ws; int ph_lo, ph_hi; };
__global__ void __launch_bounds__(NTHR, 2) mk_fwd(Args args) {
    extern __shared__ __attribute__((aligned(16))) unsigned char lds_raw[];
    Frame F;
    F.lds = (LAS unsigned char*)lds_raw;
    F.tid = threadIdx.x; F.lane = F.tid & 63; F.wave = __builtin_amdgcn_readfirstlane(F.tid >> 6);
    F.G = gridDim.x; F.bid = blockIdx.x;
    F.ws = args.ws; F.ctl = (unsigned*)(args.ws + WS_CTL); F.out = args.out;
    F.in = args.in;
    volatile LAS unsigned* MISC = (volatile LAS unsigned*)(F.lds + LDS_MISC);
    if (F.tid < 64) MISC[F.tid] = 0u;
    __syncthreads();
    const int lo = args.ph_lo, hi = args.ph_hi;
    XcdBarrier bar; bar.bar = F.ctl + CW_BAR; bar.x = 0; bar.wv = 0;
    if (hi - lo > 1) bar = xcd_barrier_post(F.ctl + CW_BAR, MISC);
    bar.wv = F.wave;
#ifdef ONLY_PH
#define IN(k) (ONLY_PH == ((k) == 0 ? 0 : 37) && lo <= (k) && (k) < hi)
#define INL(j) (ONLY_PH == 1 + (j) && lo <= pb + (j) && pb + (j) < hi)
#else
#define IN(k) (lo <= (k) && (k) < hi)
#define INL(j) IN(pb + (j))
#endif
#define SEAM(k) do { if (lo <= (k) + 1 && (k) + 1 < hi) { xcd_barrier(bar); if (DUP_MASK & 8192) xcd_barrier(bar); } } while (0)
    LAS int* pref = (LAS int*)(F.lds + 131072);
#define PHASE_BEGIN() do { WS_OPAQUE(); int _t = tid_now(F.wave); asm volatile("" : "+v"(_t)); F.tid = _t; F.lane = _t & 63; } while (0)
#define WS_OPAQUE() do { const unsigned long long _w = (unsigned long long)args.ws;        int _l = __builtin_amdgcn_readfirstlane((int)(unsigned)_w), _h = __builtin_amdgcn_readfirstlane((int)(unsigned)(_w >> 32)); \
        int _wv = F.wave, _bd = F.bid, _g = F.G; asm volatile("" : "+s"(_l), "+s"(_h), "+s"(_wv), "+s"(_bd), "+s"(_g)); F.wave = _wv; F.bid = _bd; F.G = _g; \
        F.ws = (unsigned char*)(((unsigned long long)(unsigned)_h << 32) | (unsigned)_l); F.ctl = (unsigned*)(F.ws + WS_CTL); } while (0)

#define BG_CONVERT(nwg_, which_) do { const int _maxn = ((nwg_) + F.G - 1) / F.G, _nb = F.bid < (nwg_) ? ((nwg_) - 1 - F.bid) / F.G + 1 : 0, _nlong = (nwg_) - (_maxn - 1) * F.G; \
        unsigned* _cnt = F.ctl + CW_LONG + l * 4 + (which_); PHASE_BEGIN(); \
        if (_nb == _maxn) { if (F.tid == 0) __hip_atomic_fetch_add(_cnt, 1u, __ATOMIC_RELAXED, __HIP_MEMORY_SCOPE_AGENT); } \
        else { while (conv_chunk(F, l + 1, _cnt, (unsigned)_nlong)) { } } } while (0)
    if (IN(0)) { PHASE_BEGIN(); p0_prologue(F); if (DUP_MASK & 512) { __syncthreads(); p0_prologue(F); } SEAM(0); }
    for (int l = 0; l < DEPTH; ++l) {
        const int pb = 1 + 9 * l;
        const bool need_ctx = l < DEPTH - 1;
        if (INL(0)) { PHASE_BEGIN(); if (DUP_MASK & 1) p_norm1(F, l, true); p_norm1(F, l); if (l > 0) { while (conv_chunk(F, l, nullptr, 0u)) { } } SEAM(pb + 0); }
        if (INL(1)) for (int rep_ = 0; rep_ < ((DUP_MASK >> 1) & 1) + 1; ++rep_) {
            WS_OPAQUE();
            SchedPlain S; S.o.init(TT / 256, DIN / 256, F.G, F.bid); S.A = (const char*)(F.ws + WS_H); S.B = (const char*)(F.ws + WS_WIN) + (size_t)l * DIN * D * (WIN_FP8 ? 1 : 2); S.lda = WIN_FP8 ? 1024 : 2048; S.ldb = S.lda; S.nt = WIN_FP8 ? 8 : 16;
            EpiIn E{(bf16_t*)(F.ws + WS_P), (const f32x4*)(F.ws + WS_ROPE128), (const f32x4*)(F.ws + WS_ROPE64)}; if (DUP_MASK & 16384) { S.dupk = 1; E.pre = 0.5f; } E.P = pin(E.P);
            gm::gemm_phase<EpiIn, SchedPlain, false, WIN_FP8 != 0>(F.lds, S, E, S.lda, S.ldb, F.wave);
            SEAM(pb + 1);
        }
        if (INL(2)) { WS_OPAQUE();
#if !defined(SUB) || SUB == 0
            for (int it = F.bid; it < 64 * (((DUP_MASK >> 10) & 1) + 1); it += F.G) ret_scan_item(F, l, it & 63);
#endif
#if !defined(SUB) || SUB == 1
            for (int u_ = F.bid; u_ < 512 * (((DUP_MASK >> 11) & 1) + 1); u_ += F.G) { const int u = u_ & 511; diff_unit(F, l, u >> 7, (u >> 5) & 3, 0, u & 31); }
            if (need_ctx) for (int u = (F.bid + F.G - 224 % F.G) % F.G; u < 32; u += F.G) diff_unit(F, l, u >> 3, (u >> 1) & 3, 1, u & 1);
#endif
#if !defined(SUB) || SUB == 2
            { const int nq = need_ctx ? 34 : 32, ngq = 16 * nq, g0 = F.G > 128 ? 64 : 0;
              if (F.bid >= g0) for (int u = F.bid - g0; u < ngq; u += F.G - g0) { const int qb = u % nq, r = u / nq; gqa_unit(F, l, r >> 2, (r >> 1) & 1, r & 1, qb); } }
#endif
            {
                __syncthreads();
                if (F.wave == 0) { unsigned* cw = F.ctl + CW_R1 + l * 64; unsigned sp_ = 0;
                    while ((unsigned)__builtin_amdgcn_readfirstlane((int)__hip_atomic_load(cw, __ATOMIC_RELAXED, __HIP_MEMORY_SCOPE_AGENT)) < 64u) { __builtin_amdgcn_s_sleep(2); if (++sp_ > (1u << 24)) break; }
                    __builtin_amdgcn_fence(__ATOMIC_ACQUIRE, "agent"); asm volatile("s_waitcnt vmcnt(0)" ::: "memory"); }
                __syncthreads();
                const int c0 = need_ctx ? 0 : 2, nc = NCHUNK - c0, nu = 16 * nc, g0 = F.G > 128 ? 64 : 0;
                if (F.bid < g0) { const int u = F.bid; if (u < nu) { const int cid = c0 + u % nc, r = u / nc; ret_out_unit(F, l, r >> 2, r & 3, cid); } }
                else for (int u = g0 + (F.bid - g0); u < nu; u += F.G - g0) { const int cid = c0 + u % nc, r = u / nc; ret_out_unit(F, l, r >> 2, r & 3, cid); }
            }
            SEAM(pb + 2);
        }
        if (INL(3)) { }
        const bool fused45 = (F.G == 256) && (hi - lo > 1);
        if (INL(4)) { WS_OPAQUE();
            EpiBranch E{pin((const bf16_t*)(F.ws + WS_P)), pin((bf16_t*)(F.ws + WS_MGB))};
            if (fused45) {
                SchedBranchX S{F.bid, need_ctx ? 1 : 0, (const char*)(F.ws + WS_Y), (const char*)(F.ws + WS_WBR) + (size_t)l * D * 2048 * 2, F.ctl + CW_PB + l * 2048, F.wave};
                gm::gemm_phase<EpiBranch, SchedBranchX, false, false>(F.lds, S, E, 4096, 4096, F.wave);
            } else {
                SchedBranch S; S.o.init(need_ctx ? TT / 256 : TL / 256, 4, F.G, F.bid); S.Y = (const char*)(F.ws + WS_Y); S.W = (const char*)(F.ws + WS_WBR) + (size_t)l * D * 2048 * (BR_FP8 ? 1 : 2);
                gm::gemm_phase<EpiBranch, SchedBranch, false, BR_FP8 != 0>(F.lds, S, E, BR_FP8 ? 2048 : 4096, BR_FP8 ? 2048 : 4096, F.wave);
                if (need_ctx) BG_CONVERT(S.o.nwg, 0);
                SEAM(pb + 4);
            }
        }
        if (INL(5)) { WS_OPAQUE();
            EpiOut E{pin((float*)(F.ws + WS_XRES)), pin((const float*)(F.ws + WS_MOD) + (size_t)l * 5 * 6144), pin((float*)(F.ws + WS_XRES))};
            if (fused45) {
                SchedOutX S{F.bid, need_ctx ? 1 : 0, (const char*)(F.ws + WS_MGB), (const char*)(F.ws + WS_WOUT) + (size_t)l * D * D * 2, F.ctl + CW_PB + l * 2048, F.wave};
                gm::gemm_phase<EpiOut, SchedOutX, false, false>(F.lds, S, E, 2048, 2048, F.wave);
                if (need_ctx) {
                    unsigned* cnt_ = F.ctl + CW_LONG + l * 4; PHASE_BEGIN();
                    if ((F.bid & 7) < 4 && (F.bid >> 3) < 4) { if (F.tid == 0) __hip_atomic_fetch_add(cnt_, 1u, __ATOMIC_RELAXED, __HIP_MEMORY_SCOPE_AGENT); }
                    else { while (conv_chunk(F, l + 1, cnt_, 16u)) { } }
                }
            } else {
                SchedPlain S; S.o.init(need_ctx ? TT / 256 : TL / 256, 4, F.G, F.bid); S.A = (const char*)(F.ws + WS_MGB); S.B = (const char*)(F.ws + WS_WOUT) + (size_t)l * D * D * (BR_FP8 ? 1 : 2); S.lda = BR_FP8 ? 1024 : 2048; S.ldb = S.lda; S.nt = BR_FP8 ? 8 : 16;
                gm::gemm_phase<EpiOut, SchedPlain, false, BR_FP8 != 0>(F.lds, S, E, S.lda, S.ldb, F.wave);
                if (need_ctx) BG_CONVERT(S.o.nwg, 1);
            }
            SEAM(pb + 5);
        }
        if (INL(6)) { PHASE_BEGIN(); if (DUP_MASK & 64) p_norm2_router(F, l, true); p_norm2_router(F, l); SEAM(pb + 6); }
        if (INL(7)) for (int rep_ = 0; rep_ < ((DUP_MASK >> 7) & 1) + 1; ++rep_) {
            PHASE_BEGIN(); moe_prefix(F, l, pref);
            SchedGU S{F.G, F.bid, pref, (const int*)(F.ctl + CW_CNT + l * 64), (const int*)(F.ws + WS_LIST), (const char*)(F.ws + WS_MG), (const char*)(F.ws + WS_WGU) + (size_t)l * NEXP * 2048 * D, F.wave};
            EpiGU E{pin((bf16_t*)(F.ws + WS_ACT)), pin(F.in[I_BGU] + (size_t)l * NEXP * 2048)}; S.cnt = pin(S.cnt); S.list = pin(S.list);
            gm::gemm_phase<EpiGU, SchedGU, true, true>(F.lds, S, E, 1024, 1024, F.wave);
            SEAM(pb + 7);
        }
        if (INL(8)) for (int rep_ = 0; rep_ < ((DUP_MASK >> 8) & 1) + 1; ++rep_) {
            PHASE_BEGIN(); moe_prefix(F, l, pref);
            SchedDN S{F.G, F.bid, pref, (const int*)(F.ctl + CW_CNT + l * 64), (const char*)(F.ws + WS_ACT), (const char*)(F.ws + WS_WDN) + (size_t)l * NEXP * D * D};
            EpiDN E{pin((bf16_t*)(F.ws + WS_YK)), pin(F.in[I_BDN] + (size_t)l * NEXP * D), pin((const int*)(F.ws + WS_LIST)), pin((const float*)(F.ws + WS_TW))};
            gm::gemm_phase<EpiDN, SchedDN, false, true>(F.lds, S, E, 1024, 1024, F.wave);
            SEAM(pb + 8);
        }
    }
    if (IN(NPH - 1)) { PHASE_BEGIN(); p_final(F); }
#undef IN
#undef INL
#undef SEAM
}


#ifdef DBG_CHECK
constexpr int CW_DBG = 12288;
__device__ __forceinline__ void dbg_err(unsigned* ctl, int k, float fast, float ref, float scale) {
    float e = fabsf(fast - ref) / (fabsf(ref) + scale); if (!(e == e)) e = 9.f; if (e > 9.f) e = 9.f;
    atomicMax(ctl + CW_DBG + k, __builtin_bit_cast(unsigned, e));
}
__device__ __forceinline__ unsigned dbg_hash(unsigned x) { x ^= x >> 16; x *= 0x7feb352du; x ^= x >> 15; x *= 0x846ca68bu; x ^= x >> 16; return x; }
__device__ __forceinline__ float dbg_bf(const bf16_t* p, size_t i) { return bf2f(p[i]); }
__device__ float dbg_block_sum(float v, float* sh) {
    __syncthreads(); sh[threadIdx.x] = v; __syncthreads();
    for (int o = 128; o > 0; o >>= 1) { if ((int)threadIdx.x < o) sh[threadIdx.x] += sh[threadIdx.x + o]; __syncthreads(); }
    const float r = sh[0]; __syncthreads(); return r;
}
__device__ int dbg_srcrow_latent(int smp) { const unsigned h = dbg_hash(smp * 7919u + 13u); const int b = h & 3; int s = (h >> 2) & 4095; if ((smp & 7) == 0) s = (s & ~127); if ((smp & 7) == 1) s |= 127; return b * 4096 + s; }
__device__ int dbg_srcrow_any(int smp) { if ((smp & 3) == 3) { const unsigned h = dbg_hash(smp * 31u + 5u); return TL + (h & 1023); } return dbg_srcrow_latent(smp); }
struct DbgArgs { const float* const* in; unsigned char* ws; float* out; int stage, l; };
__device__ int dbg_win_src(int c) {
    for (int n = (c & ~255); n < (c & ~255) + 256; ++n) if (rowmap<1>(n) == c) return n;
    return -1;
}
template <int stage> __global__ void __launch_bounds__(256) dbg_chk(Args a, int l) {
    __shared__ float sh[256]; __shared__ float shv[1024];
    unsigned char* ws = a.ws; unsigned* ctl = (unsigned*)(ws + WS_CTL);
    const int t = threadIdx.x, smp = blockIdx.x;
    const float* mod = (const float*)(ws + WS_MOD) + (size_t)l * 5 * 6144;
    const bf16_t* P = (const bf16_t*)(ws + WS_P); const bf16_t* H = (const bf16_t*)(ws + WS_H); const bf16_t* Y = (const bf16_t*)(ws + WS_Y);
    const float* dec = (const float*)(ws + WS_DEC);
    if (stage == 0) {
        const unsigned h = dbg_hash(smp + 77u); const int v = h % 5, n = (h >> 8) % 6144; float s = 0.f;
        for (int k = t; k < 1024; k += 256) { const float c = v < 4 ? a.in[I_C][v * 1024 + k] : a.in[I_CCTX][k]; s += (c / (1.f + expf(-c))) * a.in[I_WMOD][((size_t)l * 1024 + k) * 6144 + n]; }
        s = dbg_block_sum(s, sh) + a.in[I_BMOD][l * 6144 + n];
        if (t == 0) dbg_err(ctl, 0, mod[v * 6144 + n], s, 0.01f);
    } else if (stage == 1) {
        const int row = dbg_srcrow_any(smp); const float* x = row < TL ? a.in[I_X] + (size_t)row * D : a.in[I_CTX] + (size_t)(row - TL) * D; float ss = 0.f;
        for (int k = t; k < 1024; k += 256) ss += x[k] * x[k];
        ss = dbg_block_sum(ss, sh); const float rs = 1.f / sqrtf(ss / 1024.f + NORM_EPS); const int v = row_modv(row);
        for (int k = t; k < 1024; k += 256) { const float h = x[k] * rs * a.in[I_GMIX][l * 1024 + k] * (1.f + mod[v * 6144 + 1024 + k]) + mod[v * 6144 + k]; dbg_err(ctl, 1, dbg_bf(H, (size_t)row * D + k), h, 0.02f); }
    } else if (stage == 2) {
        const int row = dbg_srcrow_any(smp); const bool latent = row < TL; const int s = row & 4095;
        for (int k = t; k < 1024; k += 256) shv[k] = dbg_bf(H, (size_t)row * D + k);
        __syncthreads();
        for (int it = 0; it < 4; ++it) {
            const int c = (dbg_hash(smp * 1024u + it * 256u + t) % DIN) & ~1;
            float o0 = 0.f, o1 = 0.f;
            { const int n0 = dbg_win_src(c), n1 = dbg_win_src(c + 1); for (int k = 0; k < 1024; ++k) { o0 += shv[k] * a.in[I_WIN][((size_t)l * 1024 + k) * DIN + n0]; o1 += shv[k] * a.in[I_WIN][((size_t)l * 1024 + k) * DIN + n1]; } }
            int hd = 0; float scale = 1.f;
            if (c < C_RK) { hd = 128; scale = 0.08838834764831845f; } else if (c < C_RV) hd = 128; else if (c >= C_DQ && c < C_DK) { hd = 64; scale = 0.125f; } else if (c >= C_DK && c < C_DV) hd = 64;
            else if (c >= C_GQ && c < C_GKV) { hd = 64; scale = 0.125f; } else if (c >= C_GKV && c < C_GATE && ((c - C_GKV) & 127) < 64) hd = 64;
            if (hd && latent) { const int i = (hd == 128 ? (c & 127) : (c & 63)) >> 1, quarter = hd / 4; const int pos = i < quarter ? (s >> 6) : (s & 63), j = i < quarter ? i : i - quarter;
                const float ang = (float)pos * powf(10000.f, -(float)j / (float)quarter), cs = __cosf(ang), sn = __sinf(ang); const float x1 = o0, x2 = o1; o0 = x1 * cs - x2 * sn; o1 = x1 * sn + x2 * cs; }
            if (c >= C_RG && c < C_DQ) { o0 = o0 / (1.f + expf(-o0)); o1 = o1 / (1.f + expf(-o1)); }
            if (c >= C_GATE) { o0 = 1.f / (1.f + expf(-o0)); o1 = 1.f / (1.f + expf(-o1)); }
            o0 *= scale; o1 *= scale;
            { int cls = c < C_RK ? 0 : c < C_RV ? 1 : c < C_RG ? 2 : c < C_DQ ? 3 : c < C_DK ? 4 : c < C_DV ? 5 : c < C_GQ ? 6 : c < C_GKV ? 7 : c < C_GATE ? (((c - C_GKV) & 127) < 64 ? 8 : 9) : 10;
              const int slot = 20 + cls * 2 + (latent ? 0 : 1);
              const float esc = 0.5f * scale;
              dbg_err(ctl, slot, dbg_bf(P, (size_t)row * DIN + c), o0, esc); dbg_err(ctl, slot, dbg_bf(P, (size_t)row * DIN + c + 1), o1, esc); }
        }
    } else if (stage == 4) {
        const unsigned hsh = dbg_hash(smp + 999u); const int h = hsh & 3; const int row = dbg_srcrow_any(smp); const bool latent = row < TL; const int b = latent ? row >> 12 : (row - TL) >> 8; const int tq = latent ? (row & 4095) : ((row - TL) & 255);
        const float lgf = dec[l * 8 + h], lgb = dec[l * 8 + 4 + h];
        if (t < 128) shv[t] = dbg_bf(P, (size_t)row * DIN + C_RQ + h * 128 + t);
        __syncthreads();
        const int pfq = latent ? 256 + tq : tq, pbq = latent ? 256 + 4095 - tq : 255 - tq;
        float o = 0.f;
        for (int sidx = 0; sidx < 4352; ++sidx) { const bool sl = sidx >= 256; const int sp = sl ? sidx - 256 : sidx; const int srow = sl ? b * 4096 + sp : TL + b * 256 + sp;
            if (!latent && sl) continue;
            const int pfs = sl ? 256 + sp : sp, pbs = sl ? 256 + 4095 - sp : 255 - sp;
            float wgt = 0.f; if (pfs <= pfq) wgt += exp2f(lgf * (float)(pfq - pfs)); if (pbs <= pbq) wgt += exp2f(lgb * (float)(pbq - pbs));
            if (wgt == 0.f) continue;
            float dot = 0.f; for (int d = 0; d < 128; ++d) dot += shv[d] * dbg_bf(P, (size_t)srow * DIN + C_RK + h * 128 + d);
            o += wgt * dot * dbg_bf(P, (size_t)srow * DIN + C_RV + h * 256 + t); }
        const float mu = dbg_block_sum(o, sh) / 256.f; const float var = dbg_block_sum((o - mu) * (o - mu), sh) / 256.f;
        const float y = (o - mu) / sqrtf(var + NORM_EPS) * dbg_bf(P, (size_t)row * DIN + C_RG + h * 256 + t);
        dbg_err(ctl, 4, dbg_bf(Y, (size_t)row * 2048 + h * 256 + t), y, 0.3f);
    } else if (stage == 5) {
        const unsigned hsh = dbg_hash(smp + 555u); const int h = hsh & 3; const int row = dbg_srcrow_any(smp); const bool latent = row < TL; const int b = latent ? row >> 12 : (row - TL) >> 8;
        if (t < 128) shv[t] = dbg_bf(P, (size_t)row * DIN + C_DQ + h * 128 + t);
        __syncthreads();
        float m1 = -1e30f, m2 = -1e30f;
        const int s0 = latent ? 0 : 4096;
        for (int sidx = s0; sidx < 4352; ++sidx) { const int srow = sidx < 4096 ? b * 4096 + sidx : TL + b * 256 + sidx - 4096; float d1 = 0.f, d2 = 0.f;
            for (int d = 0; d < 64; ++d) { d1 += shv[d] * dbg_bf(P, (size_t)srow * DIN + C_DK + h * 128 + d); d2 += shv[64 + d] * dbg_bf(P, (size_t)srow * DIN + C_DK + h * 128 + 64 + d); }
            m1 = fmaxf(m1, d1); m2 = fmaxf(m2, d2); }
        float l1 = 0.f, l2 = 0.f, o1 = 0.f, o2 = 0.f;
        for (int sidx = s0; sidx < 4352; ++sidx) { const int srow = sidx < 4096 ? b * 4096 + sidx : TL + b * 256 + sidx - 4096; float d1 = 0.f, d2 = 0.f;
            for (int d = 0; d < 64; ++d) { d1 += shv[d] * dbg_bf(P, (size_t)srow * DIN + C_DK + h * 128 + d); d2 += shv[64 + d] * dbg_bf(P, (size_t)srow * DIN + C_DK + h * 128 + 64 + d); }
            const float p1 = expf(d1 - m1), p2 = expf(d2 - m2); l1 += p1; l2 += p2; const float v = t < 128 ? dbg_bf(P, (size_t)srow * DIN + C_DV + h * 128 + t) : 0.f; o1 += p1 * v; o2 += p2 * v; }
        const float lam = dec[32 + l], li = dec[40 + l]; const float o = t < 128 ? o1 / l1 - lam * o2 / l2 : 0.f;
        const float ms = dbg_block_sum(o * o, sh) / 128.f;
        if (t < 128) { const float y = o / sqrtf(ms + NORM_EPS) * a.in[I_SUBLN][l * 128 + t] * (1.f - li); dbg_err(ctl, 5, dbg_bf(Y, (size_t)row * 2048 + 1024 + h * 128 + t), y, 0.4f); }
    } else if (stage == 6) {
        const unsigned hsh = dbg_hash(smp + 333u); const int head = hsh & 7, kvh = head >> 2; const int row = dbg_srcrow_any(smp); const bool latent = row < TL; const int b = latent ? row >> 12 : (row - TL) >> 8; const int tq = row & 4095;
        if (t < 64) shv[t] = dbg_bf(P, (size_t)row * DIN + C_GQ + head * 64 + t);
        __syncthreads();
        const float sink = a.in[I_SINK][l * 8 + head];
        float m = sink;
        for (int pass = 0; pass < 2; ++pass) { float lsum = 0.f, o = 0.f;
            for (int sidx = 0; sidx < 4352; ++sidx) { const bool sl = sidx >= 256; const int sp = sl ? sidx - 256 : sidx; if (sl && (!latent || sp < tq - 128 || sp > tq + 128)) continue;
                const int srow = sl ? b * 4096 + sp : TL + b * 256 + sp; float d = 0.f;
                for (int k = 0; k < 64; ++k) d += shv[k] * dbg_bf(P, (size_t)srow * DIN + C_GKV + kvh * 128 + k);
                if (pass == 0) m = fmaxf(m, d); else { const float p = expf(d - m); lsum += p; o += p * (t < 64 ? dbg_bf(P, (size_t)srow * DIN + C_GKV + kvh * 128 + 64 + t) : 0.f); } }
            if (pass == 1 && t < 64) { lsum += expf(sink - m); dbg_err(ctl, 6, dbg_bf(Y, (size_t)row * 2048 + 1536 + head * 64 + t), o / lsum, 0.15f); } }
    } else if (stage == 7) {
        const int row = dbg_srcrow_any(smp);
        for (int it = 0; it < 4; ++it) { const int col = it * 256 + t; float r = 0.f;
            for (int seg = 0; seg < 3; ++seg) { const int k0 = seg == 0 ? 0 : (seg == 1 ? 1024 : 1536), k1 = seg == 0 ? 1024 : (seg == 1 ? 1536 : 2048); float acc = 0.f;
                for (int k = k0; k < k1; ++k) acc += dbg_bf(Y, (size_t)row * 2048 + k) * a.in[I_WBR][((size_t)l * 2048 + k) * D + col];
                r += acc * dbg_bf(P, (size_t)row * DIN + C_GATE + seg * 1024 + col); }
            dbg_err(ctl, 7, dbg_bf((const bf16_t*)(ws + WS_MGB), (size_t)row * D + col), r, 0.25f); }
    } else if (stage == 8) {
        const int row = dbg_srcrow_any(smp); const float* x = row < TL ? a.in[I_X] + (size_t)row * D : a.in[I_CTX] + (size_t)(row - TL) * D; const int v = row_modv(row);
        for (int it = 0; it < 4; ++it) { const int col = it * 256 + t; float acc = 0.f;
            for (int k = 0; k < 1024; ++k) acc += dbg_bf((const bf16_t*)(ws + WS_MGB), (size_t)row * D + k) * a.in[I_WOUT][((size_t)l * D + k) * D + col];
            dbg_err(ctl, 8, ((const float*)(ws + WS_XRES))[(size_t)row * D + col], x[col] + mod[v * 6144 + 2048 + col] * acc, 0.5f); }
    } else if (stage == 9) {
        const int row = dbg_srcrow_any(smp); const float* x = (const float*)(ws + WS_XRES) + (size_t)row * D; const int v = row_modv(row);
        __shared__ float hx[1024]; __shared__ float act[1024]; __shared__ float totsh[1024]; __shared__ float lg[32]; __shared__ int tix[4]; __shared__ float twt[4];
        float ss = 0.f; for (int k = t; k < 1024; k += 256) ss += x[k] * x[k];
        ss = dbg_block_sum(ss, sh); const float rs = 1.f / sqrtf(ss / 1024.f + NORM_EPS);
        for (int k = t; k < 1024; k += 256) hx[k] = x[k] * rs * a.in[I_GFFN][l * 1024 + k] * (1.f + mod[v * 6144 + 4096 + k]) + mod[v * 6144 + 3072 + k];
        __syncthreads();
        if (t < 32) { float s = a.in[I_BR][l * 32 + t]; for (int k = 0; k < 1024; ++k) s += hx[k] * a.in[I_WR][((size_t)l * D + k) * 32 + t]; lg[t] = s; }
        __syncthreads();
        if (t == 0) { for (int k = 0; k < 4; ++k) { int bi = 0; float bv = -1e30f; for (int e = 0; e < 32; ++e) if (lg[e] > bv) { bv = lg[e]; bi = e; } tix[k] = bi; twt[k] = bv; lg[bi] = -1e30f; }
            float sm = 0.f; const float t0 = twt[0]; for (int k = 0; k < 4; ++k) { twt[k] = expf(twt[k] - t0); sm += twt[k]; } for (int k = 0; k < 4; ++k) twt[k] /= sm; }
        __syncthreads();
        for (int c = t; c < 1024; c += 256) totsh[c] = 0.f;
        for (int k = 0; k < 4; ++k) { const int e = tix[k]; const float wk_ = twt[k]; const float* wgu = a.in[I_WGU] + ((size_t)l * 32 + e) * 1024 * 2048; const float* wdn = a.in[I_WDN] + ((size_t)l * 32 + e) * 1024 * 1024;
            for (int it = 0; it < 4; ++it) { const int j = it * 256 + t; float g = a.in[I_BGU][((size_t)l * 32 + e) * 2048 + j], li = a.in[I_BGU][((size_t)l * 32 + e) * 2048 + 1024 + j];
                for (int kk = 0; kk < 1024; ++kk) { g += hx[kk] * wgu[(size_t)kk * 2048 + j]; li += hx[kk] * wgu[(size_t)kk * 2048 + 1024 + j]; }
                g = fminf(g, 7.f); li = fminf(fmaxf(li, -7.f), 7.f); act[j] = g / (1.f + expf(-1.702f * g)) * (li + 1.f); }
            __syncthreads();
#pragma unroll
            for (int it = 0; it < 4; ++it) { const int c = it * 256 + t; float y = a.in[I_BDN][((size_t)l * 32 + e) * 1024 + c]; for (int kk = 0; kk < 1024; ++kk) y += act[kk] * wdn[(size_t)kk * 1024 + c]; totsh[c] += wk_ * y; }
            __syncthreads(); }
#pragma unroll
        for (int it = 0; it < 4; ++it) { const int c = it * 256 + t; float f = 0.f; for (int k = 0; k < 4; ++k) f += dbg_bf((const bf16_t*)(ws + WS_YK), ((size_t)row * 4 + k) * D + c); dbg_err(ctl, 9, f, totsh[c], 0.3f); }
    }
}
__global__ void dbg_prim(Args a) {
    unsigned* ctl = (unsigned*)(a.ws + WS_CTL); const int lane = threadIdx.x & 63; const float v = (float)(lane * lane + 1);
    float tot = 0.f; for (int i = 0; i < 64; ++i) tot += (float)(i * i + 1);
    dbg_err(ctl, 10, wave_sum(v), tot, 0.f);
    const float ov = (float)((lane ^ 32) * (lane ^ 32) + 1);
    dbg_err(ctl, 11, xsum(v), v + ov, 0.f); dbg_err(ctl, 12, xmax(v), fmaxf(v, ov), 0.f); dbg_err(ctl, 13, xother(v, lane >> 5), ov, 0.f);
}
__global__ void dbg_report(Args a, int nstage) {
    unsigned* ctl = (unsigned*)(a.ws + WS_CTL);
    int idx = nstage; float ev = 0.f;
    const int order[36] = {10, 11, 12, 13, 0, 1, 20, 21, 22, 23, 24, 25, 26, 27, 28, 29, 30, 31, 32, 33, 34, 35, 36, 37, 38, 39, 40, 41, 3, 4, 5, 6, 7, 8, 9, -1};
    idx = 35;
    for (int kk = 0; kk < 35; ++kk) { const float e = __builtin_bit_cast(float, ctl[CW_DBG + order[kk]]); if (e > 0.08f) { idx = kk; ev = e; break; } }
    const float X = 100.f * (float)(1 + idx);
    const float c = sqrtf(X);
    for (size_t i = (size_t)blockIdx.x * blockDim.x + threadIdx.x; i < (size_t)TL * D; i += (size_t)gridDim.x * blockDim.x) a.out[i] = c;
}
#endif

extern "C" void kernel_launch(void* const* d_in, const int* in_sizes, int n_in, void* d_out, int out_size, void* d_ws, size_t ws_size, hipStream_t stream) {
    static int grid = 0;
    if (grid == 0) {
        if (n_in != 26 || out_size != TL * D || ws_size < WS_END) { fprintf(stderr, "kernel_launch: unexpected shapes (n_in %d out %d ws %zu need %zu)\n", n_in, out_size, ws_size, (size_t)WS_END); grid = -1; return; }
        int dev = 0, cus = 0, per_cu = 0;
        if (hipGetDevice(&dev) != hipSuccess || hipDeviceGetAttribute(&cus, hipDeviceAttributeMultiprocessorCount, dev) != hipSuccess) { grid = -1; return; }
        if (hipFuncSetAttribute((const void*)mk_fwd, hipFuncAttributeMaxDynamicSharedMemorySize, LDS_BYTES) != hipSuccess) { fprintf(stderr, "kernel_launch: hipFuncSetAttribute failed\n"); grid = -1; return; }
        if (hipOccupancyMaxActiveBlocksPerMultiprocessor(&per_cu, (const void*)mk_fwd, NTHR, LDS_BYTES) != hipSuccess || per_cu < 1) { fprintf(stderr, "kernel_launch: occupancy query says %d\n", per_cu); (void)hipGetLastError(); per_cu = 1; }
        grid = cus;
    }
    if (grid < 0) return;
    (void)hipMemsetAsync((char*)d_ws + WS_CTL, 0, CTL_ZERO_BYTES, stream);
    Args a{};
    for (int i = 0; i < 26; ++i) a.in[i] = (const float*)d_in[i];
    a.out = (float*)d_out; a.ws = (unsigned char*)d_ws;
#if MK_MULTI
    for (int p = 0; p < NPH; ++p) { a.ph_lo = p; a.ph_hi = p + 1; hipLaunchKernelGGL(mk_fwd, dim3(grid), dim3(NTHR), LDS_BYTES, stream, a);
#ifdef DBG_CHECK
        const int L = DBG_CHECK - 1, pb = 1 + 9 * L;
        if (p == 0) hipLaunchKernelGGL(dbg_prim, dim3(1), dim3(64), 0, stream, a);
        if (p == 0) hipLaunchKernelGGL(dbg_chk<0>, dim3(64), dim3(256), 0, stream, a, L);
        if (p == pb + 0 && L == 0) hipLaunchKernelGGL(dbg_chk<1>, dim3(64), dim3(256), 0, stream, a, L);
        if (p == pb + 1) hipLaunchKernelGGL(dbg_chk<2>, dim3(256), dim3(256), 0, stream, a, L);
        if (p == pb + 3) { hipLaunchKernelGGL(dbg_chk<4>, dim3(48), dim3(256), 0, stream, a, L); hipLaunchKernelGGL(dbg_chk<5>, dim3(48), dim3(256), 0, stream, a, L); hipLaunchKernelGGL(dbg_chk<6>, dim3(48), dim3(256), 0, stream, a, L); }
        if (p == pb + 4) hipLaunchKernelGGL(dbg_chk<7>, dim3(32), dim3(256), 0, stream, a, L);
        if (p == pb + 5 && L == 0) hipLaunchKernelGGL(dbg_chk<8>, dim3(32), dim3(256), 0, stream, a, L);
        if (p == pb + 8) hipLaunchKernelGGL(dbg_chk<9>, dim3(24), dim3(256), 0, stream, a, L);
        if (p == NPH - 1) hipLaunchKernelGGL(dbg_report, dim3(256), dim3(256), 0, stream, a, 10);
#endif
    }
#else
    a.ph_lo = 0; a.ph_hi = NPH;
    hipLaunchKernelGGL(mk_fwd, dim3(grid), dim3(NTHR), LDS_BYTES, stream, a);
#endif
}
```

```cpp
#include <hip/hip_runtime.h>
#include <cstdio>
#include <cstdint>

#define LAS __attribute__((address_space(3)))
#define GAS __attribute__((address_space(1)))
typedef unsigned short bf16_t;
typedef short bf16x8 __attribute__((ext_vector_type(8)));
typedef short s16x4 __attribute__((ext_vector_type(4)));
typedef float f32x2 __attribute__((ext_vector_type(2)));
typedef float f32x4 __attribute__((ext_vector_type(4)));
typedef float f32x16 __attribute__((ext_vector_type(16)));
typedef unsigned u32x2 __attribute__((ext_vector_type(2)));
typedef unsigned u32x4 __attribute__((ext_vector_type(4)));
typedef int v4i32 __attribute__((ext_vector_type(4)));
typedef int v8i32 __attribute__((ext_vector_type(8)));

#ifndef WIN_FP8
#define WIN_FP8 1
#endif
#ifndef BR_FP8
#define BR_FP8 0
#endif
#ifndef DUP_MASK
#define DUP_MASK 0
#endif
#ifndef MK_MULTI
#define MK_MULTI 0
#endif

constexpr int D = 1024, NB = 4, SEQ = 4096, DEPTH = 4, CTXL = 256;
constexpr int TL = NB * SEQ, TC = NB * CTXL, TT = TL + TC;
constexpr int DIN = 8448;
constexpr int C_RQ = 0, C_RK = 512, C_RV = 1024, C_RG = 2048, C_DQ = 3072, C_DK = 3584, C_DV = 4096, C_GQ = 4608, C_GKV = 5120, C_GATE = 5376;
constexpr int NEXP = 32, TOPK = 4, NASG = TT * TOPK;
constexpr int SLOT_TILES = 304, NSLOT = SLOT_TILES * 256;
constexpr int NCHUNK = 34;
constexpr float NORM_EPS = 1e-6f;
constexpr float LOG2E = 1.4426950408889634f;

constexpr size_t al256(size_t x) { return (x + 255) & ~(size_t)255; }
constexpr size_t WS_CTL = 0, CTL_ZERO_BYTES = 1u << 20;
constexpr size_t WS_MOD = CTL_ZERO_BYTES;
constexpr size_t WS_ROPE128 = al256(WS_MOD + (size_t)DEPTH * 5 * 6144 * 4);
constexpr size_t WS_ROPE64 = al256(WS_ROPE128 + 64 * 32 * 8);
constexpr size_t WS_DEC = al256(WS_ROPE64 + 64 * 16 * 8);
constexpr size_t WS_XRES = al256(WS_DEC + 1024);
constexpr size_t WS_H = al256(WS_XRES + (size_t)TT * D * 4);
constexpr size_t WS_P = al256(WS_H + (size_t)TT * D * 2);
constexpr size_t WS_KDF = al256(WS_P + (size_t)TT * DIN * 2);
constexpr size_t WS_KDB = al256(WS_KDF + (size_t)TT * 512 * 2);
constexpr size_t WS_ST = al256(WS_KDB + (size_t)TT * 512 * 2);
constexpr size_t WS_Y = al256(WS_ST + (size_t)NB * 4 * 2 * NCHUNK * 256 * 128 * 2);
constexpr size_t WS_MG = al256(WS_Y + (size_t)TT * 2048 * 2);
constexpr size_t WS_MGB = al256(WS_MG + (size_t)TT * D * 4);
constexpr size_t WS_ACT = al256(WS_MGB + (size_t)TT * D * 2);
constexpr size_t WS_YK = al256(WS_ACT + (size_t)NSLOT * D * 2);
constexpr size_t WS_LIST = al256(WS_YK + (size_t)NASG * D * 2);
constexpr size_t WS_TW = al256(WS_LIST + (size_t)NEXP * TT * 4);
constexpr size_t WS_WIN = al256(WS_TW + (size_t)NASG * 4);
constexpr size_t WS_WBR = al256(WS_WIN + (size_t)DEPTH * DIN * D * 2);
constexpr size_t WS_WOUT = al256(WS_WBR + (size_t)DEPTH * D * 2048 * 2);
constexpr size_t WS_WGU = al256(WS_WOUT + (size_t)DEPTH * D * D * 2);
constexpr size_t WS_WDN = al256(WS_WGU + (size_t)DEPTH * NEXP * 2048 * D * 2);
constexpr size_t WS_WRT = al256(WS_WDN + (size_t)DEPTH * NEXP * D * D * 2);
constexpr size_t WS_END = al256(WS_WRT + (size_t)DEPTH * 2 * NEXP * D * 2);
constexpr int CW_BAR = 4096;
constexpr int CW_CNT = 8192;

constexpr int LDS_MAIN = 139264;
constexpr int LDS_MISC = LDS_MAIN;
constexpr int LDS_BYTES = LDS_MAIN + 256;
constexpr int NTHR = 512;

typedef __bf16 bf16x2_t __attribute__((ext_vector_type(2)));
__device__ __forceinline__ unsigned cvt_pk_bf16(float lo, float hi) { const f32x2 v = {lo, hi}; return __builtin_bit_cast(unsigned, __builtin_convertvector(v, bf16x2_t)); }
__device__ __forceinline__ unsigned pk_fp8x4(float a, float b, float c, float d) { unsigned w = 0u; w = __builtin_amdgcn_cvt_pk_fp8_f32(a, b, w, false); w = __builtin_amdgcn_cvt_pk_fp8_f32(c, d, w, true); return w; }
__device__ __forceinline__ float bf2f(unsigned short x) { return __builtin_bit_cast(float, (unsigned)x << 16); }
__device__ __forceinline__ float bflo(unsigned x) { return __builtin_bit_cast(float, x << 16); }
__device__ __forceinline__ float bfhi(unsigned x) { return __builtin_bit_cast(float, x & 0xffff0000u); }
__device__ __forceinline__ float fexp2(float x) { return __builtin_amdgcn_exp2f(x); }
__device__ __forceinline__ float frcp(float x) { return __builtin_amdgcn_rcpf(x); }
__device__ __forceinline__ float sigmoidf_(float x) { return frcp(1.f + fexp2(-x * LOG2E)); }
template <int CTRL> __device__ __forceinline__ float dpp_f(float v) { return __builtin_bit_cast(float, __builtin_amdgcn_update_dpp(0, __builtin_bit_cast(int, v), CTRL, 0xf, 0xf, false)); }
__device__ __forceinline__ f32x2 halves(float v) {
    unsigned va = __builtin_bit_cast(unsigned, v), vb = va;
    asm volatile("v_nop\n\tv_nop\n\tv_permlane32_swap_b32 %0, %1" : "+v"(va), "+v"(vb));
    return (f32x2){__builtin_bit_cast(float, va), __builtin_bit_cast(float, vb)}; }
__device__ __forceinline__ float xsum(float v) { const f32x2 h = halves(v); return h.x + h.y; }
__device__ __forceinline__ float xmax(float v) { const f32x2 h = halves(v); return fmaxf(h.x, h.y); }
__device__ __forceinline__ int lane_now() { int l; asm volatile("v_mbcnt_lo_u32_b32 %0, -1, 0\n\tv_mbcnt_hi_u32_b32 %0, -1, %0" : "=v"(l)); return l; }
__device__ __forceinline__ int tid_now(int wave) { return (wave << 6) | lane_now(); }
__device__ __forceinline__ int opaque_lane() { int l = lane_now(); asm volatile("" : "+v"(l)); return l; }
__device__ __forceinline__ float shx(float v, int mask, int lane) { return __builtin_bit_cast(float, __builtin_amdgcn_ds_bpermute((lane ^ mask) << 2, __builtin_bit_cast(int, v))); }
__device__ __forceinline__ float xother(float v, int) { return shx(v, 32, opaque_lane()); }
__device__ __forceinline__ float wave_sum(float v) {
    const int l = opaque_lane();
#pragma unroll
    for (int o = 1; o < 64; o <<= 1) v += shx(v, o, l);
    return v;
}
#define XB_TMO      128
#define XB_XCNT(j)  (256  + 64 * (j))
#define XB_XSUB(j)  (1280 + 64 * (j))
#define XB_XGEN(j)  (2304 + 64 * (j))
#define XB_TOP      3328
#define XB_TOPGEN   3392
#define XCD_BAR_WORDS 3456
#define XB_SPIN_CAP (1u << 27)
__device__ __forceinline__ unsigned xb_ld(unsigned* p)              { return __hip_atomic_load(p, __ATOMIC_RELAXED, __HIP_MEMORY_SCOPE_AGENT); }
__device__ __forceinline__ unsigned xb_add(unsigned* p, unsigned v) { return __hip_atomic_fetch_add(p, v, __ATOMIC_RELAXED, __HIP_MEMORY_SCOPE_AGENT); }
__device__ __forceinline__ unsigned xb_xcc_id() { return (unsigned)__builtin_amdgcn_s_getreg((3 << 11) | 20) & 0xFu; }
#define XB_SPIN(cond, bar) do { unsigned _sp = 0; while (cond) { __builtin_amdgcn_s_sleep(1); \
    if ((++_sp & 255u) == 0u) { if (xb_ld(&(bar)[XB_TMO])) break; if (_sp > XB_SPIN_CAP) { atomicAdd(&(bar)[XB_TMO], 1u); break; } } } } while (0)
extern __shared__ __attribute__((aligned(16))) unsigned char lds_dyn_base[];
struct XcdBarrier { unsigned* bar; unsigned x; int wv; };
#define XB_ST ((volatile LAS unsigned*)((LAS unsigned char*)lds_dyn_base + LDS_MISC))
__device__ __forceinline__ XcdBarrier xcd_barrier_post(unsigned* bar, volatile LAS unsigned* st) {
    XcdBarrier b; b.bar = bar; b.x = xb_xcc_id(); b.wv = 0; (void)st;
    if (threadIdx.x == 0) (void)xb_add(&bar[XB_XCNT(b.x)], 1u);
    return b;
}
__device__ __forceinline__ void xcd_barrier_complete(unsigned* bar, unsigned x, unsigned& nloc, unsigned& nx) {
    const unsigned G = gridDim.x * gridDim.y * gridDim.z;
    unsigned sum, cnt, mine, sp = 0u;
    for (;;) {
        sum = 0u; cnt = 0u; mine = 0u;
#pragma unroll
        for (unsigned j = 0; j < 16; ++j) { const unsigned c = xb_ld(&bar[XB_XCNT(j)]); sum += c; cnt += (c > 0u) ? 1u : 0u; mine = (j == x) ? c : mine; }
        if (sum == G) break;
        __builtin_amdgcn_s_sleep(1);
        if ((++sp & 255u) == 0u) { if (xb_ld(&bar[XB_TMO])) break; if (sp > XB_SPIN_CAP) { atomicAdd(&bar[XB_TMO], 1u); break; } }
    }
    nloc = mine > 0u ? mine : 1u; nx = cnt > 0u ? cnt : 1u;
}
__device__ __forceinline__ void xcd_barrier(const XcdBarrier& b) {
    asm volatile("s_waitcnt vmcnt(0)" ::: "memory");
    __syncthreads();
    if (b.wv == 0 && lane_now() == 0) {
        unsigned* bar = b.bar;
        __builtin_amdgcn_s_waitcnt(0);
        unsigned nloc = XB_ST[0], nx = XB_ST[1];
        if (nloc == 0u) { xcd_barrier_complete(bar, b.x, nloc, nx); XB_ST[0] = nloc; XB_ST[1] = nx; }
        const unsigned old = xb_add(&bar[XB_XSUB(b.x)], 1u);
        const unsigned gen = old / nloc;
        if (old + 1u == (gen + 1u) * nloc) {
            __builtin_amdgcn_fence(__ATOMIC_RELEASE, "agent");
            asm volatile("s_waitcnt vmcnt(0)" ::: "memory");
            const unsigned og = xb_add(&bar[XB_TOP], 1u);
            const unsigned tg = og / nx;
            if (og + 1u == (tg + 1u) * nx) xb_add(&bar[XB_TOPGEN], 1u);
            else XB_SPIN(xb_ld(&bar[XB_TOPGEN]) == tg, bar);
            __builtin_amdgcn_fence(__ATOMIC_ACQUIRE, "agent");
            xb_add(&bar[XB_XGEN(b.x)], 1u);
            asm volatile("s_waitcnt vmcnt(0)" ::: "memory");
        } else {
            XB_SPIN(xb_ld(&bar[XB_XGEN(b.x)]) == gen, bar);
            __builtin_amdgcn_fence(__ATOMIC_ACQUIRE, "agent");
            asm volatile("s_waitcnt vmcnt(0)" ::: "memory");
        }
    }
    __syncthreads();
}

template <class T> __device__ __forceinline__ T* pin(T* p_) { const unsigned long long v_ = (unsigned long long)p_;
    return (T*)(((unsigned long long)(unsigned)__builtin_amdgcn_readfirstlane((int)(unsigned)(v_ >> 32)) << 32) | (unsigned)__builtin_amdgcn_readfirstlane((int)(unsigned)v_)); }
namespace gm {
constexpr int BM = 256, BK = 64, HALF = 128, HTB = HALF * BK * 2, STAGE_BYTES = 8 * HTB;
__device__ __forceinline__ int lds_byte(int r, int c) { const int st = (r >> 4) * 2 + (c >> 5), rr = r & 15, cc = c & 31, ob = rr * 64 + cc * 2; return st * 1024 + (ob ^ (((ob >> 9) & 1) << 5)); }
__device__ __forceinline__ void stage_rc(int b, int& R, int& C) { const int st = b / 1024, sb = b % 1024, swz = sb ^ (((sb >> 9) & 1) << 5); R = (st >> 1) * 16 + swz / 64; C = (st & 1) * 32 + (swz % 64) / 2; }
__device__ __forceinline__ int perm32(int rho) { const int n = rho >> 4, i = rho & 15; return 8 * (i >> 2) + 4 * n + (i & 3); }

struct GU {
    unsigned A;
    unsigned B;
    int nt;
    int pm, pn, e0, e1;
};

template <class Epi, class Sched, bool GATHER, bool FP8 = false>
__device__ __forceinline__ void gemm_phase(LAS unsigned char* lds, const Sched& S, const Epi& E, const int lda, const int ldb, const int wv) {
    int tid_ = tid_now(wv); asm volatile("" : "+v"(tid_));
    const int tid = tid_, wid = __builtin_amdgcn_readfirstlane(tid >> 6), lane = tid & 63, wr = wid >> 2, wc = wid & 3, fr = lane & 15, fq = lane >> 4;
    int sR[2], sC[2];
    unsigned voffB[2], cvA[2][2], nvA[2][2];
#pragma unroll
    for (int i = 0; i < 2; ++i) { stage_rc(tid * 16 + i * 8192, sR[i], sC[i]); const int Rb = (sR[i] & ~31) + perm32(sR[i] & 31);
        voffB[i] = (unsigned)(Rb * ldb + sC[i] * 2); cvA[0][i] = (unsigned)(sR[i] * lda + sC[i] * 2); cvA[1][i] = cvA[0][i]; nvA[0][i] = cvA[0][i]; nvA[1][i] = cvA[0][i]; }
    const unsigned kstep = (unsigned)(BK * 2);
    const unsigned hstepB = (unsigned)(HALF * ldb), hstepA = GATHER ? 0u : (unsigned)(HALF * lda);
    const unsigned ldsw = (unsigned)wid * 1024u;
    const int aoff = lds_byte(wr * 64 + fr, fq * (FP8 ? 16 : 8)), boff = lds_byte(wc * 32 + fr, fq * (FP8 ? 16 : 8));
    auto rfl64 = [](const char* p_) { const unsigned long long v_ = (unsigned long long)p_; return (const char*)(((unsigned long long)(unsigned)__builtin_amdgcn_readfirstlane((int)(unsigned)(v_ >> 32)) << 32) | (unsigned)__builtin_amdgcn_readfirstlane((int)(unsigned)v_)); };
    const char* const baseA = rfl64(S.baseA()); const char* const baseB = rfl64(S.baseB());
    int nr_, fl_; asm volatile("s_mov_b32 %0, 0x7fffffff\n\ts_mov_b32 %1, 0x20000" : "=s"(nr_), "=s"(fl_));
    const __amdgpu_buffer_rsrc_t rsA = __builtin_amdgcn_make_buffer_rsrc((void*)baseA, 0, nr_, fl_), rsB = __builtin_amdgcn_make_buffer_rsrc((void*)baseB, 0, nr_, fl_);
#define G_SA(b, h) (((b) * 2 + (h)) * HTB)
#define G_SB(b, h) ((4 + (b) * 2 + (h)) * HTB)
#define G_STAGE2(bufoff, rs, so, o0, o1) do { \
        __builtin_amdgcn_raw_ptr_buffer_load_lds(rs, (LAS void*)(lds + (bufoff) + ldsw), 16, (int)(o0), (int)(so), 0, 0); \
        __builtin_amdgcn_raw_ptr_buffer_load_lds(rs, (LAS void*)(lds + (bufoff) + ldsw + 8192), 16, (int)(o1), (int)(so), 0, 0); } while (0)
#define G_STB(bufoff, so) G_STAGE2(bufoff, rsB, so, voffB[0], voffB[1])
#define G_STA(bufoff, so, h, o0, o1) G_STAGE2(bufoff, rsA, (so) + (h) * hstepA, o0, o1)
#define G_LD16(off_) (*(const LAS v4i32*)(lds + (off_)))
#define G_LDA(dst, b, h) do { if constexpr (FP8) { LAS unsigned char* pa_ = lds + G_SA(b, h) + aoff; asm volatile("" : "+v"(pa_));   \
            _Pragma("unroll") for (int m = 0; m < 4; ++m) dst##8[m] = __builtin_shufflevector(*(const LAS v4i32*)(pa_ + m * 2048), *(const LAS v4i32*)(pa_ + m * 2048 + 16), 0, 1, 2, 3, 4, 5, 6, 7); } \
        else { _Pragma("unroll") for (int m = 0; m < 4; ++m) _Pragma("unroll") for (int k = 0; k < 2; ++k) dst[m][k] = *(const LAS bf16x8*)(lds + G_SA(b, h) + aoff + m * 2048 + k * 1024); } } while (0)
#define G_LDB(dst, b, h) do { if constexpr (FP8) { LAS unsigned char* pb_ = lds + G_SB(b, h) + boff; asm volatile("" : "+v"(pb_)); \
            _Pragma("unroll") for (int n = 0; n < 2; ++n) dst##8[n] = __builtin_shufflevector(*(const LAS v4i32*)(pb_ + n * 2048), *(const LAS v4i32*)(pb_ + n * 2048 + 16), 0, 1, 2, 3, 4, 5, 6, 7); } \
        else { _Pragma("unroll") for (int n = 0; n < 2; ++n) _Pragma("unroll") for (int k = 0; k < 2; ++k) dst[n][k] = *(const LAS bf16x8*)(lds + G_SB(b, h) + boff + n * 2048 + k * 1024); } } while (0)
#define G_MMA(ai, bj, At, Bt) do { __builtin_amdgcn_s_setprio(1); \
        if constexpr (FP8) { _Pragma("unroll") for (int m = 0; m < 4; ++m) _Pragma("unroll") for (int n = 0; n < 2; ++n) \
            acc[ai][bj][m][n] = __builtin_amdgcn_mfma_scale_f32_16x16x128_f8f6f4(Bt##8[n], At##8[m], acc[ai][bj][m][n], 0, 0, 0, 0x7F7F7F7F, 0, 0x7F7F7F7F); } \
        else { _Pragma("unroll") for (int m = 0; m < 4; ++m) _Pragma("unroll") for (int n = 0; n < 2; ++n) _Pragma("unroll") for (int k = 0; k < 2; ++k) \
            acc[ai][bj][m][n] = __builtin_amdgcn_mfma_f32_16x16x32_bf16(Bt[n][k], At[m][k], acc[ai][bj][m][n], 0, 0, 0); } \
        __builtin_amdgcn_s_setprio(0); } while (0)
#define G_WAIT_V(n) asm volatile("s_waitcnt vmcnt(" #n ")" ::: "memory")
#define G_WAIT_L(n) asm volatile("s_waitcnt lgkmcnt(" #n ")" ::: "memory")
#define G_BAR __builtin_amdgcn_s_barrier()
#define G_SCHED __builtin_amdgcn_sched_barrier(0)
    GU cur, nxt; int ui = 0;
    if (!S.next(0, cur)) return;
    if constexpr (GATHER) { S.gather(cur, cvA); }
    S.a_ready(cur);
    f32x4 acc[2][2][4][2];
#pragma unroll
    for (int a = 0; a < 2; ++a)
#pragma unroll
        for (int b = 0; b < 2; ++b)
#pragma unroll
            for (int m = 0; m < 4; ++m)
#pragma unroll
                for (int n = 0; n < 2; ++n) acc[a][b][m][n] = (f32x4){0.f, 0.f, 0.f, 0.f};
    bf16x8 At[4][2], B0[2][2], B1[2][2];
    v8i32 At8[4], B08[2], B18[2];
    (void)At; (void)B0; (void)B1; (void)At8; (void)B08; (void)B18;
    unsigned cA = (unsigned)__builtin_amdgcn_readfirstlane((int)cur.A), cB = (unsigned)__builtin_amdgcn_readfirstlane((int)cur.B);
    G_STB(G_SB(0, 0), cB); G_STB(G_SB(0, 1), cB + hstepB); G_STA(G_SA(0, 0), cA, 0, cvA[0][0], cvA[0][1]); G_STA(G_SA(0, 1), cA, 1, cvA[1][0], cvA[1][1]);
    if (wr == 1) G_BAR;
    G_WAIT_V(2); G_BAR;
    G_STB(G_SB(1, 0), cB + kstep); G_STA(G_SA(1, 0), cA + kstep, 0, cvA[0][0], cvA[0][1]); G_STB(G_SB(1, 1), cB + hstepB + kstep);
    G_WAIT_V(6); G_BAR;
    for (;;) {
        const bool has_next = S.next(ui + 1, nxt);
        if (has_next) { if constexpr (GATHER) S.gather(nxt, nvA); }
        const unsigned nA = (unsigned)__builtin_amdgcn_readfirstlane((int)(has_next ? nxt.A : cA)), nB = (unsigned)__builtin_amdgcn_readfirstlane((int)(has_next ? nxt.B : cB));
        int nt = cur.nt; asm volatile("" : "+s"(nt));
#pragma unroll 1
        for (int t = 0; t < nt; t += 2) {
            const bool last = (t == nt - 2);
            const int km = ((DUP_MASK & 16384) && Epi::DUPK) ? (nt >> 1) - 1 : 0x7fff;
            const unsigned a1 = cA + (unsigned)((t + 1) & km) * kstep;
            const unsigned a2 = last ? nA : cA + (unsigned)((t + 2) & km) * kstep, b2 = last ? nB : cB + (unsigned)((t + 2) & km) * kstep;
            const unsigned a3 = a2 + kstep, b3 = b2 + kstep;
            unsigned x00, x01, x10, x11;
            if (last && has_next) S.a_ready(nxt);
            if (GATHER && last && has_next) { x00 = nvA[0][0]; x01 = nvA[0][1]; x10 = nvA[1][0]; x11 = nvA[1][1]; } else { x00 = cvA[0][0]; x01 = cvA[0][1]; x10 = cvA[1][0]; x11 = cvA[1][1]; }
            G_LDB(B0, 0, 0); G_LDB(B1, 0, 1); G_SCHED; G_LDA(At, 0, 0); G_STA(G_SA(1, 1), a1, 1, cvA[1][0], cvA[1][1]);
            G_WAIT_V(8); G_WAIT_L(0); G_BAR; G_MMA(0, 0, At, B0); G_MMA(0, 1, At, B1); G_BAR; G_SCHED;
            G_LDA(At, 0, 1); G_STB(G_SB(0, 0), b2); G_STB(G_SB(0, 1), b2 + hstepB); G_STA(G_SA(0, 0), a2, 0, x00, x01);
            G_WAIT_V(8); G_WAIT_L(0); G_BAR; G_MMA(1, 0, At, B0); G_MMA(1, 1, At, B1); G_BAR; G_SCHED;
            G_LDB(B0, 1, 0); G_LDB(B1, 1, 1); G_SCHED; G_LDA(At, 1, 0); G_STA(G_SA(0, 1), a2, 1, x10, x11);
            G_WAIT_V(8); G_WAIT_L(0); G_BAR; G_MMA(0, 0, At, B0); G_MMA(0, 1, At, B1); G_BAR; G_SCHED;
            G_LDA(At, 1, 1); G_STB(G_SB(1, 0), b3); G_STB(G_SB(1, 1), b3 + hstepB); G_STA(G_SA(1, 0), a3, 0, x00, x01);
            G_WAIT_V(8); G_WAIT_L(0); G_BAR; G_MMA(1, 0, At, B0); G_MMA(1, 1, At, B1); G_BAR; G_SCHED;
        }
        if (wr == 0) G_BAR;
        { int t2_ = lane_now(); asm volatile("" : "+v"(t2_)); const int fr_ = t2_ & 15, fq_ = (t2_ & 63) >> 4; E(acc, cur, wr, wc, fr_, fq_);
          if (Epi::DUPE) { asm volatile("" : "+v"(t2_)); const int fr2_ = t2_ & 15, fq2_ = (t2_ & 63) >> 4; E(acc, cur, wr, wc, fr2_, fq2_); } }
        S.done(cur);
        if (!has_next) break;
        if (!(Epi::CHAIN && cur.e1)) {
#pragma unroll
        for (int a = 0; a < 2; ++a)
#pragma unroll
            for (int b = 0; b < 2; ++b)
#pragma unroll
                for (int m = 0; m < 4; ++m)
#pragma unroll
                    for (int n = 0; n < 2; ++n) acc[a][b][m][n] = (f32x4){0.f, 0.f, 0.f, 0.f};
        }
        cur = nxt; cA = nA; cB = nB; ++ui;
        if constexpr (GATHER) {
#pragma unroll
            for (int h = 0; h < 2; ++h)
#pragma unroll
                for (int i = 0; i < 2; ++i) cvA[h][i] = nvA[h][i];
        }
        if (wr == 1) G_BAR;
    }
    G_WAIT_V(0);
    G_BAR;
#undef G_SA
#undef G_SB
#undef G_STAGE2
#undef G_STB
#undef G_STA
#undef G_LDA
#undef G_LDB
#undef G_MMA
#undef G_WAIT_V
#undef G_WAIT_L
#undef G_BAR
#undef G_SCHED
}
}

struct Frame {
    LAS unsigned char* lds;
    int tid, lane, wave, G, bid;
    unsigned char* ws;
    unsigned* ctl;
    const float* const* in;
    float* out;
};
enum { I_X = 0, I_C, I_CTX, I_CCTX, I_WMOD, I_BMOD, I_GMIX, I_GFFN, I_WIN, I_RDF, I_RDB, I_LQ1, I_LK1, I_LQ2, I_LK2, I_SUBLN, I_SINK, I_WBR, I_WOUT, I_WR, I_BR, I_WGU, I_BGU, I_WDN, I_BDN, I_GFIN };

__device__ __forceinline__ int row_modv(int row) { return row < TL ? (row >> 12) : 4; }
__device__ __forceinline__ const float* modp(const Frame& F, int l, int v, int part) { return (const float*)(F.ws + WS_MOD) + ((size_t)(l * 5 + v) * 6 + part) * 1024; }

__device__ __forceinline__ unsigned swz(unsigned r) { return ((r & 3u) << 2) | ((r >> 2) & 3u); }
__device__ __forceinline__ unsigned img_off(unsigned row, unsigned ch) { return 256u * row + 16u * (ch ^ swz(row)); }
__device__ __forceinline__ void dma4(LAS unsigned char* img, int idx, const char* g0, unsigned stride, int lane) {
    const unsigned q4 = (unsigned)lane >> 4, ch = (((unsigned)lane & 15u) ^ (q4 << 2)) ^ ((unsigned)idx & 3u);
    __builtin_amdgcn_global_load_lds((const unsigned*)(g0 + (q4 * stride + 16u * ch)), (LAS unsigned*)(img + 1024u * (unsigned)idx), 16, 0, 0);
}
#define DMA4(img, idx, ROWPTR) dma4((img), (idx), (const char*)(ROWPTR(4 * (idx))), DIN * 2, dl)
#define DMA4S(img, idx, ROWPTR, stride) dma4((img), (idx), (const char*)(ROWPTR(4 * (idx))), (stride), dl)
#define DMA_LANE() int dl = lane; asm volatile("" : "+v"(dl))
struct LA { unsigned rowb, trn, trp; };
__device__ __forceinline__ LA make_la(int lane) {
    const unsigned r32 = lane & 31, hh = (unsigned)lane >> 5, blk = ((unsigned)lane >> 4) & 1u, q = ((unsigned)lane & 15u) >> 2, p = (unsigned)lane & 3u;
    LA a; a.rowb = 256u * r32 + 16u * swz(r32);
    a.trn = 256u * (8u * hh + q) + 16u * ((2u * blk + (p >> 1)) ^ ((q << 2) | (2u * hh))) + 8u * (p & 1u);
    a.trp = 256u * (4u * hh + q) + 16u * ((2u * blk + (p >> 1)) ^ ((q << 2) | hh)) + 8u * (p & 1u);
    return a;
}
#define OPAQUE(x) asm volatile("" : "+v"(x))
__device__ __forceinline__ bf16x8 frag_row(LAS unsigned char* img, unsigned rowb, unsigned R0, unsigned ch) { return *(const LAS bf16x8*)(img + 256u * R0 + (rowb ^ (16u * ch))); }
__device__ __forceinline__ s16x4 tr4(LAS unsigned char* p) { return __builtin_bit_cast(s16x4, __builtin_amdgcn_ds_read_tr16_b64_v4i16((LAS s16x4*)p)); }
__device__ __forceinline__ bf16x8 frag_trn(LAS unsigned char* img, unsigned trn, unsigned R0, unsigned c, unsigned cb0) {
    const s16x4 lo = tr4(img + 256u * R0 + (trn ^ (16u * (cb0 + 4u * c)))), hi = tr4(img + 256u * (R0 + 4u) + (trn ^ (16u * ((cb0 + 4u * c) ^ 1u))));
    return (bf16x8){lo[0], lo[1], lo[2], lo[3], hi[0], hi[1], hi[2], hi[3]};
}
__device__ __forceinline__ bf16x8 frag_trp(LAS unsigned char* img, unsigned trp, unsigned R0, unsigned c, unsigned cb0) {
    const s16x4 lo = tr4(img + 256u * R0 + (trp ^ (16u * (cb0 + 4u * c)))), hi = tr4(img + 256u * (R0 + 8u) + (trp ^ (16u * ((cb0 + 4u * c) ^ 2u))));
    return (bf16x8){lo[0], lo[1], lo[2], lo[3], hi[0], hi[1], hi[2], hi[3]};
}
__device__ __forceinline__ bf16x8 pack8(const f32x16& v, int o) {
    u32x4 w; w.x = cvt_pk_bf16(v[o], v[o + 1]); w.y = cvt_pk_bf16(v[o + 2], v[o + 3]); w.z = cvt_pk_bf16(v[o + 4], v[o + 5]); w.w = cvt_pk_bf16(v[o + 6], v[o + 7]);
    return __builtin_bit_cast(bf16x8, w);
}
__device__ __forceinline__ int crow(int r, int hh) { return (r & 3) + 8 * (r >> 2) + 4 * hh; }
#define MFMA32(a, b, c) __builtin_amdgcn_mfma_f32_32x32x16_bf16((a), (b), (c), 0, 0, 0)
#define VMWAIT0() asm volatile("s_waitcnt vmcnt(0)" ::: "memory")

template <int MAP>
__device__ __forceinline__ int rowmap(int n) {
    if (MAP == 1) {
        if (n < 1024) { const int i = n & 127; return (n & ~127) + (i < 64 ? 2 * i : 2 * (i - 64) + 1); }
        if ((n >= C_DQ && n < C_DV) || (n >= C_GQ && n < C_GKV)) { const int i = n & 63; return (n & ~63) + (i < 32 ? 2 * i : 2 * (i - 32) + 1); }
        if (n >= C_GKV && n < C_GKV + 128) { const int kvh = (n - C_GKV) >> 6, i = n & 63; return C_GKV + kvh * 128 + (i < 32 ? 2 * i : 2 * (i - 32) + 1); }
        if (n >= C_GKV + 128 && n < C_GATE) { const int kvh = (n - C_GKV - 128) >> 6, i = n & 63; return C_GKV + kvh * 128 + 64 + i; }
        return n;
    }
    if (MAP == 2) return n < 1024 ? 2 * n : 2 * (n - 1024) + 1;
    return n;
}
template <int MAP, bool OUT8 = false>
__device__ __forceinline__ void transpose_item(const float* W, int K, int N, bf16_t* WT, LAS float* scr, int item, int lane) {
    const int nblk = N / 64, kb = item / nblk, nb = item % nblk, k0 = 64 * kb, n0 = 64 * nb;
    const int lr = lane >> 4, lc = (lane & 15) * 4;
    f32x4 v[16];
#pragma unroll
    for (int i = 0; i < 16; ++i) v[i] = *(const f32x4*)(W + (size_t)(k0 + 4 * i + lr) * N + n0 + lc);
#pragma unroll
    for (int i = 0; i < 16; ++i) *(LAS f32x4*)(scr + (4 * i + lr) * 64 + (lc ^ (8 * ((i >> 1) & 3)))) = v[i];
    asm volatile("s_waitcnt lgkmcnt(0)" ::: "memory");
    const int c = lane & 7;
#pragma unroll
    for (int j = 0; j < 8; ++j) { const int n = (lane >> 3) + 8 * j; const LAS float* s_ = scr + (8 * c) * 64 + (n ^ (8 * (c & 3)));
        if constexpr (OUT8) {
            *(u32x2*)((unsigned char*)WT + (size_t)rowmap<MAP>(n0 + n) * K + k0 + 8 * c) = (u32x2){pk_fp8x4(s_[0 * 64] * 32.f, s_[1 * 64] * 32.f, s_[2 * 64] * 32.f, s_[3 * 64] * 32.f), pk_fp8x4(s_[4 * 64] * 32.f, s_[5 * 64] * 32.f, s_[6 * 64] * 32.f, s_[7 * 64] * 32.f)};
        } else {
        u32x4 o; o.x = cvt_pk_bf16(s_[0 * 64], s_[1 * 64]); o.y = cvt_pk_bf16(s_[2 * 64], s_[3 * 64]); o.z = cvt_pk_bf16(s_[4 * 64], s_[5 * 64]); o.w = cvt_pk_bf16(s_[6 * 64], s_[7 * 64]);
        *(u32x4*)(WT + (size_t)rowmap<MAP>(n0 + n) * K + k0 + 8 * c) = o; } }
    asm volatile("s_waitcnt lgkmcnt(0)" ::: "memory");
}
constexpr int CV_IN = 16 * (DIN / 64), CV_BRN = 32 * 16, CV_OUT = 16 * 16, CV_GU = 16 * 32, CV_DN = 16 * 16;
constexpr int CV_PER_L = CV_IN + CV_BRN + CV_OUT + NEXP * (CV_GU + CV_DN);
constexpr int CW_R1 = 8192 + 1024;
constexpr int CW_Q = 8192 + 512;
constexpr int CW_LONG = CW_Q + 64;
__device__ __forceinline__ void conv_item(Frame& F, int l, int r, LAS float* scr) {
    if (r < CV_IN) { if (WIN_FP8) transpose_item<1, true>(F.in[I_WIN] + (size_t)l * D * DIN, D, DIN, (bf16_t*)(F.ws + WS_WIN + (size_t)l * DIN * D), scr, r, F.lane);
        else transpose_item<1>(F.in[I_WIN] + (size_t)l * D * DIN, D, DIN, (bf16_t*)(F.ws + WS_WIN) + (size_t)l * DIN * D, scr, r, F.lane); return; } r -= CV_IN;
    if (r < CV_BRN) { if (BR_FP8) transpose_item<0, true>(F.in[I_WBR] + (size_t)l * 2048 * D, 2048, D, (bf16_t*)(F.ws + WS_WBR + (size_t)l * D * 2048), scr, r, F.lane);
        else transpose_item<0>(F.in[I_WBR] + (size_t)l * 2048 * D, 2048, D, (bf16_t*)(F.ws + WS_WBR) + (size_t)l * D * 2048, scr, r, F.lane); return; } r -= CV_BRN;
    if (r < CV_OUT) { if (BR_FP8) transpose_item<0, true>(F.in[I_WOUT] + (size_t)l * D * D, D, D, (bf16_t*)(F.ws + WS_WOUT + (size_t)l * D * D), scr, r, F.lane);
        else transpose_item<0>(F.in[I_WOUT] + (size_t)l * D * D, D, D, (bf16_t*)(F.ws + WS_WOUT) + (size_t)l * D * D, scr, r, F.lane); return; } r -= CV_OUT;
    const int e = r / (CV_GU + CV_DN); r %= (CV_GU + CV_DN);
    if (r < CV_GU) transpose_item<2, true>(F.in[I_WGU] + ((size_t)l * NEXP + e) * D * 2048, D, 2048, (bf16_t*)(F.ws + WS_WGU + ((size_t)l * NEXP + e) * 2048 * D), scr, r, F.lane);
    else transpose_item<0, true>(F.in[I_WDN] + ((size_t)l * NEXP + e) * D * D, D, D, (bf16_t*)(F.ws + WS_WDN + ((size_t)l * NEXP + e) * D * D), scr, r - CV_GU, F.lane);
}
__device__ __forceinline__ bool conv_chunk(Frame& F, int l, const unsigned* stop, unsigned stop_at) {
    volatile LAS int* slot = (volatile LAS int*)(F.lds + LDS_MISC + 64);
    __syncthreads();
    if (F.tid == 0) { int base = -1;
        if (!(stop && __hip_atomic_load(stop, __ATOMIC_RELAXED, __HIP_MEMORY_SCOPE_AGENT) >= stop_at)) { base = (int)__hip_atomic_fetch_add(F.ctl + CW_Q + l, 8u, __ATOMIC_RELAXED, __HIP_MEMORY_SCOPE_AGENT); if (base >= CV_PER_L) base = -1; }
        *slot = base; }
    __syncthreads();
    const int base = *slot;
    if (base < 0) return false;
    if (base + F.wave < CV_PER_L) conv_item(F, l, base + F.wave, (LAS float*)(F.lds + F.wave * 16384));
    return true;
}
__device__ __forceinline__ void p0_prologue(Frame& F) {
    const int gw = F.bid * 8 + F.wave, NGW = F.G * 8;
    {
        LAS float* sc = (LAS float*)F.lds;
        LAS float* red = sc + 5 * 1024;
        for (int i = F.tid; i < 5 * 1024; i += NTHR) { const int v = i >> 10, k = i & 1023; const float c = v < 4 ? F.in[I_C][v * 1024 + k] : F.in[I_CCTX][k]; sc[i] = c * sigmoidf_(c); }
        __syncthreads();
        for (int u = F.bid; u < DEPTH * 96; u += F.G) {
            const int l = u / 96, n0 = (u % 96) * 64;
            const float* W = F.in[I_WMOD] + (size_t)l * 1024 * 6144 + n0 + F.lane;
            float a0 = 0.f, a1 = 0.f, a2 = 0.f, a3 = 0.f, a4 = 0.f;
            const int kb = F.wave * 128;
#pragma unroll 8
            for (int k = 0; k < 128; ++k) { const float w = W[(size_t)(kb + k) * 6144];
                a0 += w * sc[kb + k]; a1 += w * sc[1024 + kb + k]; a2 += w * sc[2048 + kb + k]; a3 += w * sc[3072 + kb + k]; a4 += w * sc[4096 + kb + k]; }
            red[(F.wave * 5 + 0) * 64 + F.lane] = a0; red[(F.wave * 5 + 1) * 64 + F.lane] = a1; red[(F.wave * 5 + 2) * 64 + F.lane] = a2;
            red[(F.wave * 5 + 3) * 64 + F.lane] = a3; red[(F.wave * 5 + 4) * 64 + F.lane] = a4;
            __syncthreads();
            if (F.tid < 320) { const int v = F.tid >> 6, c = F.tid & 63; float s = F.in[I_BMOD][l * 6144 + n0 + c];
#pragma unroll
                for (int w = 0; w < 8; ++w) s += red[(w * 5 + v) * 64 + c];
                ((float*)(F.ws + WS_MOD))[(size_t)(l * 5 + v) * 6144 + n0 + c] = s; }
            __syncthreads();
        }
    }
    if (F.bid == 0) {
        for (int i = F.tid; i < 64 * 32; i += NTHR) { const int pos = i >> 5, j = i & 31; const float inv = powf(10000.f, -(float)j / 32.f), a = (float)pos * inv;
            ((f32x2*)(F.ws + WS_ROPE128))[i] = (f32x2){cosf(a), sinf(a)}; }
        for (int i = F.tid; i < 64 * 16; i += NTHR) { const int pos = i >> 4, j = i & 15; const float inv = powf(10000.f, -(float)j / 16.f), a = (float)pos * inv;
            ((f32x2*)(F.ws + WS_ROPE64))[i] = (f32x2){cosf(a), sinf(a)}; }
        if (F.tid < DEPTH * 8) { const int l = F.tid >> 3, dir = (F.tid >> 2) & 1, h = F.tid & 3; const float x = (dir ? F.in[I_RDB] : F.in[I_RDF])[l * 4 + h];
            const float ls = -log1pf(expf(-x));
            ((float*)(F.ws + WS_DEC))[F.tid] = ls * LOG2E; }
        if (F.tid >= 64 && F.tid < 64 + DEPTH) { const int l = F.tid - 64; float s1 = 0.f, s2 = 0.f;
            for (int i = 0; i < 64; ++i) { s1 += F.in[I_LQ1][l * 64 + i] * F.in[I_LK1][l * 64 + i]; s2 += F.in[I_LQ2][l * 64 + i] * F.in[I_LK2][l * 64 + i]; }
            const float lam_init = 0.8f - 0.6f * expf(-0.3f * (float)l);
            ((float*)(F.ws + WS_DEC))[32 + l] = expf(s1) - expf(s2) + lam_init; ((float*)(F.ws + WS_DEC))[40 + l] = lam_init; }
    }
    for (int i = F.bid * NTHR + F.tid; i < DEPTH * NEXP * D; i += F.G * NTHR) { const int l = i / (NEXP * D), e = (i / D) % NEXP, k = i % D;
        const float w = F.in[I_WR][((size_t)l * D + k) * NEXP + e]; const unsigned hi = cvt_pk_bf16(w, 0.f) & 0xffffu; const float lo = w - bf2f((unsigned short)hi);
        bf16_t* o = (bf16_t*)(F.ws + WS_WRT) + (size_t)l * 2 * NEXP * D; o[(size_t)e * D + k] = (bf16_t)hi; o[(size_t)(NEXP + e) * D + k] = (bf16_t)(cvt_pk_bf16(lo, 0.f) & 0xffffu); }
    __syncthreads();
    while (conv_chunk(F, 0, nullptr, 0u)) { }
}
struct Row16 { f32x4 v[4]; };
__device__ __forceinline__ Row16 ld_row_f32(const float* p, int lane) { Row16 r; const f32x4* q = (const f32x4*)p + lane;
#pragma unroll
    for (int j = 0; j < 4; ++j) r.v[j] = q[64 * j];
    return r; }
__device__ __forceinline__ void st_row_f32(float* p, int lane, const Row16& r) { f32x4* q = (f32x4*)p + lane;
#pragma unroll
    for (int j = 0; j < 4; ++j) q[64 * j] = r.v[j]; }
__device__ __forceinline__ void st_row_bf16(bf16_t* p, int lane, const Row16& r) { u32x2* q = (u32x2*)p + lane;
#pragma unroll
    for (int j = 0; j < 4; ++j) q[64 * j] = (u32x2){cvt_pk_bf16(r.v[j].x, r.v[j].y), cvt_pk_bf16(r.v[j].z, r.v[j].w)}; }
__device__ __forceinline__ float row_rstd(const Row16& r) { float s = 0.f;
#pragma unroll
    for (int j = 0; j < 4; ++j) s += (r.v[j].x * r.v[j].x + r.v[j].y * r.v[j].y) + (r.v[j].z * r.v[j].z + r.v[j].w * r.v[j].w);
    return 1.f / sqrtf(wave_sum(s) * (1.f / D) + NORM_EPS); }
__device__ __forceinline__ Row16 x_row_combined(const Frame& F, int l, int row) {
    if (l == 0) return ld_row_f32(row < TL ? F.in[I_X] + (size_t)row * D : F.in[I_CTX] + (size_t)(row - TL) * D, F.lane);
    Row16 x = ld_row_f32((const float*)(F.ws + WS_XRES) + (size_t)row * D, F.lane);
    const Row16 ga = ld_row_f32(modp(F, l - 1, row_modv(row), 5), F.lane);
    const u32x2* yk = (const u32x2*)(F.ws + WS_YK) + (size_t)row * 4 * (D / 4) + F.lane;
#pragma unroll
    for (int j = 0; j < 4; ++j) { f32x4 s = (f32x4){0.f, 0.f, 0.f, 0.f};
#pragma unroll
        for (int k = 0; k < 4; ++k) { const u32x2 w = yk[(size_t)k * (D / 4) + 64 * j]; s += (f32x4){bflo(w.x), bfhi(w.x), bflo(w.y), bfhi(w.y)}; }
        x.v[j] += ga.v[j] * s; }
    return x;
}
__device__ __forceinline__ void p_norm1(Frame& F, int l, bool dry = false) {
    const int gw = F.bid * 8 + F.wave, NGW = F.G * 8;
    const Row16 g = ld_row_f32(F.in[I_GMIX] + (size_t)l * D, F.lane);
    for (int row = gw; row < TT; row += NGW) {
        const Row16 x = x_row_combined(F, l, row);
        if (!dry) st_row_f32((float*)(F.ws + WS_XRES) + (size_t)row * D, F.lane, x);
        const float rs = row_rstd(x); const int v = row_modv(row);
        const Row16 sh = ld_row_f32(modp(F, l, v, 0), F.lane), sc = ld_row_f32(modp(F, l, v, 1), F.lane);
        Row16 h;
#pragma unroll
        for (int j = 0; j < 4; ++j) h.v[j] = x.v[j] * rs * g.v[j] * (sc.v[j] + 1.f) + sh.v[j];
        if (!WIN_FP8) st_row_bf16((bf16_t*)(F.ws + WS_H) + (size_t)row * D, F.lane, h);
        else { unsigned* h8 = (unsigned*)(F.ws + WS_H + (size_t)row * D) + F.lane;
#pragma unroll
          for (int j = 0; j < 4; ++j) h8[64 * j] = pk_fp8x4(h.v[j].x * 8.f, h.v[j].y * 8.f, h.v[j].z * 8.f, h.v[j].w * 8.f); }
    }
}
__device__ __forceinline__ void p_final(Frame& F) {
    const int gw = F.bid * 8 + F.wave, NGW = F.G * 8;
    const Row16 g = ld_row_f32(F.in[I_GFIN], F.lane);
    for (int row = gw; row < TL; row += NGW) {
        const Row16 x = x_row_combined(F, DEPTH, row);
        const float rs = row_rstd(x); Row16 o;
#pragma unroll
        for (int j = 0; j < 4; ++j) o.v[j] = x.v[j] * rs * g.v[j];
        st_row_f32(F.out + (size_t)row * D, F.lane, o);
    }
}

struct OrderMN {
    int nM, nN, nwg, G, c;
    __device__ __forceinline__ void init(int nM_, int nN_, int G_, int c_) { nM = nM_; nN = nN_; nwg = nM * nN; G = G_; c = c_; }
    __device__ __forceinline__ bool tile(int i, int& pm, int& pn) const {
        const long L = (long)i * G + c; if (L >= nwg) return false;
        int wgid = (int)L; { const int q = nwg / 8, r = nwg % 8, xcd = wgid % 8, off = wgid / 8; wgid = (xcd < r ? xcd * (q + 1) : r * (q + 1) + (xcd - r) * q) + off; }
        const int nig = 8 * nN, gid = wgid / nig, fm = gid * 8, gsz = (nM - fm) < 8 ? (nM - fm) : 8;
        pm = fm + ((wgid % nig) % gsz); pn = (wgid % nig) / gsz; return true;
    }
};
struct SchedPlain {
    __device__ __forceinline__ void a_ready(const gm::GU&) const {}
    __device__ __forceinline__ void done(const gm::GU&) const {}
    OrderMN o; const char* A; const char* B; int lda, ldb, nt; int dupk = 0;
    __device__ __forceinline__ const char* baseA() const { return A; }
    __device__ __forceinline__ const char* baseB() const { return B; }
    __device__ __forceinline__ bool next(int i, gm::GU& u) const { int pm, pn; const int j = i; if (!o.tile(j, pm, pn)) return false;
        u.A = (unsigned)(pm * 256 * lda); u.B = (unsigned)(pn * 256 * ldb); u.nt = dupk ? 2 * nt : nt; u.pm = pm; u.pn = pn; u.e0 = 0; u.e1 = 0; return true; }
};
struct EpiIn {
    static constexpr bool CHAIN = false; static constexpr bool DUPK = true; static constexpr bool DUPE = (DUP_MASK & 32768) != 0;
    bf16_t* P; const f32x4* rope128; const f32x4* rope64; float pre = 1.f;
    template <int MODE, int BJ>
    __device__ __forceinline__ void rows(const f32x4 (&acc)[2][2][4][2], const gm::GU& u, int wr, int fr, int ct, int cl, float scale) const {
        int j0 = 0, usecol = 0;
        if (MODE == 1) { const int i0 = cl >> 1; usecol = i0 >= 32; j0 = i0 & 31; } else if (MODE == 2) { const int i0 = (cl & 63) >> 1; usecol = i0 >= 16; j0 = i0 & 15; }
        f32x4 frq = {0.f, 0.f, 0.f, 0.f};
        if (MODE == 1 || MODE == 2) { const float lstep = (MODE == 1 ? -13.287712379549449f / 32.f : -13.287712379549449f / 16.f);
#pragma unroll
            for (int q = 0; q < 4; ++q) frq[q] = fexp2(lstep * (float)(j0 + q)) * 0.15915494309189535f; }
        const float sc = (WIN_FP8 ? scale * (1.f / 256.f) : scale) * pre;
#pragma unroll
        for (int ai = 0; ai < 2; ++ai)
#pragma unroll
            for (int m = 0; m < 4; ++m) {
                const int row = u.pm * 256 + ai * 128 + wr * 64 + m * 16 + fr;
                f32x4 v0 = acc[ai][BJ][m][0] * sc, v1 = acc[ai][BJ][m][1] * sc;
                if (MODE == 1 || MODE == 2) {
                    const int s = row & 4095; const float pos = (float)(usecol ? (s & 63) : (s >> 6));
                    f32x4 cs, sn;
#pragma unroll
                    for (int q = 0; q < 4; ++q) { const float rev = pos * frq[q]; cs[q] = __builtin_amdgcn_cosf(rev); sn[q] = __builtin_amdgcn_sinf(rev); }
                    f32x4 r0, r1;
                    r0.x = v0.x * cs[0] - v0.y * sn[0]; r0.y = v0.x * sn[0] + v0.y * cs[0]; r0.z = v0.z * cs[1] - v0.w * sn[1]; r0.w = v0.z * sn[1] + v0.w * cs[1];
                    r1.x = v1.x * cs[2] - v1.y * sn[2]; r1.y = v1.x * sn[2] + v1.y * cs[2]; r1.z = v1.z * cs[3] - v1.w * sn[3]; r1.w = v1.z * sn[3] + v1.w * cs[3];
                    v0 = r0; v1 = r1;
                }
                if (MODE == 3) {
#pragma unroll
                    for (int q = 0; q < 4; ++q) { v0[q] = v0[q] * sigmoidf_(v0[q]); v1[q] = v1[q] * sigmoidf_(v1[q]); }
                } else if (MODE == 4) {
#pragma unroll
                    for (int q = 0; q < 4; ++q) { v0[q] = sigmoidf_(v0[q]); v1[q] = sigmoidf_(v1[q]); }
                }
                u32x4 w; w.x = cvt_pk_bf16(v0[0], v0[1]); w.y = cvt_pk_bf16(v0[2], v0[3]); w.z = cvt_pk_bf16(v1[0], v1[1]); w.w = cvt_pk_bf16(v1[2], v1[3]);
                *(u32x4*)(P + (size_t)row * DIN + ct + cl) = w;
            }
    }
    template <int BJ>
    __device__ __forceinline__ void half(const f32x4 (&acc)[2][2][4][2], const gm::GU& u, int wr, int wc, int fr, int fq) const {
        const bool latent = u.pm < (TL / 256);
        const int ct = u.pn * 256 + BJ * 128;
        const int cl = wc * 32 + fq * 8;
        int mode = 0; float scale = 1.f;
        if (ct < C_RK) { mode = 1; scale = 0.08838834764831845f; }
        else if (ct < C_RV) mode = 1;
        else if (ct < C_RG) mode = 0;
        else if (ct < C_DQ) mode = 3;
        else if (ct < C_DK) { mode = 2; scale = 0.125f * LOG2E; }
        else if (ct < C_DV) mode = 2;
        else if (ct < C_GQ) mode = 0;
        else if (ct < C_GKV) { mode = 2; scale = 0.125f * LOG2E; }
        else if (ct < C_GATE) mode = (wc < 2) ? 2 : 0;
        else mode = 4;
        if (!latent && (mode == 1 || mode == 2)) mode = 0;
        switch (mode) {
            case 0: rows<0, BJ>(acc, u, wr, fr, ct, cl, scale); break;
            case 1: rows<1, BJ>(acc, u, wr, fr, ct, cl, scale); break;
            case 2: rows<2, BJ>(acc, u, wr, fr, ct, cl, scale); break;
            case 3: rows<3, BJ>(acc, u, wr, fr, ct, cl, scale); break;
            default: rows<4, BJ>(acc, u, wr, fr, ct, cl, scale); break;
        }
    }
    __device__ __forceinline__ void operator()(const f32x4 (&acc)[2][2][4][2], const gm::GU& u, int wr, int wc, int fr, int fq) const {
        half<0>(acc, u, wr, wc, fr, fq); half<1>(acc, u, wr, wc, fr, fq);
    }
};
struct SchedBranch {
    __device__ __forceinline__ void a_ready(const gm::GU&) const {}
    __device__ __forceinline__ void done(const gm::GU&) const {}
    OrderMN o; const char* Y; const char* W;
    __device__ __forceinline__ const char* baseA() const { return Y; }
    __device__ __forceinline__ const char* baseB() const { return W; }
    __device__ __forceinline__ bool next(int i, gm::GU& u) const { int pm, pn; const int ti = i / 3, seg = i - 3 * ti; if (!o.tile(ti, pm, pn)) return false;
        const int koff = seg == 0 ? 0 : (seg == 1 ? 1024 : 1536), eb = BR_FP8 ? 1 : 2;
        u.A = (unsigned)(pm * 256 * 2048 * eb + koff * eb); u.B = (unsigned)(pn * 256 * 2048 * eb + koff * eb); u.nt = (seg == 0 ? 16 : 8) / (BR_FP8 ? 2 : 1); u.pm = pm; u.pn = pn; u.e0 = seg; u.e1 = seg < 2; return true; }
};
constexpr int CW_PB = 32768;
struct SchedBranchX {
    int c, ctx; const char* Y; const char* W; unsigned* cnt; int wv;
    __device__ __forceinline__ const char* baseA() const { return Y; }
    __device__ __forceinline__ const char* baseB() const { return W; }
    __device__ __forceinline__ bool next(int i, gm::GU& u) const { const int ti = i / 3, seg = i - 3 * ti, x = c & 7, r = c >> 3; int pm, pn;
        if (ti == 0) { pm = x + 8 * (r >> 2); pn = r & 3; } else if (ti == 1 && ctx && x < 4 && r < 4) { pm = 64 + x; pn = r; } else return false;
        const int koff = seg == 0 ? 0 : (seg == 1 ? 1024 : 1536);
        u.A = (unsigned)(pm * 256 * 4096 + koff * 2); u.B = (unsigned)(pn * 256 * 4096 + koff * 2); u.nt = seg == 0 ? 16 : 8; u.pm = pm; u.pn = pn; u.e0 = seg; u.e1 = seg < 2; return true; }
    __device__ __forceinline__ void a_ready(const gm::GU&) const {}
    __device__ __forceinline__ void done(const gm::GU& u) const {
        if (u.e0 != 2) return;
        asm volatile("s_waitcnt vmcnt(0)" ::: "memory");
        __builtin_amdgcn_s_barrier();
        if (wv == 0 && lane_now() == 0) { __builtin_amdgcn_fence(__ATOMIC_RELEASE, "agent"); asm volatile("s_waitcnt vmcnt(0)" ::: "memory");
            __hip_atomic_fetch_add(cnt + 16 * u.pm, 1u, __ATOMIC_RELAXED, __HIP_MEMORY_SCOPE_AGENT); }
    }
};
struct SchedOutX {
    int c, ctx; const char* A; const char* B; const unsigned* cnt; int wv;
    __device__ __forceinline__ const char* baseA() const { return A; }
    __device__ __forceinline__ const char* baseB() const { return B; }
    __device__ __forceinline__ bool next(int i, gm::GU& u) const { const int x = c & 7, r = c >> 3; const bool lng = ctx && x < 4 && r < 4; int pm, pn;
        if (i == 0) { if (lng) { pm = 64 + x; pn = r; } else { pm = x + 8 * (r >> 2); pn = r & 3; } }
        else if (i == 1 && ctx && x < 4 && r >= 4 && r < 8) { pm = x; pn = r - 4; }
        else return false;
        u.A = (unsigned)(pm * 256 * 2048); u.B = (unsigned)(pn * 256 * 2048); u.nt = 16; u.pm = pm; u.pn = pn; u.e0 = 0; u.e1 = 0; return true; }
    __device__ __forceinline__ void a_ready(const gm::GU& u) const {
        if (wv == 0) { const unsigned* w_ = cnt + 16 * u.pm; unsigned sp_ = 0;
            while ((unsigned)__builtin_amdgcn_readfirstlane((int)__hip_atomic_load(w_, __ATOMIC_RELAXED, __HIP_MEMORY_SCOPE_AGENT)) < 4u) { __builtin_amdgcn_s_sleep(2); if (++sp_ > (1u << 22)) break; }
            __builtin_amdgcn_fence(__ATOMIC_ACQUIRE, "agent"); asm volatile("s_waitcnt vmcnt(0)" ::: "memory"); }
        asm volatile("" ::: "memory"); __builtin_amdgcn_s_barrier(); asm volatile("" ::: "memory");
    }
    __device__ __forceinline__ void done(const gm::GU&) const {}
};
struct EpiBranch {
    static constexpr bool DUPK = false; static constexpr bool DUPE = false;
    static constexpr bool CHAIN = true;
    const bf16_t* P; bf16_t* MGB;
    __device__ __forceinline__ void operator()(f32x4 (&acc)[2][2][4][2], const gm::GU& u, int wr, int wc, int fr, int fq) const {
        const bool last = u.e0 == 2;
        const bf16_t* gbase = P + C_GATE + u.e0 * 1024 + u.pn * 256 + wc * 32 + fq * 8;
        const int nxt = last ? 0 : 1024;
#pragma unroll
        for (int ai = 0; ai < 2; ++ai)
#pragma unroll
            for (int m = 0; m < 4; ++m) {
                const int row = u.pm * 256 + ai * 128 + wr * 64 + m * 16 + fr;
                const bf16_t* gp = gbase + (size_t)row * DIN;
                u32x4 ga[2], gb[2];
#pragma unroll
                for (int bj = 0; bj < 2; ++bj) { ga[bj] = *(const u32x4*)(gp + bj * 128); gb[bj] = *(const u32x4*)(gp + nxt + bj * 128); }
                __builtin_amdgcn_sched_barrier(0);
#pragma unroll
                for (int bj = 0; bj < 2; ++bj) {
                    const int col = u.pn * 256 + bj * 128 + wc * 32 + fq * 8;
                    const u32x4 g = ga[bj], h = gb[bj];
                    f32x4 f0 = (f32x4){bflo(g.x), bfhi(g.x), bflo(g.y), bfhi(g.y)}, f1 = (f32x4){bflo(g.z), bfhi(g.z), bflo(g.w), bfhi(g.w)};
                    const f32x4 d0 = (f32x4){bflo(h.x), bfhi(h.x), bflo(h.y), bfhi(h.y)}, d1 = (f32x4){bflo(h.z), bfhi(h.z), bflo(h.w), bfhi(h.w)};
#pragma unroll
                    for (int q = 0; q < 4; ++q) { f0[q] *= frcp(last ? 1.f : fmaxf(d0[q], 1e-20f)); f1[q] *= frcp(last ? 1.f : fmaxf(d1[q], 1e-20f)); }
                    const f32x4 v0 = acc[ai][bj][m][0] * f0, v1 = acc[ai][bj][m][1] * f1;
                    acc[ai][bj][m][0] = v0; acc[ai][bj][m][1] = v1;
                    if (last) { u32x4 w; w.x = cvt_pk_bf16(v0[0], v0[1]); w.y = cvt_pk_bf16(v0[2], v0[3]); w.z = cvt_pk_bf16(v1[0], v1[1]); w.w = cvt_pk_bf16(v1[2], v1[3]);
                        *(u32x4*)(MGB + (size_t)row * D + col) = w; }
                }
                __builtin_amdgcn_sched_barrier(0);
            }
    }
};
struct EpiOut {
    static constexpr bool DUPK = false; static constexpr bool DUPE = false;
    static constexpr bool CHAIN = false;
    float* X; const float* mod; float* XO;
    __device__ __forceinline__ void operator()(const f32x4 (&acc)[2][2][4][2], const gm::GU& u, int wr, int wc, int fr, int fq) const {
        const int v = u.pm < (TL / 256) ? (u.pm >> 4) : 4;
#pragma unroll
        for (int bj = 0; bj < 2; ++bj) {
            const int col = u.pn * 256 + bj * 128 + wc * 32 + fq * 8;
            const f32x4 g0 = *(const f32x4*)(mod + (size_t)v * 6144 + 2048 + col), g1 = *(const f32x4*)(mod + (size_t)v * 6144 + 2048 + col + 4);
#pragma unroll
            for (int ai = 0; ai < 2; ++ai) {
                f32x4 x0[4], x1[4];
#pragma unroll
                for (int m = 0; m < 4; ++m) { const float* x = X + (size_t)(u.pm * 256 + ai * 128 + wr * 64 + m * 16 + fr) * D + col; x0[m] = *(const f32x4*)x; x1[m] = *(const f32x4*)(x + 4); }
                __builtin_amdgcn_sched_barrier(0);
#pragma unroll
                for (int m = 0; m < 4; ++m) {
                    float* xo = XO + (size_t)(u.pm * 256 + ai * 128 + wr * 64 + m * 16 + fr) * D + col;
                    constexpr float SCO = BR_FP8 ? 1.f / 256.f : 1.f;
                    *(f32x4*)xo = x0[m] + g0 * (acc[ai][bj][m][0] * SCO);
                    *(f32x4*)(xo + 4) = x1[m] + g1 * (acc[ai][bj][m][1] * SCO);
                }
                __builtin_amdgcn_sched_barrier(0);
            }
        }
    }
};
struct SchedGU {
    __device__ __forceinline__ void a_ready(const gm::GU&) const {}
    __device__ __forceinline__ void done(const gm::GU&) const {}
    int G, c; const LAS int* pref; const int* cnt; const int* list; const char* H; const char* W; int wv;
    __device__ __forceinline__ const char* baseA() const { return H; }
    __device__ __forceinline__ const char* baseB() const { return W; }
    __device__ __forceinline__ bool next(int i, gm::GU& u) const {
        const int ntile = __builtin_amdgcn_readfirstlane(pref[NEXP]); int ti, pn;
        if ((G & 7) == 0) {
            const int x = c & 7, j = c >> 3, t0 = x * ntile / 8, t1 = (x + 1) * ntile / 8, m = j + (G >> 3) * i; if (m >= (t1 - t0) * 8) return false; ti = t0 + (m >> 3); pn = m & 7;
        } else { const long L = (long)i * G + c; if (L >= (long)ntile * 8) return false; ti = (int)(L >> 3); pn = (int)(L & 7); }
        const int rec = __builtin_amdgcn_readfirstlane(pref[64 + ti]); const int e = rec & 255, valid = (rec >> 8) & 4095, mt = rec >> 20;
        u.A = 0u; u.B = (unsigned)((e * 2048 + pn * 256) * 1024); u.nt = 8; u.pm = ti; u.pn = pn; u.e0 = e | (mt << 8); u.e1 = valid; return true;
    }
    __device__ __forceinline__ void gather(const gm::GU& u, unsigned (&o)[2][2]) const {
        const int e = u.e0 & 255, mt = u.e0 >> 8;
        int tid = tid_now(wv); asm volatile("" : "+v"(tid));
#pragma unroll
        for (int i = 0; i < 2; ++i) { int R, C; gm::stage_rc(tid * 16 + i * 8192, R, C);
#pragma unroll
            for (int h = 0; h < 2; ++h) { const int r = h * 128 + R; const int idx = mt * 256 + (r < u.e1 ? r : 0); const int a = list[(size_t)e * TT + idx];
                o[h][i] = (unsigned)(a >> 2) * 1024u + (unsigned)C * 2u; } }
    }
};
struct EpiGU {
    static constexpr bool DUPK = false; static constexpr bool DUPE = (DUP_MASK & 65536) != 0;
    static constexpr bool CHAIN = false;
    bf16_t* ACT; const float* bgu;
    __device__ __forceinline__ void operator()(const f32x4 (&acc)[2][2][4][2], const gm::GU& u, int wr, int wc, int fr, int fq) const {
        const int e = u.e0 & 255;
#pragma unroll
        for (int bj = 0; bj < 2; ++bj) {
            const int j0 = u.pn * 128 + bj * 64 + wc * 16 + fq * 4;
            const f32x4 bg = *(const f32x4*)(bgu + (size_t)e * 2048 + j0), bl = *(const f32x4*)(bgu + (size_t)e * 2048 + 1024 + j0);
#pragma unroll
            for (int ai = 0; ai < 2; ++ai)
#pragma unroll
                for (int m = 0; m < 4; ++m) {
                    const int r = ai * 128 + wr * 64 + m * 16 + fr;
                    const f32x4 v0 = acc[ai][bj][m][0], v1 = acc[ai][bj][m][1];
                    constexpr float SC = 1.f / 256.f;
                    float gl[4] = {v0[0] * SC + bg[0], v0[2] * SC + bg[1], v1[0] * SC + bg[2], v1[2] * SC + bg[3]};
                    float li[4] = {v0[1] * SC + bl[0], v0[3] * SC + bl[1], v1[1] * SC + bl[2], v1[3] * SC + bl[3]};
                    float o[4];
#pragma unroll
                    for (int q = 0; q < 4; ++q) { const float g = fminf(gl[q], 7.f), ln = fminf(fmaxf(li[q], -7.f), 7.f); o[q] = g * sigmoidf_(1.702f * g) * (ln + 1.f); }
                    *(unsigned*)((unsigned char*)ACT + ((size_t)u.pm * 256 + r) * D + j0) = pk_fp8x4(o[0] * 4.f, o[1] * 4.f, o[2] * 4.f, o[3] * 4.f);
                }
        }
    }
};
struct SchedDN {
    __device__ __forceinline__ void a_ready(const gm::GU&) const {}
    __device__ __forceinline__ void done(const gm::GU&) const {}
    int G, c; const LAS int* pref; const int* cnt; const char* ACT; const char* W;
    __device__ __forceinline__ const char* baseA() const { return ACT; }
    __device__ __forceinline__ const char* baseB() const { return W; }
    __device__ __forceinline__ bool next(int i, gm::GU& u) const {
        const int ntile = __builtin_amdgcn_readfirstlane(pref[NEXP]); int ti, pn;
        if ((G & 7) == 0) { const int x = c & 7, j = c >> 3, t0 = x * ntile / 8, t1 = (x + 1) * ntile / 8, m = j + (G >> 3) * i; if (m >= (t1 - t0) * 4) return false; ti = t0 + (m >> 2); pn = m & 3; }
        else { const long L = (long)i * G + c; if (L >= (long)ntile * 4) return false; ti = (int)(L >> 2); pn = (int)(L & 3); }
        const int rec = __builtin_amdgcn_readfirstlane(pref[64 + ti]); const int e = rec & 255, valid = (rec >> 8) & 4095, mt = rec >> 20;
        u.A = (unsigned)(ti * 256 * 1024); u.B = (unsigned)((e * 1024 + pn * 256) * 1024); u.nt = 8; u.pm = ti; u.pn = pn; u.e0 = e | (mt << 8); u.e1 = valid; return true;
    }
};
struct EpiDN {
    static constexpr bool DUPK = false; static constexpr bool DUPE = (DUP_MASK & 131072) != 0;
    static constexpr bool CHAIN = false;
    bf16_t* YK; const float* bdn; const int* list; const float* tw;
    __device__ __forceinline__ void operator()(const f32x4 (&acc)[2][2][4][2], const gm::GU& u, int wr, int wc, int fr, int fq) const {
        const int e = u.e0 & 255, mt = u.e0 >> 8;
        int aid[8]; float wgt[8];
#pragma unroll
        for (int k = 0; k < 8; ++k) { const int r = (k >> 2) * 128 + wr * 64 + (k & 3) * 16 + fr; aid[k] = list[(size_t)e * TT + mt * 256 + (r < u.e1 ? r : 0)]; }
#pragma unroll
        for (int k = 0; k < 8; ++k) wgt[k] = tw[aid[k]];
#pragma unroll
        for (int bj = 0; bj < 2; ++bj) {
            const int col = u.pn * 256 + bj * 128 + wc * 32 + fq * 8;
            const f32x4 b0 = *(const f32x4*)(bdn + (size_t)e * 1024 + col), b1 = *(const f32x4*)(bdn + (size_t)e * 1024 + col + 4);
#pragma unroll
            for (int ai = 0; ai < 2; ++ai)
#pragma unroll
                for (int m = 0; m < 4; ++m) {
                    const int r = ai * 128 + wr * 64 + m * 16 + fr; const int k = ai * 4 + m;
                    if (r < u.e1) {
                        const float w = wgt[k];
                        const f32x4 v0 = (acc[ai][bj][m][0] * (1.f / 128.f) + b0) * w, v1 = (acc[ai][bj][m][1] * (1.f / 128.f) + b1) * w;
                        u32x4 o; o.x = cvt_pk_bf16(v0[0], v0[1]); o.y = cvt_pk_bf16(v0[2], v0[3]); o.z = cvt_pk_bf16(v1[0], v1[1]); o.w = cvt_pk_bf16(v1[2], v1[3]);
                        *(u32x4*)(YK + (size_t)aid[k] * D + col) = o;
                    }
                }
        }
    }
};

struct SmState { float m, l; };
constexpr float SM_DEFER = 8.f;
__device__ __forceinline__ float max3f(float a, float b, float c) { float r; asm("v_max3_f32 %0, %1, %2, %3" : "=v"(r) : "v"(a), "v"(b), "v"(c)); return r; }
template <int NC>
__device__ __forceinline__ void softmax_tile(f32x16& s0, f32x16& s1, SmState& st, f32x16 (&O)[NC], bf16x8 (&pf)[4]) {
    float ma, mb;
    asm volatile("s_nop 15\n\ts_nop 3\n\tv_max3_f32 %0, %2, %3, %4\n\tv_max3_f32 %1, %5, %6, %7" : "=&v"(ma), "=&v"(mb) : "v"(s0[0]), "v"(s0[1]), "v"(s1[0]), "v"(s0[2]), "v"(s0[3]), "v"(s1[1]));
    ma = max3f(ma, s1[2], s1[3]);
#pragma unroll
    for (int r = 4; r < 16; r += 4) { ma = max3f(ma, s0[r], s0[r + 1]); mb = max3f(mb, s0[r + 2], s0[r + 3]); ma = max3f(ma, s1[r], s1[r + 1]); mb = max3f(mb, s1[r + 2], s1[r + 3]); }
    const float mx = xmax(max3f(ma, mb, mb));
    if (!__all(mx <= st.m)) {
        const float mn = max3f(st.m, mx, mx); const float alpha = fexp2(st.m - mn);
        st.m = mn; st.l *= alpha;
#pragma unroll
        for (int c = 0; c < NC; ++c) O[c] = O[c] * alpha;
    }
    const float mn = st.m;
    s0 = s0 - mn; s1 = s1 - mn;
#pragma unroll
    for (int r = 0; r < 16; ++r) { s0[r] = fexp2(s0[r]); s1[r] = fexp2(s1[r]); }
    const f32x16 ssum = s0 + s1;
    float sum = 0.f;
#pragma unroll
    for (int r = 0; r < 16; ++r) sum += ssum[r];
    st.l += sum;
    pf[0] = pack8(s0, 0); pf[1] = pack8(s0, 8); pf[2] = pack8(s1, 0); pf[3] = pack8(s1, 8);
}
template <int NC>
__device__ __forceinline__ void softmax_pre(f32x16& s0, f32x16& s1, f32x16& p0, f32x16& p1, bool shift_p, SmState& st, f32x16& negm, f32x16 (&O)[NC], bf16x8 (&pf)[4], bool first) {
    float ma, mb;
    asm volatile("s_nop 15\n\ts_nop 3\n\tv_max3_f32 %0, %2, %3, %4\n\tv_max3_f32 %1, %5, %6, %7" : "=&v"(ma), "=&v"(mb) : "v"(s0[0]), "v"(s0[1]), "v"(s1[0]), "v"(s0[2]), "v"(s0[3]), "v"(s1[1]));
    ma = max3f(ma, s1[2], s1[3]);
#pragma unroll
    for (int r = 4; r < 16; r += 4) { ma = max3f(ma, s0[r], s0[r + 1]); mb = max3f(mb, s0[r + 2], s0[r + 3]); ma = max3f(ma, s1[r], s1[r + 1]); mb = max3f(mb, s1[r + 2], s1[r + 3]); }
    const float mx = xmax(max3f(ma, mb, mb));
    if (first || !__all(mx <= 0.f)) {
        const float d = first ? mx : fmaxf(mx, 0.f); const float alpha = first ? 1.f : fexp2(-d);
        st.m += d; st.l *= alpha;
#pragma unroll
        for (int c = 0; c < NC; ++c) O[c] = O[c] * alpha;
        s0 = s0 - d; s1 = s1 - d;
        if (shift_p) { p0 = p0 - d; p1 = p1 - d; }
        const float nm = -st.m;
#pragma unroll
        for (int r = 0; r < 16; ++r) negm[r] = nm;
    }
#pragma unroll
    for (int r = 0; r < 16; ++r) { s0[r] = fexp2(s0[r]); s1[r] = fexp2(s1[r]); }
    const f32x16 ssum = s0 + s1;
    float sum = 0.f;
#pragma unroll
    for (int r = 0; r < 16; ++r) sum += ssum[r];
    st.l += sum;
    pf[0] = pack8(s0, 0); pf[1] = pack8(s0, 8); pf[2] = pack8(s1, 0); pf[3] = pack8(s1, 8);
}
template <int NC>
__device__ __forceinline__ void softmax_head(f32x16& s0, f32x16& s1, SmState& st, f32x16 (&O)[NC]) {
    float ma, mb;
    asm volatile("s_nop 15\n\ts_nop 3\n\tv_max3_f32 %0, %2, %3, %4\n\tv_max3_f32 %1, %5, %6, %7" : "=&v"(ma), "=&v"(mb) : "v"(s0[0]), "v"(s0[1]), "v"(s1[0]), "v"(s0[2]), "v"(s0[3]), "v"(s1[1]));
    ma = max3f(ma, s1[2], s1[3]);
#pragma unroll
    for (int r = 4; r < 16; r += 4) { ma = max3f(ma, s0[r], s0[r + 1]); mb = max3f(mb, s0[r + 2], s0[r + 3]); ma = max3f(ma, s1[r], s1[r + 1]); mb = max3f(mb, s1[r + 2], s1[r + 3]); }
    const float mx = xmax(max3f(ma, mb, mb));
    if (!__all(mx <= st.m + SM_DEFER)) {
        const float mn = max3f(st.m, mx, mx); const float alpha = fexp2(st.m - mn);
        st.m = mn; st.l *= alpha;
#pragma unroll
        for (int c = 0; c < NC; ++c) O[c] = O[c] * alpha;
    }
    const float mn = st.m;
    s0 = s0 - mn; s1 = s1 - mn;
}
template <int NC>
__device__ __forceinline__ void sm_max2(f32x16& a0, f32x16& a1, f32x16& b0, f32x16& b1, SmState& st, f32x16& negm, f32x16 (&O)[NC], bool first) {
    float ma, mb;
    asm volatile("s_nop 15\n\ts_nop 3\n\tv_max3_f32 %0, %2, %3, %4\n\tv_max3_f32 %1, %5, %6, %7" : "=&v"(ma), "=&v"(mb) : "v"(a0[0]), "v"(a0[1]), "v"(a1[0]), "v"(a0[2]), "v"(a0[3]), "v"(a1[1]));
    ma = max3f(ma, a1[2], a1[3]);
#pragma unroll
    for (int r = 4; r < 16; r += 4) { ma = max3f(ma, a0[r], a0[r + 1]); mb = max3f(mb, a0[r + 2], a0[r + 3]); ma = max3f(ma, a1[r], a1[r + 1]); mb = max3f(mb, a1[r + 2], a1[r + 3]); }
#pragma unroll
    for (int r = 0; r < 16; r += 4) { ma = max3f(ma, b0[r], b0[r + 1]); mb = max3f(mb, b0[r + 2], b0[r + 3]); ma = max3f(ma, b1[r], b1[r + 1]); mb = max3f(mb, b1[r + 2], b1[r + 3]); }
    const float mx = xmax(max3f(ma, mb, mb));
    if (first || !__all(mx <= SM_DEFER)) {
        const float d = first ? mx : fmaxf(mx, 0.f); const float alpha = first ? 1.f : fexp2(-d);
        st.m += d; st.l *= alpha;
#pragma unroll
        for (int c = 0; c < NC; ++c) O[c] = O[c] * alpha;
        a0 = a0 - d; a1 = a1 - d; b0 = b0 - d; b1 = b1 - d;
        const float nm = -st.m;
#pragma unroll
        for (int r = 0; r < 16; ++r) negm[r] = nm;
    }
}
__device__ __forceinline__ void sm_exp_q(f32x16& s, SmState& st, bf16x8& p0, bf16x8& p1) {
#pragma unroll
    for (int r = 0; r < 16; ++r) s[r] = fexp2(s[r]);
    float su0 = s[0] + s[1], su1 = s[2] + s[3];
#pragma unroll
    for (int r = 4; r < 16; r += 4) { su0 += s[r] + s[r + 1]; su1 += s[r + 2] + s[r + 3]; }
    st.l += su0 + su1;
    p0 = pack8(s, 0); p1 = pack8(s, 8);
}
__device__ __forceinline__ void sm_exp(f32x16& s0, f32x16& s1, SmState& st, bf16x8 (&pf)[4]) {
#pragma unroll
    for (int r = 0; r < 16; ++r) { s0[r] = fexp2(s0[r]); s1[r] = fexp2(s1[r]); }
    const f32x16 ssum = s0 + s1;
    float sum = 0.f;
#pragma unroll
    for (int r = 0; r < 16; ++r) sum += ssum[r];
    st.l += sum;
    pf[0] = pack8(s0, 0); pf[1] = pack8(s0, 8); pf[2] = pack8(s1, 0); pf[3] = pack8(s1, 8);
}
#define ZERO16(x) do { _Pragma("unroll") for (int _r = 0; _r < 16; ++_r) (x)[_r] = 0.f; } while (0)

__device__ __forceinline__ void diff_unit(Frame& F, int l, int b, int h, int ctxq, int qblk) {
    const bf16_t* P = (const bf16_t*)(F.ws + WS_P);
#define DKimg(x) (F.lds + 65536 * (x))
#define DVimg(x) (F.lds + 32768 + 65536 * (x))
    int lane_ = lane_now(); asm volatile("" : "+v"(lane_)); const int lane = lane_, w = F.wave, r32 = lane & 31, hh = lane >> 5;
    LA la = make_la(lane); la.rowb ^= 16u * hh;
    const int sm = w >> 2;
    const int qrow0 = ctxq ? TL + b * 256 + qblk * 128 : b * 4096 + qblk * 128;
    const int kt0 = ctxq ? 32 : 0, nkt = ctxq ? 2 : 34;
    const char* kbase = (const char*)(P + C_DK + h * 128); const char* vbase = (const char*)(P + C_DV + h * 128);
#define DIFF_KROW(kt, i) ((kt) < 32 ? (size_t)(b * 4096 + (kt) * 128 + (i)) : (size_t)(TL + b * 256 + ((kt) - 32) * 128 + (i)))
#define DIFF_KP(r_) (kbase + DIFF_KROW(ktn, (r_)) * (DIN * 2))
#define DIFF_VP(r_) (vbase + DIFF_KROW(ktn, (r_)) * (DIN * 2))
    bf16x8 qf[4];
    { const bf16_t* qp = P + (size_t)(qrow0 + 32 * (w & 3) + r32) * DIN + C_DQ + h * 128 + 64 * sm + 8 * hh;
#pragma unroll
      for (int ks = 0; ks < 4; ++ks) qf[ks] = *(const bf16x8*)(qp + 16 * ks); }
    f32x16 O[4];
#pragma unroll
    for (int c = 0; c < 4; ++c) ZERO16(O[c]);
    SmState st = {0.f, 0.f};
    f32x16 negm; ZERO16(negm);
    __syncthreads();
    { DMA_LANE(); const int ktn = kt0;
#pragma unroll
      for (int i = 0; i < 4; ++i) { DMA4(DKimg(0), 4 * w + i, DIFF_KP); DMA4(DVimg(0), 4 * w + i, DIFF_VP); } }
    VMWAIT0(); __syncthreads();
    for (int t = 0; t < nkt; ++t) {
        const int cur = t & 1;
        LAS unsigned char* Kc = DKimg(cur); LAS unsigned char* Vc = DVimg(cur);
        OPAQUE(la.rowb); OPAQUE(la.trp);
#define SB() __builtin_amdgcn_sched_barrier(0)
        bf16x8 kfa[8], kfb[8], pfa[4], pfb[4], vf[2][4];
        f32x16 a0, a1, b0, b1;
#define LOAD_K(dst, R0_) do { _Pragma("unroll") for (int ks = 0; ks < 4; ++ks) { dst[ks] = frag_row(Kc, la.rowb, (R0_), 8 * sm + 2 * ks); dst[4 + ks] = frag_row(Kc, la.rowb, (R0_) + 32, 8 * sm + 2 * ks); } } while (0)
#define QK(kf_, s0_, s1_) do { s0_ = MFMA32(kf_[0], qf[0], negm); s1_ = MFMA32(kf_[4], qf[0], negm); _Pragma("unroll") for (int ks = 1; ks < 4; ++ks) { s0_ = MFMA32(kf_[ks], qf[ks], s0_); s1_ = MFMA32(kf_[4 + ks], qf[ks], s1_); } } while (0)
#define LOAD_V(slot_, R0_) do { _Pragma("unroll") for (int c = 0; c < 4; ++c) vf[slot_][c] = frag_trp(Vc, la.trp, (R0_), c, 0); } while (0)
#define PV(pf_, R0_) do { _Pragma("unroll") for (int kq = 0; kq < 4; ++kq) { \
            _Pragma("unroll") for (int c = 0; c < 4; ++c) { O[c] = MFMA32(vf[kq & 1][c], pf_[kq], O[c]); if (DUP_MASK & 262144) O[c] = MFMA32(vf[kq & 1][c], pf_[kq], O[c]); } \
            SB(); if (kq + 2 < 4) { LOAD_V(kq & 1, (R0_) + 16 * (kq + 2)); SB(); } } } while (0)
        LOAD_K(kfa, 0); LOAD_K(kfb, 64); SB();
        QK(kfa, a0, a1); QK(kfb, b0, b1); SB();
        LOAD_V(0, 0); LOAD_V(1, 16); SB();
        sm_max2<4>(a0, a1, b0, b1, st, negm, O, t == 0); SB();
        sm_exp(a0, a1, st, pfa); SB();
        if (t + 1 < nkt) { DMA_LANE(); const int ktn = kt0 + t + 1;
#pragma unroll
            for (int i = 0; i < 4; ++i) { DMA4(DKimg(cur ^ 1), 4 * w + i, DIFF_KP); DMA4(DVimg(cur ^ 1), 4 * w + i, DIFF_VP); } }
        SB();
#pragma unroll
        for (int kq = 0; kq < 4; ++kq) {
#pragma unroll
            for (int c = 0; c < 4; ++c) O[c] = MFMA32(vf[kq & 1][c], pfa[kq], O[c]);
            if (kq + 2 < 4) LOAD_V(kq & 1, 16 * (kq + 2)); }
        sm_exp(b0, b1, st, pfb);
#pragma unroll
        for (int i_ = 0; i_ < 16; ++i_) { __builtin_amdgcn_sched_group_barrier(0x008, 1, 0); __builtin_amdgcn_sched_group_barrier(0x002, 5, 0); __builtin_amdgcn_sched_group_barrier(0x100, 1, 0); }
        SB();
        LOAD_V(0, 64); LOAD_V(1, 80); SB();
        PV(pfb, 64);
#undef LOAD_K
#undef QK
#undef LOAD_V
#undef PV
#undef SB
        VMWAIT0(); __syncthreads();
    }
#undef DIFF_KP
#undef DIFF_VP
#undef DIFF_KROW
#undef DKimg
#undef DVimg
    const float lam = ((const float*)(F.ws + WS_DEC))[32 + l], li = ((const float*)(F.ws + WS_DEC))[40 + l];
    int lane2_ = lane_now(); asm volatile("" : "+v"(lane2_));
    LAS float* ex = (LAS float*)F.lds + (size_t)(w & 3) * 4096 + lane2_;
    const float inv = (sm ? lam : 1.f) * ((DUP_MASK & 262144) ? 0.5f : 1.f) / xsum(st.l);
    if (sm) {
#pragma unroll
        for (int c = 0; c < 4; ++c)
#pragma unroll
            for (int r = 0; r < 16; ++r) ex[(c * 16 + r) * 64] = O[c][r] * inv;
    }
    __syncthreads();
    if (!sm) {
        const int hh2 = lane2_ >> 5; const int qrow2 = qrow0 + 32 * w + (lane2_ & 31);
        float ss = 0.f;
#pragma unroll
        for (int c = 0; c < 4; ++c)
#pragma unroll
            for (int r = 0; r < 16; ++r) { const float o = O[c][r] * inv - ex[(c * 16 + r) * 64]; O[c][r] = o; ss += o * o; }
        ss = xsum(ss);
        const float rs = (1.f / sqrtf(ss * (1.f / 128.f) + NORM_EPS)) * (1.f - li);
        const float* gs = F.in[I_SUBLN] + l * 128;
        bf16_t* yo = (bf16_t*)(F.ws + WS_Y) + (size_t)qrow2 * 2048 + 1024 + h * 128; unsigned char* yo8 = F.ws + WS_Y + (size_t)qrow2 * 2048 + 1024 + h * 128;
        f32x4 ggv[4][4];
#pragma unroll
        for (int c = 0; c < 4; ++c)
#pragma unroll
            for (int g = 0; g < 4; ++g) ggv[c][g] = *(const f32x4*)(gs + 32 * c + 8 * g + 4 * hh2);
        __builtin_amdgcn_sched_barrier(0);
#pragma unroll
        for (int c = 0; c < 4; ++c)
#pragma unroll
            for (int g = 0; g < 4; ++g) { const int dv = 32 * c + 8 * g + 4 * hh2; const f32x4 gg = ggv[c][g];
                const float y0 = O[c][4 * g] * rs * gg.x, y1 = O[c][4 * g + 1] * rs * gg.y, y2 = O[c][4 * g + 2] * rs * gg.z, y3 = O[c][4 * g + 3] * rs * gg.w;
                if (BR_FP8) *(unsigned*)(yo8 + dv) = pk_fp8x4(y0 * 8.f, y1 * 8.f, y2 * 8.f, y3 * 8.f);
                else *(u32x2*)(yo + dv) = (u32x2){cvt_pk_bf16(y0, y1), cvt_pk_bf16(y2, y3)}; }
    }
}

__device__ __forceinline__ void gqa_unit(Frame& F, int l, int b, int kvh, int half, int qb) {
    const bf16_t* P = (const bf16_t*)(F.ws + WS_P);
#define GImg(x) (F.lds + 16384 * (x))
    int lane_ = lane_now(); asm volatile("" : "+v"(lane_)); const int lane = lane_, w = F.wave, r32 = lane & 31, hh = lane >> 5;
    LA la = make_la(lane); la.rowb ^= 16u * hh;
    const int head = kvh * 4 + half * 2 + (w >> 2);
    const bool ctxq = qb >= 32;
    const int qpos = (ctxq ? (qb - 32) : qb) * 128 + (w & 3) * 32 + r32;
    const int qrow = (ctxq ? TL + b * 256 : b * 4096) + qpos;
    bf16x8 q[4];
#pragma unroll
    for (int ks = 0; ks < 4; ++ks) q[ks] = *(const bf16x8*)(P + (size_t)qrow * DIN + C_GQ + head * 64 + 16 * ks + 8 * hh);
    const int lo = ctxq ? 0 : (2 * qb - 2 < 0 ? 0 : 2 * qb - 2), hi = ctxq ? -1 : (2 * qb + 3 > 63 ? 63 : 2 * qb + 3);
    const int nkt = 4 + (hi - lo + 1);
    const char* kvbase = (const char*)(P + C_GKV + kvh * 128);
#define GQA_ROW(tt, i) ((tt) < 4 ? (size_t)(TL + b * 256 + (tt) * 64 + (i)) : (size_t)(b * 4096 + (lo + (tt) - 4) * 64 + (i)))
#define GQA_P(r_) (kvbase + GQA_ROW(ttn, (r_)) * (DIN * 2))
    f32x16 O[2]; ZERO16(O[0]); ZERO16(O[1]);
    SmState st = {-1e30f, 0.f};
    __syncthreads();
    { DMA_LANE(); const int ttn = 0; DMA4(GImg(0), 2 * w, GQA_P); DMA4(GImg(0), 2 * w + 1, GQA_P); }
    VMWAIT0(); __syncthreads();
    for (int t = 0; t < nkt; ++t) {
        const int cur = t & 1;
        if (t + 1 < nkt) { DMA_LANE(); const int ttn = t + 1; DMA4(GImg(cur ^ 1), 2 * w, GQA_P); DMA4(GImg(cur ^ 1), 2 * w + 1, GQA_P); }
        LAS unsigned char* Ic = GImg(cur);
        OPAQUE(la.rowb); OPAQUE(la.trp);
        f32x16 a0, a1; ZERO16(a0); ZERO16(a1);
        { bf16x8 kf[8];
#pragma unroll
          for (int ks = 0; ks < 4; ++ks) { kf[ks] = frag_row(Ic, la.rowb, 0, 2 * ks); kf[4 + ks] = frag_row(Ic, la.rowb, 32, 2 * ks); }
          __builtin_amdgcn_sched_barrier(0);
#pragma unroll
          for (int ks = 0; ks < 4; ++ks) { a0 = MFMA32(kf[ks], q[ks], a0); a1 = MFMA32(kf[4 + ks], q[ks], a1); } }
        if (t >= 4) {
            const int k0 = (lo + t - 4) * 64;
#pragma unroll
            for (int r = 0; r < 16; ++r) { const int d0 = qpos - (k0 + crow(r, hh)), d1 = d0 - 32;
                if (d0 > 128 || d0 < -128) a0[r] = -INFINITY; if (d1 > 128 || d1 < -128) a1[r] = -INFINITY; }
        }
        bf16x8 pf[4], vf[4][2];
#pragma unroll
        for (int kq = 0; kq < 4; ++kq)
#pragma unroll
            for (int c = 0; c < 2; ++c) vf[kq][c] = frag_trp(Ic, la.trp, 16 * kq, c, 8);
        __builtin_amdgcn_sched_barrier(0);
        softmax_head<2>(a0, a1, st, O);
        __builtin_amdgcn_sched_barrier(0);
        sm_exp_q(a0, st, pf[0], pf[1]);
        __builtin_amdgcn_sched_barrier(0);
#pragma unroll
        for (int kq = 0; kq < 2; ++kq)
#pragma unroll
            for (int c = 0; c < 2; ++c) O[c] = MFMA32(vf[kq][c], pf[kq], O[c]);
        sm_exp_q(a1, st, pf[2], pf[3]);
#pragma unroll
        for (int i_ = 0; i_ < 4; ++i_) { __builtin_amdgcn_sched_group_barrier(0x008, 1, 0); __builtin_amdgcn_sched_group_barrier(0x002, 12, 0); }
        __builtin_amdgcn_sched_barrier(0);
#pragma unroll
        for (int kq = 2; kq < 4; ++kq)
#pragma unroll
            for (int c = 0; c < 2; ++c) O[c] = MFMA32(vf[kq][c], pf[kq], O[c]);
        VMWAIT0(); __syncthreads();
    }
#undef GQA_P
#undef GQA_ROW
#undef GImg
    const float sink = F.in[I_SINK][l * 8 + head];
    const float inv = 1.f / (xsum(st.l) + fexp2(sink * LOG2E - st.m));
    bf16_t* yo = (bf16_t*)(F.ws + WS_Y) + (size_t)qrow * 2048 + 1536 + head * 64; unsigned char* yo8 = F.ws + WS_Y + (size_t)qrow * 2048 + 1536 + head * 64;
#pragma unroll
    for (int c = 0; c < 2; ++c)
#pragma unroll
        for (int g = 0; g < 4; ++g) { const int dv = 32 * c + 8 * g + 4 * hh;
            const float y0 = O[c][4 * g] * inv, y1 = O[c][4 * g + 1] * inv, y2 = O[c][4 * g + 2] * inv, y3 = O[c][4 * g + 3] * inv;
            if (BR_FP8) *(unsigned*)(yo8 + dv) = pk_fp8x4(y0 * 8.f, y1 * 8.f, y2 * 8.f, y3 * 8.f);
            else *(u32x2*)(yo + dv) = (u32x2){cvt_pk_bf16(y0, y1), cvt_pk_bf16(y2, y3)}; }
}

__device__ __forceinline__ size_t ret_row(int b, int cid, int i) { return cid < 2 ? (size_t)(TL + b * 256 + cid * 128 + i) : (size_t)(b * 4096 + (cid - 2) * 128 + i); }
__device__ __forceinline__ bf16_t* st_ptr(const Frame& F, int b, int h, int dir, int cid) { return (bf16_t*)(F.ws + WS_ST) + ((((size_t)b * 4 + h) * 2 + dir) * NCHUNK + cid) * (256 * 128); }
__device__ __forceinline__ void ret_scan_item(Frame& F, int l, int item) {
    const int eh = item & 1, dir = (item >> 1) & 1, h = (item >> 2) & 3, b = item >> 4;
    int lane_ = lane_now(); asm volatile("" : "+v"(lane_)); const int lane = lane_, w = F.wave, r32 = lane & 31, hh = lane >> 5;
    LA la = make_la(lane);
    const int db = w >> 1, eb0 = 2 * (w & 1);
#define RKimg(x) (F.lds + 65536 * (x))
#define RVimg(x) (F.lds + 32768 + 65536 * (x))
    const char* kbase = (const char*)((const bf16_t*)(F.ws + WS_P) + C_RK + h * 128);
    const char* vbase = (const char*)((const bf16_t*)(F.ws + WS_P) + C_RV + h * 256 + eh * 128);
    const float lg = ((const float*)(F.ws + WS_DEC))[l * 8 + dir * 4 + h];
    const float cd = fexp2(lg * 128.f);
    float dk[8];
#pragma unroll
    for (int j = 0; j < 8; ++j) dk[j] = dir == 0 ? fexp2(lg * (float)(127 - 8 * hh - j)) : fexp2(lg * (float)(8 * hh + j));
    const float lgs = dir == 0 ? -16.f * lg : 16.f * lg;
#define R1_CID(n) (dir == 0 ? (n) : ((n) == 0 ? 1 : ((n) == 1 ? 0 : 35 - (n))))
#define R1_KP(r_) (kbase + ret_row(b, cidn, (r_)) * (DIN * 2))
#define R1_VP(r_) (vbase + ret_row(b, cidn, (r_)) * (DIN * 2))
    f32x16 S0, S1; ZERO16(S0); ZERO16(S1);
    __syncthreads();
#define R1_BAR() do { asm volatile("" ::: "memory"); __builtin_amdgcn_s_barrier(); asm volatile("" ::: "memory"); } while (0)
    { DMA_LANE(); { const int cidn = R1_CID(0);
#pragma unroll
      for (int i = 0; i < 4; ++i) { DMA4(RKimg(0), 4 * w + i, R1_KP); DMA4(RVimg(0), 4 * w + i, R1_VP); } }
      { const int cidn = R1_CID(1);
#pragma unroll
      for (int i = 0; i < 4; ++i) { DMA4(RKimg(1), 4 * w + i, R1_KP); DMA4(RVimg(1), 4 * w + i, R1_VP); } } }
    asm volatile("s_waitcnt vmcnt(8)" ::: "memory"); R1_BAR();
    for (int n = 0; n < NCHUNK; ++n) {
        const int cur = n & 1, cid = R1_CID(n);
        bf16_t* sp = st_ptr(F, b, h, dir, cid);
#pragma unroll
        for (int g = 0; g < 4; ++g) { const int d = 32 * db + 8 * g + 4 * hh;
            *(u32x2*)(sp + (size_t)(eh * 128 + 32 * eb0 + r32) * 128 + d) = (u32x2){cvt_pk_bf16(S0[4 * g], S0[4 * g + 1]), cvt_pk_bf16(S0[4 * g + 2], S0[4 * g + 3])};
            *(u32x2*)(sp + (size_t)(eh * 128 + 32 * (eb0 + 1) + r32) * 128 + d) = (u32x2){cvt_pk_bf16(S1[4 * g], S1[4 * g + 1]), cvt_pk_bf16(S1[4 * g + 2], S1[4 * g + 3])}; }
        if (n < NCHUNK - 1) {
            S0 = S0 * cd; S1 = S1 * cd;
            OPAQUE(la.trn);
#pragma unroll
            for (int ks = 0; ks < 8; ++ks) {
                bf16x8 a = frag_trn(RKimg(cur), la.trn, 16 * ks, db, 0);
                { const float fk = fexp2(lgs * (float)ks); u32x4 aw = __builtin_bit_cast(u32x4, a);
                  aw.x = cvt_pk_bf16(bflo(aw.x) * (dk[0] * fk), bfhi(aw.x) * (dk[1] * fk)); aw.y = cvt_pk_bf16(bflo(aw.y) * (dk[2] * fk), bfhi(aw.y) * (dk[3] * fk));
                  aw.z = cvt_pk_bf16(bflo(aw.z) * (dk[4] * fk), bfhi(aw.z) * (dk[5] * fk)); aw.w = cvt_pk_bf16(bflo(aw.w) * (dk[6] * fk), bfhi(aw.w) * (dk[7] * fk));
                  a = __builtin_bit_cast(bf16x8, aw); }
                S0 = MFMA32(a, frag_trn(RVimg(cur), la.trn, 16 * ks, eb0, 0), S0);
                S1 = MFMA32(a, frag_trn(RVimg(cur), la.trn, 16 * ks, eb0 + 1, 0), S1); }
        }
        R1_BAR();
        const bool issue = n + 2 < NCHUNK - 1;
        if (issue) { DMA_LANE(); const int cidn = R1_CID(n + 2);
#pragma unroll
            for (int i = 0; i < 4; ++i) { DMA4(RKimg(cur), 4 * w + i, R1_KP); DMA4(RVimg(cur), 4 * w + i, R1_VP); } }
        if (issue) asm volatile("s_waitcnt vmcnt(8)" ::: "memory"); else asm volatile("s_waitcnt vmcnt(0)" ::: "memory");
        R1_BAR();
    }
    VMWAIT0(); __syncthreads();
#undef R1_BAR
#undef R1_KP
#undef R1_VP
#undef R1_CID
#undef RKimg
#undef RVimg
    if (F.wave == 0 && lane_now() == 0) { __builtin_amdgcn_fence(__ATOMIC_RELEASE, "agent"); asm volatile("s_waitcnt vmcnt(0)" ::: "memory"); __hip_atomic_fetch_add(F.ctl + CW_R1 + l * 64, 1u, __ATOMIC_RELAXED, __HIP_MEMORY_SCOPE_AGENT); }
}
__device__ __forceinline__ void ret_out_unit(Frame& F, int l, int b, int h, int cid) {
    const bf16_t* P = (const bf16_t*)(F.ws + WS_P);
    int lane_ = lane_now(); asm volatile("" : "+v"(lane_)); const int lane = lane_, w = F.wave, r32 = lane & 31, hh = lane >> 5;
    LA la = make_la(lane); const unsigned rowb0 = la.rowb; la.rowb ^= 16u * hh;
    LAS unsigned char* Qimg = F.lds; LAS unsigned char* Kimg = F.lds + 32768; LAS unsigned char* Vimg0 = F.lds + 65536;
    LAS float* red = (LAS float*)(F.lds + 131072);
    const float lgf = ((const float*)(F.ws + WS_DEC))[l * 8 + h], lgb = ((const float*)(F.ws + WS_DEC))[l * 8 + 4 + h];
    const char* qbase = (const char*)(P + C_RQ + h * 128); const char* kbase = (const char*)(P + C_RK + h * 128); const char* vbase = (const char*)(P + C_RV + h * 256);
#define R2_QP(r_) (qbase + ret_row(b, cid, (r_)) * (DIN * 2))
#define R2_KP(r_) (kbase + ret_row(b, cid, (r_)) * (DIN * 2))
#define R2_V0(r_) (vbase + ret_row(b, cid, (r_)) * (DIN * 2))
#define R2_V1(r_) (vbase + 256 + ret_row(b, cid, (r_)) * (DIN * 2))
    __syncthreads();
    DMA_LANE();
#pragma unroll
    for (int i = 0; i < 4; ++i) { DMA4(Qimg, 4 * w + i, R2_QP); DMA4(Kimg, 4 * w + i, R2_KP); DMA4(Vimg0, 4 * w + i, R2_V0); DMA4(Vimg0 + 32768, 4 * w + i, R2_V1); }
    VMWAIT0(); __syncthreads();
#undef R2_QP
#undef R2_KP
#undef R2_V0
#undef R2_V1
    f32x16 at0, at1; ZERO16(at0); ZERO16(at1);
    const int ibw = w >> 1, jbw = 2 * (w & 1);
#pragma unroll
    for (int kh = 0; kh < 2; ++kh) { bf16x8 qf[4], k0[4], k1[4];
#pragma unroll
        for (int ks = 0; ks < 4; ++ks) { qf[ks] = frag_row(Qimg, la.rowb, 32 * ibw, 2 * (4 * kh + ks)); k0[ks] = frag_row(Kimg, la.rowb, 32 * jbw, 2 * (4 * kh + ks)); k1[ks] = frag_row(Kimg, la.rowb, 32 * jbw + 32, 2 * (4 * kh + ks)); }
        __builtin_amdgcn_sched_barrier(0);
#pragma unroll
        for (int ks = 0; ks < 4; ++ks) { at0 = MFMA32(k0[ks], qf[ks], at0); at1 = MFMA32(k1[ks], qf[ks], at1); } }
    { const int i = 32 * ibw + r32;
#pragma unroll
      for (int r = 0; r < 16; ++r) { const int j0 = 32 * jbw + crow(r, hh), j1 = j0 + 32;
          at0[r] *= i > j0 ? fexp2(lgf * (float)(i - j0)) : (i < j0 ? fexp2(lgb * (float)(j0 - i)) : 2.f);
          at1[r] *= i > j1 ? fexp2(lgf * (float)(i - j1)) : (i < j1 ? fexp2(lgb * (float)(j1 - i)) : 2.f); } }
    __syncthreads();
#pragma unroll
    for (int g = 0; g < 4; ++g) {
        *(LAS u32x2*)(Kimg + 8192 * ibw + ((rowb0 + 8u * hh) ^ (16u * (4u * jbw + g)))) = (u32x2){cvt_pk_bf16(at0[4 * g], at0[4 * g + 1]), cvt_pk_bf16(at0[4 * g + 2], at0[4 * g + 3])};
        *(LAS u32x2*)(Kimg + 8192 * ibw + ((rowb0 + 8u * hh) ^ (16u * (4u * jbw + 4u + g)))) = (u32x2){cvt_pk_bf16(at1[4 * g], at1[4 * g + 1]), cvt_pk_bf16(at1[4 * g + 2], at1[4 * g + 3])}; }
    __syncthreads();
    f32x16 o[4];
    const float dfl = fexp2(lgf * (float)(r32 + 1)), dbl = fexp2(lgb * (float)(128 - r32));
    {
        const bf16_t* sf = st_ptr(F, b, h, 0, cid) + (size_t)(32 * w + r32) * 128 + 8 * hh;
        const bf16_t* sb = st_ptr(F, b, h, 1, cid) + (size_t)(32 * w + r32) * 128 + 8 * hh;
        bf16x8 af[8];
#pragma unroll
        for (int ks = 0; ks < 8; ++ks) af[ks] = *(const bf16x8*)(sf + 16 * ks);
#pragma unroll
        for (int ib = 0; ib < 4; ++ib) { f32x16 a; ZERO16(a); OPAQUE(la.rowb); bf16x8 bq[8];
#pragma unroll
            for (int ks = 0; ks < 8; ++ks) bq[ks] = frag_row(Qimg, la.rowb, 32 * ib, 2 * ks);
            __builtin_amdgcn_sched_barrier(0);
#pragma unroll
            for (int ks = 0; ks < 8; ++ks) a = MFMA32(af[ks], bq[ks], a);
            o[ib] = a * (dfl * fexp2(lgf * (float)(32 * ib))); }
#pragma unroll
        for (int ks = 0; ks < 8; ++ks) af[ks] = *(const bf16x8*)(sb + 16 * ks);
#pragma unroll
        for (int ib = 0; ib < 4; ++ib) { f32x16 a; ZERO16(a); OPAQUE(la.rowb); bf16x8 bq[8];
#pragma unroll
            for (int ks = 0; ks < 8; ++ks) bq[ks] = frag_row(Qimg, la.rowb, 32 * ib, 2 * ks);
            __builtin_amdgcn_sched_barrier(0);
#pragma unroll
            for (int ks = 0; ks < 8; ++ks) a = MFMA32(af[ks], bq[ks], a);
            o[ib] += a * (dbl * fexp2(-lgb * (float)(32 * ib))); }
        LAS unsigned char* Vh = Vimg0 + 32768 * (w >> 2);
#pragma unroll
        for (int ks = 0; ks < 8; ++ks) af[ks] = frag_trn(Vh, la.trn, 16 * ks, w & 3, 0);
#pragma unroll
        for (int ib = 0; ib < 4; ++ib) { OPAQUE(la.rowb); bf16x8 bq[8];
#pragma unroll
            for (int ks = 0; ks < 8; ++ks) bq[ks] = frag_row(Kimg, la.rowb, 32 * ib, 2 * ks);
            __builtin_amdgcn_sched_barrier(0);
#pragma unroll
            for (int ks = 0; ks < 8; ++ks) o[ib] = MFMA32(af[ks], bq[ks], o[ib]); }
    }
#pragma unroll
    for (int ib = 0; ib < 4; ++ib) { float s = 0.f, s2 = 0.f;
#pragma unroll
        for (int r = 0; r < 16; ++r) { s += o[ib][r]; s2 += o[ib][r] * o[ib][r]; }
        s = xsum(s); s2 = xsum(s2);
        if (hh == 0) { red[(w * 128 + 32 * ib + r32) * 2] = s; red[(w * 128 + 32 * ib + r32) * 2 + 1] = s2; } }
    __syncthreads();
    const int ybase = h * 256 + 32 * w;
#pragma unroll
    for (int ib = 0; ib < 4; ++ib) { float s = 0.f, s2 = 0.f;
#pragma unroll
        for (int ww = 0; ww < 8; ++ww) { s += red[(ww * 128 + 32 * ib + r32) * 2]; s2 += red[(ww * 128 + 32 * ib + r32) * 2 + 1]; }
        const float mu = s * (1.f / 256.f), var = fmaxf(s2 * (1.f / 256.f) - mu * mu, 0.f), rs = 1.f / sqrtf(var + NORM_EPS);
        const size_t row = ret_row(b, cid, 32 * ib + r32);
        const bf16_t* gp = P + row * DIN + C_RG + ybase; bf16_t* yo = (bf16_t*)(F.ws + WS_Y) + row * 2048 + ybase;
#pragma unroll
        for (int g = 0; g < 4; ++g) { const int e = 8 * g + 4 * hh; const u32x2 gw = *(const u32x2*)(gp + e);
            const float y0 = (o[ib][4 * g] - mu) * rs * bflo(gw.x), y1 = (o[ib][4 * g + 1] - mu) * rs * bfhi(gw.x), y2 = (o[ib][4 * g + 2] - mu) * rs * bflo(gw.y), y3 = (o[ib][4 * g + 3] - mu) * rs * bfhi(gw.y);
            if (BR_FP8) *(unsigned*)(F.ws + WS_Y + row * 2048 + ybase + e) = pk_fp8x4(y0 * 8.f, y1 * 8.f, y2 * 8.f, y3 * 8.f);
            else *(u32x2*)(yo + e) = (u32x2){cvt_pk_bf16(y0, y1), cvt_pk_bf16(y2, y3)}; } }
}

__device__ __forceinline__ void p_norm2_router(Frame& F, int l, bool dry = false) {
    LAS int* lcount = (LAS int*)F.lds;
    LAS int* lbase = lcount + 32;
    LAS int* rec_e = lbase + 32;
    LAS float* rec_w = (LAS float*)(rec_e + 1024);
    LAS int* rec_a = (LAS int*)(rec_w + 1024);
    LAS int* nrec = rec_a + 1024;
    int lane_ = lane_now(); asm volatile("" : "+v"(lane_)); const int lane = lane_, w = F.wave, r32 = lane & 31, hh = lane >> 5;
    const int NGRP = (l < DEPTH - 1 ? TT : TL) / 32;
    float sink_acc = 0.f;
    if (F.tid < 32) lcount[F.tid] = 0;
    if (F.tid == 32) *nrec = 0;
    const Row16 g = ld_row_f32(F.in[I_GFFN] + (size_t)l * D, lane);
    bf16_t* H = (bf16_t*)(F.ws + WS_H); bf16_t* HLO = (bf16_t*)(F.ws + WS_MGB);
    for (int grp = F.bid; grp < NGRP; grp += F.G)
        for (int i = 0; i < 4; ++i) {
            const int row = grp * 32 + w * 4 + i;
            const Row16 x = ld_row_f32((const float*)(F.ws + WS_XRES) + (size_t)row * D, lane);
            const float rs = row_rstd(x); const int v = row_modv(row);
            const Row16 sh = ld_row_f32(modp(F, l, v, 3), lane), sc = ld_row_f32(modp(F, l, v, 4), lane);
            Row16 h, lo;
#pragma unroll
            for (int j = 0; j < 4; ++j) { h.v[j] = x.v[j] * rs * g.v[j] * (sc.v[j] + 1.f) + sh.v[j];
                const unsigned a = cvt_pk_bf16(h.v[j].x, h.v[j].y), b = cvt_pk_bf16(h.v[j].z, h.v[j].w);
                lo.v[j] = h.v[j] - (f32x4){bflo(a), bfhi(a), bflo(b), bfhi(b)}; }
            st_row_bf16(H + (size_t)row * D, lane, h); st_row_bf16(HLO + (size_t)row * D, lane, lo);
            { unsigned* h8 = (unsigned*)(F.ws + WS_MG + (size_t)row * D) + lane;
#pragma unroll
              for (int j = 0; j < 4; ++j) h8[64 * j] = pk_fp8x4(h.v[j].x * 8.f, h.v[j].y * 8.f, h.v[j].z * 8.f, h.v[j].w * 8.f); }
        }
    VMWAIT0(); __syncthreads();
    __builtin_amdgcn_fence(__ATOMIC_ACQUIRE, "agent");
    LAS float* part = (LAS float*)(F.lds + 16384);
    for (int g0 = 0; F.bid + g0 * F.G < NGRP; g0 += 3) {
        __syncthreads();
        for (int gi = 0; gi < 3; ++gi) { const int grp = F.bid + (g0 + gi) * F.G; if (grp >= NGRP) break;
            const bf16_t* wr = (const bf16_t*)(F.ws + WS_WRT) + (size_t)l * 2 * NEXP * D + (size_t)r32 * D + 8 * hh + 128 * w;
            const bf16_t* hp = H + (size_t)(grp * 32 + r32) * D + 8 * hh + 128 * w; const bf16_t* lp = HLO + (size_t)(grp * 32 + r32) * D + 8 * hh + 128 * w;
            f32x16 pacc; ZERO16(pacc);
            bf16x8 whi[8], wlo[8], xhi[8], xlo[8];
#pragma unroll
            for (int ks = 0; ks < 8; ++ks) { whi[ks] = *(const bf16x8*)(wr + 16 * ks); wlo[ks] = *(const bf16x8*)(wr + NEXP * D + 16 * ks); xhi[ks] = *(const bf16x8*)(hp + 16 * ks); xlo[ks] = *(const bf16x8*)(lp + 16 * ks); }
            __builtin_amdgcn_sched_barrier(0);
#pragma unroll
            for (int ks = 0; ks < 8; ++ks) { pacc = MFMA32(whi[ks], xhi[ks], pacc); pacc = MFMA32(whi[ks], xlo[ks], pacc); pacc = MFMA32(wlo[ks], xhi[ks], pacc); }
#pragma unroll
            for (int r = 0; r < 16; ++r) part[((gi * 8 + w) * 16 + r) * 64 + lane] = pacc[r];
        }
        __syncthreads();
        const int grp = F.bid + (g0 + w) * F.G;
        if (w < 3 && grp < NGRP) {
            f32x16 acc;
#pragma unroll
            for (int r = 0; r < 16; ++r) { float sum = 0.f;
#pragma unroll
                for (int ww = 0; ww < 8; ++ww) sum += part[((w * 8 + ww) * 16 + r) * 64 + lane];
                acc[r] = sum; }
            float mine[16], oth[16];
#pragma unroll
            for (int r = 0; r < 16; ++r) { mine[r] = acc[r] + F.in[I_BR][l * NEXP + crow(r, hh)]; oth[r] = xother(mine[r], hh); }
            float tv[4]; int ti[4];
#pragma unroll
            for (int k = 0; k < 4; ++k) {
                float best = -INFINITY; int bi = 1 << 20;
#pragma unroll
                for (int r = 0; r < 16; ++r) { const int e0 = crow(r, hh), e1 = crow(r, hh ^ 1);
                    if (mine[r] > best || (mine[r] == best && e0 < bi)) { best = mine[r]; bi = e0; }
                    if (oth[r] > best || (oth[r] == best && e1 < bi)) { best = oth[r]; bi = e1; } }
                tv[k] = best; ti[k] = bi;
#pragma unroll
                for (int r = 0; r < 16; ++r) { if (crow(r, hh) == bi) mine[r] = -INFINITY; if (crow(r, hh ^ 1) == bi) oth[r] = -INFINITY; }
            }
            if (dry) sink_acc += tv[0] + tv[1] + tv[2] + tv[3] + (float)(ti[0] + ti[1] + ti[2] + ti[3]);
            if (hh == 0 && !dry) {
                const float e1 = fexp2((tv[1] - tv[0]) * LOG2E), e2 = fexp2((tv[2] - tv[0]) * LOG2E), e3 = fexp2((tv[3] - tv[0]) * LOG2E), inv = 1.f / (1.f + e1 + e2 + e3);
                const float wk[4] = {inv, e1 * inv, e2 * inv, e3 * inv};
                const int token = grp * 32 + r32;
#pragma unroll
                for (int k = 0; k < 4; ++k) { const int pos = __hip_atomic_fetch_add(&lcount[ti[k]], 1, __ATOMIC_RELAXED, __HIP_MEMORY_SCOPE_WORKGROUP); const int slot = __hip_atomic_fetch_add(nrec, 1, __ATOMIC_RELAXED, __HIP_MEMORY_SCOPE_WORKGROUP);
                    rec_e[slot] = ti[k] | (pos << 8); rec_w[slot] = wk[k]; rec_a[slot] = token * 4 + k; }
            }
        }
    }
    __syncthreads();
    int* cnt = (int*)(F.ctl + CW_CNT + l * 64);
    if (dry) { if (sink_acc == 1.2345e33f) cnt[63] = 1; __syncthreads(); return; }
    if (F.tid < 32) lbase[F.tid] = atomicAdd(&cnt[F.tid], lcount[F.tid]);
    __syncthreads();
    int* list = (int*)(F.ws + WS_LIST); float* tw = (float*)(F.ws + WS_TW);
    const int n = *nrec;
    for (int i = F.tid; i < n; i += NTHR) { const int e = rec_e[i] & 255, pos = rec_e[i] >> 8, a = rec_a[i]; list[(size_t)e * TT + lbase[e] + pos] = a; tw[a] = rec_w[i]; }
}
__device__ __forceinline__ void moe_prefix(Frame& F, int l, LAS int* pref) {
    __syncthreads();
    if (F.tid == 0) { const int* cnt = (const int*)(F.ctl + CW_CNT + l * 64); int s = 0;
        for (int e = 0; e < NEXP; ++e) { pref[e] = s; s += (cnt[e] + 255) >> 8; } pref[NEXP] = s; }
    __syncthreads();
    { const int ntile = pref[NEXP]; const int* cnt = (const int*)(F.ctl + CW_CNT + l * 64);
      int t0_ = tid_now(F.wave); asm volatile("" : "+v"(t0_));
      for (int ti = t0_; ti < ntile; ti += NTHR) { int e = 0; for (int k = 1; k < NEXP; ++k) e += (pref[k] <= ti) ? 1 : 0;
          const int mt = ti - pref[e]; int valid = cnt[e] - mt * 256; valid = valid > 256 ? 256 : valid; pref[64 + ti] = e | (valid << 8) | (mt << 20); } }
    __syncthreads();
}

constexpr int NPH = 2 + 9 * DEPTH;
struct Args { const float* in[26]; float* out; unsigned char* ws; int ph_lo, ph_hi; };
__global__ void __launch_bounds__(NTHR, 2) mk_fwd(Args args) {
    extern __shared__ __attribute__((aligned(16))) unsigned char lds_raw[];
    Frame F;
    F.lds = (LAS unsigned char*)lds_raw;
    F.tid = threadIdx.x; F.lane = F.tid & 63; F.wave = __builtin_amdgcn_readfirstlane(F.tid >> 6);
    F.G = gridDim.x; F.bid = blockIdx.x;
    F.ws = args.ws; F.ctl = (unsigned*)(args.ws + WS_CTL); F.out = args.out;
    F.in = args.in;
    volatile LAS unsigned* MISC = (volatile LAS unsigned*)(F.lds + LDS_MISC);
    if (F.tid < 64) MISC[F.tid] = 0u;
    __syncthreads();
    const int lo = args.ph_lo, hi = args.ph_hi;
    XcdBarrier bar; bar.bar = F.ctl + CW_BAR; bar.x = 0; bar.wv = 0;
    if (hi - lo > 1) bar = xcd_barrier_post(F.ctl + CW_BAR, MISC);
    bar.wv = F.wave;
#ifdef ONLY_PH
#define IN(k) (ONLY_PH == ((k) == 0 ? 0 : 37) && lo <= (k) && (k) < hi)
#define INL(j) (ONLY_PH == 1 + (j) && lo <= pb + (j) && pb + (j) < hi)
#else
#define IN(k) (lo <= (k) && (k) < hi)
#define INL(j) IN(pb + (j))
#endif
#define SEAM(k) do { if (lo <= (k) + 1 && (k) + 1 < hi) { xcd_barrier(bar); if (DUP_MASK & 8192) xcd_barrier(bar); } } while (0)
    LAS int* pref = (LAS int*)(F.lds + 131072);
#define PHASE_BEGIN() do { WS_OPAQUE(); int _t = tid_now(F.wave); asm volatile("" : "+v"(_t)); F.tid = _t; F.lane = _t & 63; } while (0)
#define WS_OPAQUE() do { const unsigned long long _w = (unsigned long long)args.ws;        int _l = __builtin_amdgcn_readfirstlane((int)(unsigned)_w), _h = __builtin_amdgcn_readfirstlane((int)(unsigned)(_w >> 32)); \
        int _wv = F.wave, _bd = F.bid, _g = F.G; asm volatile("" : "+s"(_l), "+s"(_h), "+s"(_wv), "+s"(_bd), "+s"(_g)); F.wave = _wv; F.bid = _bd; F.G = _g; \
        F.ws = (unsigned char*)(((unsigned long long)(unsigned)_h << 32) | (unsigned)_l); F.ctl = (unsigned*)(F.ws + WS_CTL); } while (0)

#define BG_CONVERT(nwg_, which_) do { const int _maxn = ((nwg_) + F.G - 1) / F.G, _nb = F.bid < (nwg_) ? ((nwg_) - 1 - F.bid) / F.G + 1 : 0, _nlong = (nwg_) - (_maxn - 1) * F.G; \
        unsigned* _cnt = F.ctl + CW_LONG + l * 4 + (which_); PHASE_BEGIN(); \
        if (_nb == _maxn) { if (F.tid == 0) __hip_atomic_fetch_add(_cnt, 1u, __ATOMIC_RELAXED, __HIP_MEMORY_SCOPE_AGENT); } \
        else { while (conv_chunk(F, l + 1, _cnt, (unsigned)_nlong)) { } } } while (0)
    if (IN(0)) { PHASE_BEGIN(); p0_prologue(F); if (DUP_MASK & 512) { __syncthreads(); p0_prologue(F); } SEAM(0); }
    for (int l = 0; l < DEPTH; ++l) {
        const int pb = 1 + 9 * l;
        const bool need_ctx = l < DEPTH - 1;
        if (INL(0)) { PHASE_BEGIN(); if (DUP_MASK & 1) p_norm1(F, l, true); p_norm1(F, l); if (l > 0) { while (conv_chunk(F, l, nullptr, 0u)) { } } SEAM(pb + 0); }
        if (INL(1)) for (int rep_ = 0; rep_ < ((DUP_MASK >> 1) & 1) + 1; ++rep_) {
            WS_OPAQUE();
            SchedPlain S; S.o.init(TT / 256, DIN / 256, F.G, F.bid); S.A = (const char*)(F.ws + WS_H); S.B = (const char*)(F.ws + WS_WIN) + (size_t)l * DIN * D * (WIN_FP8 ? 1 : 2); S.lda = WIN_FP8 ? 1024 : 2048; S.ldb = S.lda; S.nt = WIN_FP8 ? 8 : 16;
            EpiIn E{(bf16_t*)(F.ws + WS_P), (const f32x4*)(F.ws + WS_ROPE128), (const f32x4*)(F.ws + WS_ROPE64)}; if (DUP_MASK & 16384) { S.dupk = 1; E.pre = 0.5f; } E.P = pin(E.P);
            gm::gemm_phase<EpiIn, SchedPlain, false, WIN_FP8 != 0>(F.lds, S, E, S.lda, S.ldb, F.wave);
            SEAM(pb + 1);
        }
        if (INL(2)) { WS_OPAQUE();
#if !defined(SUB) || SUB == 0
            for (int it = F.bid; it < 64 * (((DUP_MASK >> 10) & 1) + 1); it += F.G) ret_scan_item(F, l, it & 63);
#endif
#if !defined(SUB) || SUB == 1
            for (int u_ = F.bid; u_ < 512 * (((DUP_MASK >> 11) & 1) + 1); u_ += F.G) { const int u = u_ & 511; diff_unit(F, l, u >> 7, (u >> 5) & 3, 0, u & 31); }
            if (need_ctx) for (int u = (F.bid + F.G - 64 % F.G) % F.G; u < 32; u += F.G) diff_unit(F, l, u >> 3, (u >> 1) & 3, 1, u & 1);
#endif
#if !defined(SUB) || SUB == 2
            { const int nq = need_ctx ? 34 : 32, ngq = 16 * nq, g0 = F.G > 128 ? 64 : 0;
              if (F.bid >= g0) for (int u = F.bid - g0; u < ngq; u += F.G - g0) { const int qb = u % nq, r = u / nq; gqa_unit(F, l, r >> 2, (r >> 1) & 1, r & 1, qb); } }
#endif
            {
                __syncthreads();
                if (F.wave == 0) { unsigned* cw = F.ctl + CW_R1 + l * 64; unsigned sp_ = 0;
                    while ((unsigned)__builtin_amdgcn_readfirstlane((int)__hip_atomic_load(cw, __ATOMIC_RELAXED, __HIP_MEMORY_SCOPE_AGENT)) < 64u) { __builtin_amdgcn_s_sleep(2); if (++sp_ > (1u << 24)) break; }
                    __builtin_amdgcn_fence(__ATOMIC_ACQUIRE, "agent"); asm volatile("s_waitcnt vmcnt(0)" ::: "memory"); }
                __syncthreads();
                const int c0 = need_ctx ? 0 : 2, nc = NCHUNK - c0, nu = 16 * nc, g0 = F.G > 128 ? 64 : 0;
                if (F.bid < g0) { const int u = F.bid + (F.G > 128 ? nu : 0); if (u < nu) { const int cid = c0 + u % nc, r = u / nc; ret_out_unit(F, l, r >> 2, r & 3, cid); } }
                else for (int u = F.bid - g0; u < nu; u += F.G - g0) { const int cid = c0 + u % nc, r = u / nc; ret_out_unit(F, l, r >> 2, r & 3, cid); }
            }
            SEAM(pb + 2);
        }
        if (INL(3)) { }
        const bool fused45 = (F.G == 256) && (hi - lo > 1);
        if (INL(4)) { WS_OPAQUE();
            EpiBranch E{pin((const bf16_t*)(F.ws + WS_P)), pin((bf16_t*)(F.ws + WS_MGB))};
            if (fused45) {
                SchedBranchX S{F.bid, need_ctx ? 1 : 0, (const char*)(F.ws + WS_Y), (const char*)(F.ws + WS_WBR) + (size_t)l * D * 2048 * 2, F.ctl + CW_PB + l * 2048, F.wave};
                gm::gemm_phase<EpiBranch, SchedBranchX, false, false>(F.lds, S, E, 4096, 4096, F.wave);
            } else {
                SchedBranch S; S.o.init(need_ctx ? TT / 256 : TL / 256, 4, F.G, F.bid); S.Y = (const char*)(F.ws + WS_Y); S.W = (const char*)(F.ws + WS_WBR) + (size_t)l * D * 2048 * (BR_FP8 ? 1 : 2);
                gm::gemm_phase<EpiBranch, SchedBranch, false, BR_FP8 != 0>(F.lds, S, E, BR_FP8 ? 2048 : 4096, BR_FP8 ? 2048 : 4096, F.wave);
                if (need_ctx) BG_CONVERT(S.o.nwg, 0);
                SEAM(pb + 4);
            }
        }
        if (INL(5)) { WS_OPAQUE();
            EpiOut E{pin((float*)(F.ws + WS_XRES)), pin((const float*)(F.ws + WS_MOD) + (size_t)l * 5 * 6144), pin((float*)(F.ws + WS_XRES))};
            if (fused45) {
                SchedOutX S{F.bid, need_ctx ? 1 : 0, (const char*)(F.ws + WS_MGB), (const char*)(F.ws + WS_WOUT) + (size_t)l * D * D * 2, F.ctl + CW_PB + l * 2048, F.wave};
                gm::gemm_phase<EpiOut, SchedOutX, false, false>(F.lds, S, E, 2048, 2048, F.wave);
                if (need_ctx) {
                    unsigned* cnt_ = F.ctl + CW_LONG + l * 4; PHASE_BEGIN();
                    if ((F.bid & 7) < 4 && (F.bid >> 3) < 4) { if (F.tid == 0) __hip_atomic_fetch_add(cnt_, 1u, __ATOMIC_RELAXED, __HIP_MEMORY_SCOPE_AGENT); }
                    else { while (conv_chunk(F, l + 1, cnt_, 16u)) { } }
                }
            } else {
                SchedPlain S; S.o.init(need_ctx ? TT / 256 : TL / 256, 4, F.G, F.bid); S.A = (const char*)(F.ws + WS_MGB); S.B = (const char*)(F.ws + WS_WOUT) + (size_t)l * D * D * (BR_FP8 ? 1 : 2); S.lda = BR_FP8 ? 1024 : 2048; S.ldb = S.lda; S.nt = BR_FP8 ? 8 : 16;
                gm::gemm_phase<EpiOut, SchedPlain, false, BR_FP8 != 0>(F.lds, S, E, S.lda, S.ldb, F.wave);
                if (need_ctx) BG_CONVERT(S.o.nwg, 1);
            }
            SEAM(pb + 5);
        }
        if (INL(6)) { PHASE_BEGIN(); if (DUP_MASK & 64) p_norm2_router(F, l, true); p_norm2_router(F, l); SEAM(pb + 6); }
        if (INL(7)) for (int rep_ = 0; rep_ < ((DUP_MASK >> 7) & 1) + 1; ++rep_) {
            PHASE_BEGIN(); moe_prefix(F, l, pref);
            SchedGU S{F.G, F.bid, pref, (const int*)(F.ctl + CW_CNT + l * 64), (const int*)(F.ws + WS_LIST), (const char*)(F.ws + WS_MG), (const char*)(F.ws + WS_WGU) + (size_t)l * NEXP * 2048 * D, F.wave};
            EpiGU E{pin((bf16_t*)(F.ws + WS_ACT)), pin(F.in[I_BGU] + (size_t)l * NEXP * 2048)}; S.cnt = pin(S.cnt); S.list = pin(S.list);
            gm::gemm_phase<EpiGU, SchedGU, true, true>(F.lds, S, E, 1024, 1024, F.wave);
            SEAM(pb + 7);
        }
        if (INL(8)) for (int rep_ = 0; rep_ < ((DUP_MASK >> 8) & 1) + 1; ++rep_) {
            PHASE_BEGIN(); moe_prefix(F, l, pref);
            SchedDN S{F.G, F.bid, pref, (const int*)(F.ctl + CW_CNT + l * 64), (const char*)(F.ws + WS_ACT), (const char*)(F.ws + WS_WDN) + (size_t)l * NEXP * D * D};
            EpiDN E{pin((bf16_t*)(F.ws + WS_YK)), pin(F.in[I_BDN] + (size_t)l * NEXP * D), pin((const int*)(F.ws + WS_LIST)), pin((const float*)(F.ws + WS_TW))};
            gm::gemm_phase<EpiDN, SchedDN, false, true>(F.lds, S, E, 1024, 1024, F.wave);
            SEAM(pb + 8);
        }
    }
    if (IN(NPH - 1)) { PHASE_BEGIN(); p_final(F); }
#undef IN
#undef INL
#undef SEAM
}


#ifdef DBG_CHECK
constexpr int CW_DBG = 12288;
__device__ __forceinline__ void dbg_err(unsigned* ctl, int k, float fast, float ref, float scale) {
    float e = fabsf(fast - ref) / (fabsf(ref) + scale); if (!(e == e)) e = 9.f; if (e > 9.f) e = 9.f;
    atomicMax(ctl + CW_DBG + k, __builtin_bit_cast(unsigned, e));
}
__device__ __forceinline__ unsigned dbg_hash(unsigned x) { x ^= x >> 16; x *= 0x7feb352du; x ^= x >> 15; x *= 0x846ca68bu; x ^= x >> 16; return x; }
__device__ __forceinline__ float dbg_bf(const bf16_t* p, size_t i) { return bf2f(p[i]); }
__device__ float dbg_block_sum(float v, float* sh) {
    __syncthreads(); sh[threadIdx.x] = v; __syncthreads();
    for (int o = 128; o > 0; o >>= 1) { if ((int)threadIdx.x < o) sh[threadIdx.x] += sh[threadIdx.x + o]; __syncthreads(); }
    const float r = sh[0]; __syncthreads(); return r;
}
__device__ int dbg_srcrow_latent(int smp) { const unsigned h = dbg_hash(smp * 7919u + 13u); const int b = h & 3; int s = (h >> 2) & 4095; if ((smp & 7) == 0) s = (s & ~127); if ((smp & 7) == 1) s |= 127; return b * 4096 + s; }
__device__ int dbg_srcrow_any(int smp) { if ((smp & 3) == 3) { const unsigned h = dbg_hash(smp * 31u + 5u); return TL + (h & 1023); } return dbg_srcrow_latent(smp); }
struct DbgArgs { const float* const* in; unsigned char* ws; float* out; int stage, l; };
__device__ int dbg_win_src(int c) {
    for (int n = (c & ~255); n < (c & ~255) + 256; ++n) if (rowmap<1>(n) == c) return n;
    return -1;
}
template <int stage> __global__ void __launch_bounds__(256) dbg_chk(Args a, int l) {
    __shared__ float sh[256]; __shared__ float shv[1024];
    unsigned char* ws = a.ws; unsigned* ctl = (unsigned*)(ws + WS_CTL);
    const int t = threadIdx.x, smp = blockIdx.x;
    const float* mod = (const float*)(ws + WS_MOD) + (size_t)l * 5 * 6144;
    const bf16_t* P = (const bf16_t*)(ws + WS_P); const bf16_t* H = (const bf16_t*)(ws + WS_H); const bf16_t* Y = (const bf16_t*)(ws + WS_Y);
    const float* dec = (const float*)(ws + WS_DEC);
    if (stage == 0) {
        const unsigned h = dbg_hash(smp + 77u); const int v = h % 5, n = (h >> 8) % 6144; float s = 0.f;
        for (int k = t; k < 1024; k += 256) { const float c = v < 4 ? a.in[I_C][v * 1024 + k] : a.in[I_CCTX][k]; s += (c / (1.f + expf(-c))) * a.in[I_WMOD][((size_t)l * 1024 + k) * 6144 + n]; }
        s = dbg_block_sum(s, sh) + a.in[I_BMOD][l * 6144 + n];
        if (t == 0) dbg_err(ctl, 0, mod[v * 6144 + n], s, 0.01f);
    } else if (stage == 1) {
        const int row = dbg_srcrow_any(smp); const float* x = row < TL ? a.in[I_X] + (size_t)row * D : a.in[I_CTX] + (size_t)(row - TL) * D; float ss = 0.f;
        for (int k = t; k < 1024; k += 256) ss += x[k] * x[k];
        ss = dbg_block_sum(ss, sh); const float rs = 1.f / sqrtf(ss / 1024.f + NORM_EPS); const int v = row_modv(row);
        for (int k = t; k < 1024; k += 256) { const float h = x[k] * rs * a.in[I_GMIX][l * 1024 + k] * (1.f + mod[v * 6144 + 1024 + k]) + mod[v * 6144 + k]; dbg_err(ctl, 1, dbg_bf(H, (size_t)row * D + k), h, 0.02f); }
    } else if (stage == 2) {
        const int row = dbg_srcrow_any(smp); const bool latent = row < TL; const int s = row & 4095;
        for (int k = t; k < 1024; k += 256) shv[k] = dbg_bf(H, (size_t)row * D + k);
        __syncthreads();
        for (int it = 0; it < 4; ++it) {
            const int c = (dbg_hash(smp * 1024u + it * 256u + t) % DIN) & ~1;
            float o0 = 0.f, o1 = 0.f;
            { const int n0 = dbg_win_src(c), n1 = dbg_win_src(c + 1); for (int k = 0; k < 1024; ++k) { o0 += shv[k] * a.in[I_WIN][((size_t)l * 1024 + k) * DIN + n0]; o1 += shv[k] * a.in[I_WIN][((size_t)l * 1024 + k) * DIN + n1]; } }
            int hd = 0; float scale = 1.f;
            if (c < C_RK) { hd = 128; scale = 0.08838834764831845f; } else if (c < C_RV) hd = 128; else if (c >= C_DQ && c < C_DK) { hd = 64; scale = 0.125f; } else if (c >= C_DK && c < C_DV) hd = 64;
            else if (c >= C_GQ && c < C_GKV) { hd = 64; scale = 0.125f; } else if (c >= C_GKV && c < C_GATE && ((c - C_GKV) & 127) < 64) hd = 64;
            if (hd && latent) { const int i = (hd == 128 ? (c & 127) : (c & 63)) >> 1, quarter = hd / 4; const int pos = i < quarter ? (s >> 6) : (s & 63), j = i < quarter ? i : i - quarter;
                const float ang = (float)pos * powf(10000.f, -(float)j / (float)quarter), cs = __cosf(ang), sn = __sinf(ang); const float x1 = o0, x2 = o1; o0 = x1 * cs - x2 * sn; o1 = x1 * sn + x2 * cs; }
            if (c >= C_RG && c < C_DQ) { o0 = o0 / (1.f + expf(-o0)); o1 = o1 / (1.f + expf(-o1)); }
            if (c >= C_GATE) { o0 = 1.f / (1.f + expf(-o0)); o1 = 1.f / (1.f + expf(-o1)); }
            o0 *= scale; o1 *= scale;
            { int cls = c < C_RK ? 0 : c < C_RV ? 1 : c < C_RG ? 2 : c < C_DQ ? 3 : c < C_DK ? 4 : c < C_DV ? 5 : c < C_GQ ? 6 : c < C_GKV ? 7 : c < C_GATE ? (((c - C_GKV) & 127) < 64 ? 8 : 9) : 10;
              const int slot = 20 + cls * 2 + (latent ? 0 : 1);
              const float esc = 0.5f * scale;
              dbg_err(ctl, slot, dbg_bf(P, (size_t)row * DIN + c), o0, esc); dbg_err(ctl, slot, dbg_bf(P, (size_t)row * DIN + c + 1), o1, esc); }
        }
    } else if (stage == 4) {
        const unsigned hsh = dbg_hash(smp + 999u); const int h = hsh & 3; const int row = dbg_srcrow_any(smp); const bool latent = row < TL; const int b = latent ? row >> 12 : (row - TL) >> 8; const int tq = latent ? (row & 4095) : ((row - TL) & 255);
        const float lgf = dec[l * 8 + h], lgb = dec[l * 8 + 4 + h];
        if (t < 128) shv[t] = dbg_bf(P, (size_t)row * DIN + C_RQ + h * 128 + t);
        __syncthreads();
        const int pfq = latent ? 256 + tq : tq, pbq = latent ? 256 + 4095 - tq : 255 - tq;
        float o = 0.f;
        for (int sidx = 0; sidx < 4352; ++sidx) { const bool sl = sidx >= 256; const int sp = sl ? sidx - 256 : sidx; const int srow = sl ? b * 4096 + sp : TL + b * 256 + sp;
            if (!latent && sl) continue;
            const int pfs = sl ? 256 + sp : sp, pbs = sl ? 256 + 4095 - sp : 255 - sp;
            float wgt = 0.f; if (pfs <= pfq) wgt += exp2f(lgf * (float)(pfq - pfs)); if (pbs <= pbq) wgt += exp2f(lgb * (float)(pbq - pbs));
            if (wgt == 0.f) continue;
            float dot = 0.f; for (int d = 0; d < 128; ++d) dot += shv[d] * dbg_bf(P, (size_t)srow * DIN + C_RK + h * 128 + d);
            o += wgt * dot * dbg_bf(P, (size_t)srow * DIN + C_RV + h * 256 + t); }
        const float mu = dbg_block_sum(o, sh) / 256.f; const float var = dbg_block_sum((o - mu) * (o - mu), sh) / 256.f;
        const float y = (o - mu) / sqrtf(var + NORM_EPS) * dbg_bf(P, (size_t)row * DIN + C_RG + h * 256 + t);
        dbg_err(ctl, 4, dbg_bf(Y, (size_t)row * 2048 + h * 256 + t), y, 0.3f);
    } else if (stage == 5) {
        const unsigned hsh = dbg_hash(smp + 555u); const int h = hsh & 3; const int row = dbg_srcrow_any(smp); const bool latent = row < TL; const int b = latent ? row >> 12 : (row - TL) >> 8;
        if (t < 128) shv[t] = dbg_bf(P, (size_t)row * DIN + C_DQ + h * 128 + t);
        __syncthreads();
        float m1 = -1e30f, m2 = -1e30f;
        const int s0 = latent ? 0 : 4096;
        for (int sidx = s0; sidx < 4352; ++sidx) { const int srow = sidx < 4096 ? b * 4096 + sidx : TL + b * 256 + sidx - 4096; float d1 = 0.f, d2 = 0.f;
            for (int d = 0; d < 64; ++d) { d1 += shv[d] * dbg_bf(P, (size_t)srow * DIN + C_DK + h * 128 + d); d2 += shv[64 + d] * dbg_bf(P, (size_t)srow * DIN + C_DK + h * 128 + 64 + d); }
            m1 = fmaxf(m1, d1); m2 = fmaxf(m2, d2); }
        float l1 = 0.f, l2 = 0.f, o1 = 0.f, o2 = 0.f;
        for (int sidx = s0; sidx < 4352; ++sidx) { const int srow = sidx < 4096 ? b * 4096 + sidx : TL + b * 256 + sidx - 4096; float d1 = 0.f, d2 = 0.f;
            for (int d = 0; d < 64; ++d) { d1 += shv[d] * dbg_bf(P, (size_t)srow * DIN + C_DK + h * 128 + d); d2 += shv[64 + d] * dbg_bf(P, (size_t)srow * DIN + C_DK + h * 128 + 64 + d); }
            const float p1 = expf(d1 - m1), p2 = expf(d2 - m2); l1 += p1; l2 += p2; const float v = t < 128 ? dbg_bf(P, (size_t)srow * DIN + C_DV + h * 128 + t) : 0.f; o1 += p1 * v; o2 += p2 * v; }
        const float lam = dec[32 + l], li = dec[40 + l]; const float o = t < 128 ? o1 / l1 - lam * o2 / l2 : 0.f;
        const float ms = dbg_block_sum(o * o, sh) / 128.f;
        if (t < 128) { const float y = o / sqrtf(ms + NORM_EPS) * a.in[I_SUBLN][l * 128 + t] * (1.f - li); dbg_err(ctl, 5, dbg_bf(Y, (size_t)row * 2048 + 1024 + h * 128 + t), y, 0.4f); }
    } else if (stage == 6) {
        const unsigned hsh = dbg_hash(smp + 333u); const int head = hsh & 7, kvh = head >> 2; const int row = dbg_srcrow_any(smp); const bool latent = row < TL; const int b = latent ? row >> 12 : (row - TL) >> 8; const int tq = row & 4095;
        if (t < 64) shv[t] = dbg_bf(P, (size_t)row * DIN + C_GQ + head * 64 + t);
        __syncthreads();
        const float sink = a.in[I_SINK][l * 8 + head];
        float m = sink;
        for (int pass = 0; pass < 2; ++pass) { float lsum = 0.f, o = 0.f;
            for (int sidx = 0; sidx < 4352; ++sidx) { const bool sl = sidx >= 256; const int sp = sl ? sidx - 256 : sidx; if (sl && (!latent || sp < tq - 128 || sp > tq + 128)) continue;
                const int srow = sl ? b * 4096 + sp : TL + b * 256 + sp; float d = 0.f;
                for (int k = 0; k < 64; ++k) d += shv[k] * dbg_bf(P, (size_t)srow * DIN + C_GKV + kvh * 128 + k);
                if (pass == 0) m = fmaxf(m, d); else { const float p = expf(d - m); lsum += p; o += p * (t < 64 ? dbg_bf(P, (size_t)srow * DIN + C_GKV + kvh * 128 + 64 + t) : 0.f); } }
            if (pass == 1 && t < 64) { lsum += expf(sink - m); dbg_err(ctl, 6, dbg_bf(Y, (size_t)row * 2048 + 1536 + head * 64 + t), o / lsum, 0.15f); } }
    } else if (stage == 7) {
        const int row = dbg_srcrow_any(smp);
        for (int it = 0; it < 4; ++it) { const int col = it * 256 + t; float r = 0.f;
            for (int seg = 0; seg < 3; ++seg) { const int k0 = seg == 0 ? 0 : (seg == 1 ? 1024 : 1536), k1 = seg == 0 ? 1024 : (seg == 1 ? 1536 : 2048); float acc = 0.f;
                for (int k = k0; k < k1; ++k) acc += dbg_bf(Y, (size_t)row * 2048 + k) * a.in[I_WBR][((size_t)l * 2048 + k) * D + col];
                r += acc * dbg_bf(P, (size_t)row * DIN + C_GATE + seg * 1024 + col); }
            dbg_err(ctl, 7, dbg_bf((const bf16_t*)(ws + WS_MGB), (size_t)row * D + col), r, 0.25f); }
    } else if (stage == 8) {
        const int row = dbg_srcrow_any(smp); const float* x = row < TL ? a.in[I_X] + (size_t)row * D : a.in[I_CTX] + (size_t)(row - TL) * D; const int v = row_modv(row);
        for (int it = 0; it < 4; ++it) { const int col = it * 256 + t; float acc = 0.f;
            for (int k = 0; k < 1024; ++k) acc += dbg_bf((const bf16_t*)(ws + WS_MGB), (size_t)row * D + k) * a.in[I_WOUT][((size_t)l * D + k) * D + col];
            dbg_err(ctl, 8, ((const float*)(ws + WS_XRES))[(size_t)row * D + col], x[col] + mod[v * 6144 + 2048 + col] * acc, 0.5f); }
    } else if (stage == 9) {
        const int row = dbg_srcrow_any(smp); const float* x = (const float*)(ws + WS_XRES) + (size_t)row * D; const int v = row_modv(row);
        __shared__ float hx[1024]; __shared__ float act[1024]; __shared__ float totsh[1024]; __shared__ float lg[32]; __shared__ int tix[4]; __shared__ float twt[4];
        float ss = 0.f; for (int k = t; k < 1024; k += 256) ss += x[k] * x[k];
        ss = dbg_block_sum(ss, sh); const float rs = 1.f / sqrtf(ss / 1024.f + NORM_EPS);
        for (int k = t; k < 1024; k += 256) hx[k] = x[k] * rs * a.in[I_GFFN][l * 1024 + k] * (1.f + mod[v * 6144 + 4096 + k]) + mod[v * 6144 + 3072 + k];
        __syncthreads();
        if (t < 32) { float s = a.in[I_BR][l * 32 + t]; for (int k = 0; k < 1024; ++k) s += hx[k] * a.in[I_WR][((size_t)l * D + k) * 32 + t]; lg[t] = s; }
        __syncthreads();
        if (t == 0) { for (int k = 0; k < 4; ++k) { int bi = 0; float bv = -1e30f; for (int e = 0; e < 32; ++e) if (lg[e] > bv) { bv = lg[e]; bi = e; } tix[k] = bi; twt[k] = bv; lg[bi] = -1e30f; }
            float sm = 0.f; const float t0 = twt[0]; for (int k = 0; k < 4; ++k) { twt[k] = expf(twt[k] - t0); sm += twt[k]; } for (int k = 0; k < 4; ++k) twt[k] /= sm; }
        __syncthreads();
        for (int c = t; c < 1024; c += 256) totsh[c] = 0.f;
        for (int k = 0; k < 4; ++k) { const int e = tix[k]; const float wk_ = twt[k]; const float* wgu = a.in[I_WGU] + ((size_t)l * 32 + e) * 1024 * 2048; const float* wdn = a.in[I_WDN] + ((size_t)l * 32 + e) * 1024 * 1024;
            for (int it = 0; it < 4; ++it) { const int j = it * 256 + t; float g = a.in[I_BGU][((size_t)l * 32 + e) * 2048 + j], li = a.in[I_BGU][((size_t)l * 32 + e) * 2048 + 1024 + j];
                for (int kk = 0; kk < 1024; ++kk) { g += hx[kk] * wgu[(size_t)kk * 2048 + j]; li += hx[kk] * wgu[(size_t)kk * 2048 + 1024 + j]; }
                g = fminf(g, 7.f); li = fminf(fmaxf(li, -7.f), 7.f); act[j] = g / (1.f + expf(-1.702f * g)) * (li + 1.f); }
            __syncthreads();
#pragma unroll
            for (int it = 0; it < 4; ++it) { const int c = it * 256 + t; float y = a.in[I_BDN][((size_t)l * 32 + e) * 1024 + c]; for (int kk = 0; kk < 1024; ++kk) y += act[kk] * wdn[(size_t)kk * 1024 + c]; totsh[c] += wk_ * y; }
            __syncthreads(); }
#pragma unroll
        for (int it = 0; it < 4; ++it) { const int c = it * 256 + t; float f = 0.f; for (int k = 0; k < 4; ++k) f += dbg_bf((const bf16_t*)(ws + WS_YK), ((size_t)row * 4 + k) * D + c); dbg_err(ctl, 9, f, totsh[c], 0.3f); }
    }
}
__global__ void dbg_prim(Args a) {
    unsigned* ctl = (unsigned*)(a.ws + WS_CTL); const int lane = threadIdx.x & 63; const float v = (float)(lane * lane + 1);
    float tot = 0.f; for (int i = 0; i < 64; ++i) tot += (float)(i * i + 1);
    dbg_err(ctl, 10, wave_sum(v), tot, 0.f);
    const float ov = (float)((lane ^ 32) * (lane ^ 32) + 1);
    dbg_err(ctl, 11, xsum(v), v + ov, 0.f); dbg_err(ctl, 12, xmax(v), fmaxf(v, ov), 0.f); dbg_err(ctl, 13, xother(v, lane >> 5), ov, 0.f);
}
__global__ void dbg_report(Args a, int nstage) {
    unsigned* ctl = (unsigned*)(a.ws + WS_CTL);
    int idx = nstage; float ev = 0.f;
    const int order[36] = {10, 11, 12, 13, 0, 1, 20, 21, 22, 23, 24, 25, 26, 27, 28, 29, 30, 31, 32, 33, 34, 35, 36, 37, 38, 39, 40, 41, 3, 4, 5, 6, 7, 8, 9, -1};
    idx = 35;
    for (int kk = 0; kk < 35; ++kk) { const float e = __builtin_bit_cast(float, ctl[CW_DBG + order[kk]]); if (e > 0.08f) { idx = kk; ev = e; break; } }
    const float X = 100.f * (float)(1 + idx);
    const float c = sqrtf(X);
    for (size_t i = (size_t)blockIdx.x * blockDim.x + threadIdx.x; i < (size_t)TL * D; i += (size_t)gridDim.x * blockDim.x) a.out[i] = c;
}
#endif

extern "C" void kernel_launch(void* const* d_in, const int* in_sizes, int n_in, void* d_out, int out_size, void* d_ws, size_t ws_size, hipStream_t stream) {
    static int grid = 0;
    if (grid == 0) {
        if (n_in != 26 || out_size != TL * D || ws_size < WS_END) { fprintf(stderr, "kernel_launch: unexpected shapes (n_in %d out %d ws %zu need %zu)\n", n_in, out_size, ws_size, (size_t)WS_END); grid = -1; return; }
        int dev = 0, cus = 0, per_cu = 0;
        if (hipGetDevice(&dev) != hipSuccess || hipDeviceGetAttribute(&cus, hipDeviceAttributeMultiprocessorCount, dev) != hipSuccess) { grid = -1; return; }
        if (hipFuncSetAttribute((const void*)mk_fwd, hipFuncAttributeMaxDynamicSharedMemorySize, LDS_BYTES) != hipSuccess) { fprintf(stderr, "kernel_launch: hipFuncSetAttribute failed\n"); grid = -1; return; }
        if (hipOccupancyMaxActiveBlocksPerMultiprocessor(&per_cu, (const void*)mk_fwd, NTHR, LDS_BYTES) != hipSuccess || per_cu < 1) { fprintf(stderr, "kernel_launch: occupancy query says %d\n", per_cu); (void)hipGetLastError(); per_cu = 1; }
        grid = cus;
    }
    if (grid < 0) return;
    (void)hipMemsetAsync((char*)d_ws + WS_CTL, 0, CTL_ZERO_BYTES, stream);
    Args a{};
    for (int i = 0; i < 26; ++i) a.in[i] = (const float*)d_in[i];
    a.out = (float*)d_out; a.ws = (unsigned char*)d_ws;
#if MK_MULTI
    for (int p = 0; p < NPH; ++p) { a.ph_lo = p; a.ph_hi = p + 1; hipLaunchKernelGGL(mk_fwd, dim3(grid), dim3(NTHR), LDS_BYTES, stream, a);
#ifdef DBG_CHECK
        const int L = DBG_CHECK - 1, pb = 1 + 9 * L;
        if (p == 0) hipLaunchKernelGGL(dbg_prim, dim3(1), dim3(64), 0, stream, a);
        if (p == 0) hipLaunchKernelGGL(dbg_chk<0>, dim3(64), dim3(256), 0, stream, a, L);
        if (p == pb + 0 && L == 0) hipLaunchKernelGGL(dbg_chk<1>, dim3(64), dim3(256), 0, stream, a, L);
        if (p == pb + 1) hipLaunchKernelGGL(dbg_chk<2>, dim3(256), dim3(256), 0, stream, a, L);
        if (p == pb + 3) { hipLaunchKernelGGL(dbg_chk<4>, dim3(48), dim3(256), 0, stream, a, L); hipLaunchKernelGGL(dbg_chk<5>, dim3(48), dim3(256), 0, stream, a, L); hipLaunchKernelGGL(dbg_chk<6>, dim3(48), dim3(256), 0, stream, a, L); }
        if (p == pb + 4) hipLaunchKernelGGL(dbg_chk<7>, dim3(32), dim3(256), 0, stream, a, L);
        if (p == pb + 5 && L == 0) hipLaunchKernelGGL(dbg_chk<8>, dim3(32), dim3(256), 0, stream, a, L);
        if (p == pb + 8) hipLaunchKernelGGL(dbg_chk<9>, dim3(24), dim3(256), 0, stream, a, L);
        if (p == NPH - 1) hipLaunchKernelGGL(dbg_report, dim3(256), dim3(256), 0, stream, a, 10);
#endif
    }
#else
    a.ph_lo = 0; a.ph_hi = NPH;
    hipLaunchKernelGGL(mk_fwd, dim3(grid), dim3(NTHR), LDS_BYTES, stream, a);
#endif
}
```
